# Optimizing an MI355X kernel written in HIP

```python
import math
import jax, jax.numpy as jnp
from jax import lax
import numpy as np

D_MODEL = 1024
BATCH = 8
SEQ = 2048
DEPTH = 2
DEC_BATCH = 32
DEC_SEQ = 32
PAST_LEN = 4096

CHUNK = 64
N_A = DEPTH // 2
N_B = DEPTH - N_A
H_A = 8
DK_A = D_MODEL // H_A
DV_A = 2 * DK_A
A_IN = 2 * H_A * DK_A + 2 * H_A * DV_A
H_B = 8
DH_B = D_MODEL // (2 * H_B)
QK_B = 2 * H_B * DH_B
V_B = H_B * 2 * DH_B
D_FF = 11 * D_MODEL // 4
N_MOD = 9
ROPE_THETA = 10000.0
EPS = 1e-6
Q_BLOCK = 128
HALF = 0.5

kernel_name = "yoco_retention_diffattn_streaming_step"


def rms_norm(x, g):
    xf = x.astype(jnp.float32)
    y = xf * lax.rsqrt(jnp.mean(xf * xf, axis=-1, keepdims=True) + EPS)
    return (y * g.astype(jnp.float32)).astype(x.dtype)


def modulate(x, g, shift, scale):
    return rms_norm(x, g) * (1 + scale[:, None, :]) + shift[:, None, :]


def swiglu(h, w_in, w_out):
    a, b = jnp.split(h @ w_in, 2, axis=-1)
    return (jax.nn.silu(a) * b) @ w_out


def rotary(x, pos):
    d = x.shape[-1]
    inv = jnp.power(ROPE_THETA, -jnp.arange(0, d, 2, dtype=jnp.float32) / d)
    ang = pos[:, None] * inv[None, :]
    ang = ang.reshape((ang.shape[0],) + (1,) * (x.ndim - 3) + (ang.shape[1],))
    cos, sin = jnp.cos(ang), jnp.sin(ang)
    x1, x2 = jnp.split(x.astype(jnp.float32), 2, axis=-1)
    return jnp.concatenate([x1 * cos - x2 * sin, x2 * cos + x1 * sin], axis=-1).astype(x.dtype)


def retention_log_gamma():
    return jnp.log1p(-jnp.exp2(-5.0 - jnp.arange(H_A, dtype=jnp.float32)))


def retention_block(state, q, k, v, log_gamma):
    n = q.shape[2]
    idx = jnp.arange(n, dtype=jnp.float32)
    lg = log_gamma[:, None]
    d_intra = jnp.exp(lg[:, :, None] * jnp.abs(idx[:, None] - idx[None, :])).astype(q.dtype)
    q_dec = jnp.exp(lg * idx).astype(q.dtype)
    k_dec = jnp.exp(lg * (n - idx)).astype(q.dtype)
    c_dec = jnp.exp(log_gamma * n).astype(q.dtype)
    scores = jnp.einsum('bhid,bhjd->bhij', q, k) * d_intra
    out = (jnp.einsum('bhij,bhjv->bhiv', scores, v)
           + jnp.einsum('bhid,bhdv->bhiv', q * q_dec[..., None], state))
    new_state = state * c_dec[:, None, None] + jnp.einsum('bhjd,bhjv->bhdv', k * k_dec[..., None], v)
    return out, new_state


def retention_mixer(h, pos, state, w_in, g_gn, w_out, prompt):
    b, s, _ = h.shape
    q, k, v, g = jnp.split(h @ w_in, [H_A * DK_A, 2 * H_A * DK_A, 2 * H_A * DK_A + H_A * DV_A], axis=-1)
    q = rotary(q.reshape(b, s, H_A, DK_A), pos)
    k = rotary(k.reshape(b, s, H_A, DK_A), pos) * (DK_A ** -0.5)
    v = v.reshape(b, s, H_A, DV_A)
    lg = retention_log_gamma()
    if prompt:
        nc = s // CHUNK

        def to_chunks(t):
            return t.reshape(b, nc, CHUNK, H_A, t.shape[-1]).transpose(1, 0, 3, 2, 4)

        def step(st, qkv):
            out, st = retention_block(st, *qkv, lg)
            return st, out

        state0 = jnp.zeros((b, H_A, DK_A, DV_A), h.dtype)
        new_state, o = lax.scan(step, state0, (to_chunks(q), to_chunks(k), to_chunks(v)))
        o = o.transpose(1, 0, 3, 2, 4).reshape(b, s, H_A, DV_A)
    else:
        o, new_state = retention_block(state, q.transpose(0, 2, 1, 3), k.transpose(0, 2, 1, 3),
                                       v.transpose(0, 2, 1, 3), lg)
        o = o.transpose(0, 2, 1, 3)
    o = rms_norm(o, g_gn.reshape(H_A, DV_A))
    y = (jax.nn.silu(g) * o.reshape(b, s, H_A * DV_A)) @ w_out
    return y, new_state


def shared_kv(x, c, pos, w_ada_kv, b_ada_kv, g_kv, w_kv):
    b, s, _ = x.shape
    shift, scale = jnp.split(jax.nn.silu(c) @ w_ada_kv + b_ada_kv, 2, axis=-1)
    k, v = jnp.split(modulate(x, g_kv, shift, scale) @ w_kv, 2, axis=-1)
    k = rotary(k.reshape(b, s, H_B, 2, DH_B), pos)
    v = v.reshape(b, s, H_B, 2 * DH_B)
    return k, v


def diff_attention_prompt(q, k, v, lam):
    b, s = q.shape[:2]
    nb = s // Q_BLOCK
    key_pos = jnp.arange(s)
    qb = q.reshape(b, nb, Q_BLOCK, H_B, 2, DH_B).transpose(1, 0, 2, 3, 4, 5)

    def block(args):
        qblk, i = args
        qpos = i * Q_BLOCK + jnp.arange(Q_BLOCK)
        visible = key_pos[None, :] < (qpos[:, None] // CHUNK + 1) * CHUNK
        logits = jnp.einsum('bqhtd,bkhtd->bhtqk', qblk, k).astype(jnp.float32) * (DH_B ** -0.5)
        p = jax.nn.softmax(jnp.where(visible, logits, -jnp.inf), axis=-1)
        pd = (p[:, :, 0] - lam * p[:, :, 1]).astype(v.dtype)
        return jnp.einsum('bhqk,bkhv->bqhv', pd, v)

    o = lax.map(block, (qb, jnp.arange(nb)))
    return o.transpose(1, 0, 2, 3, 4).reshape(b, s, H_B, 2 * DH_B)


def diff_attention_sample(q, k_new, v_new, k_past, v_past, lam):
    sc = DH_B ** -0.5
    lp = jnp.einsum('bqhtd,bkhtd->bhtqk', q, k_past).astype(jnp.float32) * sc
    ln = jnp.einsum('bqhtd,bkhtd->bhtqk', q, k_new).astype(jnp.float32) * sc
    p = jax.nn.softmax(jnp.concatenate([lp, ln], axis=-1), axis=-1)
    pd = (p[:, :, 0] - lam * p[:, :, 1]).astype(v_new.dtype)
    past = k_past.shape[1]
    return (jnp.einsum('bhqk,bkhv->bqhv', pd[..., :past], v_past)
            + jnp.einsum('bhqk,bkhv->bqhv', pd[..., past:], v_new))


def diff_mixer(h, pos, k, v, k_past, v_past, w_q, lam_p, g_sub, w_out, lam_init, prompt):
    b, s, _ = h.shape
    q = rotary((h @ w_q).reshape(b, s, H_B, 2, DH_B), pos)
    lp = lam_p.astype(jnp.float32)
    lam = jnp.exp(jnp.sum(lp[0] * lp[1])) - jnp.exp(jnp.sum(lp[2] * lp[3])) + lam_init
    if prompt:
        o = diff_attention_prompt(q, k, v, lam)
    else:
        o = diff_attention_sample(q, k, v, k_past, v_past, lam)
    o = rms_norm(o, g_sub) * (1 - lam_init)
    return o.reshape(b, s, V_B) @ w_out


def run_trunk(x, c, pos, ret_state, k_past, v_past, prompt,
              w_ada, b_ada, g_norm, w_ffn_in, w_ffn_out, w_in_a, g_gn_a, w_out_a,
              w_ada_kv, b_ada_kv, g_kv, w_kv, w_q_b, lam_b, g_subln_b, w_out_b):
    b = x.shape[0]
    new_ret = []
    k = v = None
    for l in range(DEPTH):
        mod = (jax.nn.silu(c) @ w_ada[l] + b_ada[l]).reshape(b, N_MOD, D_MODEL)
        h = modulate(x, g_norm[l, 0], mod[:, 0], mod[:, 1])
        x = x + HALF * mod[:, 2, None] * rms_norm(swiglu(h, w_ffn_in[l, 0], w_ffn_out[l, 0]), g_norm[l, 1])
        h = modulate(x, g_norm[l, 2], mod[:, 3], mod[:, 4])
        if l < N_A:
            y, st = retention_mixer(h, pos, None if prompt else ret_state[l],
                                    w_in_a[l], g_gn_a[l], w_out_a[l], prompt)
            new_ret.append(st)
        else:
            j = l - N_A
            lam_init = 0.8 - 0.6 * math.exp(-0.3 * l)
            y = diff_mixer(h, pos, k, v, k_past, v_past, w_q_b[j], lam_b[j], g_subln_b[j], w_out_b[j],
                           lam_init, prompt)
        x = x + mod[:, 5, None] * rms_norm(y, g_norm[l, 3])
        h = modulate(x, g_norm[l, 4], mod[:, 6], mod[:, 7])
        x = x + HALF * mod[:, 8, None] * rms_norm(swiglu(h, w_ffn_in[l, 1], w_ffn_out[l, 1]), g_norm[l, 5])
        if l == N_A - 1:
            k, v = shared_kv(x, c, pos, w_ada_kv, b_ada_kv, g_kv, w_kv)
    return x, jnp.stack(new_ret), k, v


def _nrm(key, shape, s):
    return jax.random.normal(key, shape, jnp.float32) * s


def setup_inputs(seed: int = 0) -> dict:
    key = jax.random.key(seed)
    ks = jax.random.split(key, 23)
    D = D_MODEL
    return {
        "x_prompt": _nrm(ks[0], (BATCH, SEQ, D), 1.0),
        "x_sample": _nrm(ks[1], (DEC_BATCH, DEC_SEQ, D), 1.0),
        "state_ret": _nrm(ks[2], (N_A, DEC_BATCH, H_A, DK_A, DV_A), 0.5),
        "cache_k": _nrm(ks[3], (DEC_BATCH, PAST_LEN, 2 * H_B, DH_B), 1.0),
        "cache_v": _nrm(ks[4], (DEC_BATCH, PAST_LEN, H_B, 2 * DH_B), 1.0),
        "c_prompt": _nrm(ks[5], (BATCH, D), 1.0),
        "c_sample": _nrm(ks[6], (DEC_BATCH, D), 1.0),
        "w_ada": _nrm(ks[7], (DEPTH, D, N_MOD * D), 0.5 * D ** -0.5),
        "b_ada": _nrm(ks[8], (DEPTH, N_MOD * D), 0.01),
        "g_norm": 1.0 + _nrm(ks[9], (DEPTH, 6, D), 0.02),
        "w_ffn_in": _nrm(ks[10], (DEPTH, 2, D, 2 * D_FF), D ** -0.5),
        "w_ffn_out": _nrm(ks[11], (DEPTH, 2, D_FF, D), D_FF ** -0.5),
        "w_in_a": _nrm(ks[12], (N_A, D, A_IN), D ** -0.5),
        "g_gn_a": 1.0 + _nrm(ks[13], (N_A, H_A * DV_A), 0.02),
        "w_out_a": _nrm(ks[14], (N_A, H_A * DV_A, D), (H_A * DV_A) ** -0.5),
        "w_ada_kv": _nrm(ks[15], (D, 2 * D), 0.5 * D ** -0.5),
        "b_ada_kv": _nrm(ks[16], (2 * D,), 0.01),
        "g_kv": 1.0 + _nrm(ks[17], (D,), 0.02),
        "w_kv": _nrm(ks[18], (D, QK_B + V_B), D ** -0.5),
        "w_q_b": _nrm(ks[19], (N_B, D, QK_B), D ** -0.5),
        "lam_b": _nrm(ks[20], (N_B, 4, DH_B), 0.1),
        "g_subln_b": 1.0 + _nrm(ks[21], (N_B, 2 * DH_B), 0.02),
        "w_out_b": _nrm(ks[22], (N_B, V_B, D), V_B ** -0.5),
    }


def reference(x_prompt, x_sample, state_ret, cache_k, cache_v, c_prompt, c_sample,
              w_ada, b_ada, g_norm, w_ffn_in, w_ffn_out, w_in_a, g_gn_a, w_out_a,
              w_ada_kv, b_ada_kv, g_kv, w_kv, w_q_b, lam_b, g_subln_b, w_out_b):
    weights = (w_ada, b_ada, g_norm, w_ffn_in, w_ffn_out, w_in_a, g_gn_a, w_out_a,
               w_ada_kv, b_ada_kv, g_kv, w_kv, w_q_b, lam_b, g_subln_b, w_out_b)
    bp, sp = x_prompt.shape[:2]
    bs, ss = x_sample.shape[:2]
    pos_p = jnp.arange(sp, dtype=jnp.float32)
    y_prompt, ret_p, k_p, v_p = run_trunk(x_prompt, c_prompt, pos_p, None, None, None, True, *weights)
    pos_s = PAST_LEN + jnp.arange(ss, dtype=jnp.float32)
    k_past = cache_k.reshape(cache_k.shape[0], cache_k.shape[1], H_B, 2, DH_B)
    y_sample, ret_s, k_s, v_s = run_trunk(x_sample, c_sample, pos_s, state_ret, k_past, cache_v, False, *weights)
    return (y_prompt, y_sample,
            ret_p, k_p.reshape(bp, sp, 2 * H_B, DH_B), v_p,
            ret_s, k_s.reshape(bs, ss, 2 * H_B, DH_B), v_s)
```

```cpp
#include <hip/hip_runtime.h>
#include <cstdio>
#include <cstdint>
namespace pg8 {
#define PG8_LAS __attribute__((address_space(3)))
typedef unsigned short bf16_t;
typedef short bf16x8 __attribute__((ext_vector_type(8)));
typedef float f32x4 __attribute__((ext_vector_type(4)));
typedef unsigned u32x4 __attribute__((ext_vector_type(4)));
constexpr int BM = 256, BK = 64, HALF = 128, HTB = HALF * BK * 2  , STAGE_BYTES = 8 * HTB, NXCD = 8, WGM = 8;

__host__ __device__ __forceinline__ int lds_byte(int r, int c) { const int st = (r >> 4) * 2 + (c >> 5), rr = r & 15, cc = c & 31, ob = rr * 64 + cc * 2; return st * 1024 + (ob ^ (((ob >> 9) & 1) << 5)); }
__host__ __device__ __forceinline__ void stage_rc(int b, int& R, int& C) { const int st = b / 1024, sb = b % 1024, swz = sb ^ (((sb >> 9) & 1) << 5); R = (st >> 1) * 16 + swz / 64; C = (st & 1) * 32 + (swz % 64) / 2; }
__host__ __device__ __forceinline__ int perm32(int rho) { const int n = rho >> 4, i = rho & 15; return 8 * (i >> 2) + 4 * n + (i & 3); }

struct Unit { int pm, pn; };
struct Gemm { const bf16_t* A; const bf16_t* Bt; int M, N, K; };

struct StaticOrder {
    int nM, nN, nwg, G, c;
    __host__ __device__ void init(int M, int N, int G_, int c_) { nM = M / BM; nN = N / BM; nwg = nM * nN; G = G_; c = c_; }
    __host__ __device__ bool next(int i, Unit& u) const {
        const long L = (long)i * G + c; if (L >= nwg) return false;
        int wgid = (int)L; { const int q = nwg / NXCD, r = nwg % NXCD, xcd = wgid % NXCD, off = wgid / NXCD; wgid = (xcd < r ? xcd * (q + 1) : r * (q + 1) + (xcd - r) * q) + off; }
        const int nig = WGM * nN, gid = wgid / nig, fm = gid * WGM, gsz = (nM - fm) < WGM ? (nM - fm) : WGM;
        u.pm = fm + ((wgid % nig) % gsz); u.pn = (wgid % nig) / gsz; return true;
    }
    __device__ __forceinline__ void a_ready(const Unit&) const {}
    __device__ __forceinline__ void done(const Unit&) const {}
};


__device__ __forceinline__ unsigned cvt_pk_bf16(float lo, float hi) { unsigned r; asm volatile("v_cvt_pk_bf16_f32 %0, %1, %2" : "=v"(r) : "v"(lo), "v"(hi)); return r; }
__device__ __forceinline__ u32x4 pack8(const f32x4 a, const f32x4 b) { u32x4 w; w.x = cvt_pk_bf16(a[0], a[1]); w.y = cvt_pk_bf16(a[2], a[3]); w.z = cvt_pk_bf16(b[0], b[1]); w.w = cvt_pk_bf16(b[2], b[3]); return w; }
__device__ __forceinline__ float silu_f(float a) { return a * __builtin_amdgcn_rcpf(1.0f + __builtin_amdgcn_exp2f(-1.4426950408889634f * a)); }
__device__ __forceinline__ f32x4 silu4(const f32x4 a) { f32x4 r; r[0] = silu_f(a[0]); r[1] = silu_f(a[1]); r[2] = silu_f(a[2]); r[3] = silu_f(a[3]); return r; }
__device__ __forceinline__ int pidx_of(int r) { return r < 16384 ? (r & 2047) : 2048 + ((r - 16384) & 31); }

struct EpiBf16 {
    static constexpr bool PERM = true, AFTER_DRAIN = false;
    bf16_t* O; int ldc;
    __device__ __forceinline__ void operator()(const f32x4 (&acc)[2][2][4][2], const Unit& u, int wr, int wc, int fr, int fq) const {
        const int row0 = u.pm * BM + wr * 64 + fr, col0 = u.pn * BM + wc * 32 + 8 * fq;
#pragma unroll
        for (int ai = 0; ai < 2; ++ai)
#pragma unroll
            for (int m = 0; m < 4; ++m) { bf16_t* rowp = O + (size_t)(row0 + ai * HALF + m * 16) * ldc + col0;
#pragma unroll
                for (int bj = 0; bj < 2; ++bj) *(u32x4*)(rowp + bj * HALF) = pack8(acc[ai][bj][m][0], acc[ai][bj][m][1]); }
    }
};
struct EpiSwiglu {
    static constexpr bool PERM = true, AFTER_DRAIN = false;
    bf16_t* U; int ldu;
    __device__ __forceinline__ void operator()(const f32x4 (&acc)[2][2][4][2], const Unit& u, int wr, int wc, int fr, int fq) const {
        const int row0 = u.pm * BM + wr * 64 + fr, col0 = u.pn * HALF + wc * 32 + 8 * fq;
#pragma unroll
        for (int ai = 0; ai < 2; ++ai)
#pragma unroll
            for (int m = 0; m < 4; ++m) { bf16_t* rowp = U + (size_t)(row0 + ai * HALF + m * 16) * ldu + col0;
                const f32x4 v0 = silu4(acc[ai][0][m][0]) * acc[ai][1][m][0], v1 = silu4(acc[ai][0][m][1]) * acc[ai][1][m][1];
                *(u32x4*)rowp = pack8(v0, v1); }
    }
};
__device__ __forceinline__ void rot8(const f32x4* rp, const f32x4 x1a, const f32x4 x1b, const f32x4 x2a, const f32x4 x2b, float sc, f32x4& o1a, f32x4& o1b, f32x4& o2a, f32x4& o2b) {
    const f32x4 c0 = rp[0], c1 = rp[1], c2 = rp[2], c3 = rp[3];
    o1a[0] = (x1a[0] * c0[0] - x2a[0] * c0[1]) * sc; o2a[0] = (x2a[0] * c0[0] + x1a[0] * c0[1]) * sc;
    o1a[1] = (x1a[1] * c0[2] - x2a[1] * c0[3]) * sc; o2a[1] = (x2a[1] * c0[2] + x1a[1] * c0[3]) * sc;
    o1a[2] = (x1a[2] * c1[0] - x2a[2] * c1[1]) * sc; o2a[2] = (x2a[2] * c1[0] + x1a[2] * c1[1]) * sc;
    o1a[3] = (x1a[3] * c1[2] - x2a[3] * c1[3]) * sc; o2a[3] = (x2a[3] * c1[2] + x1a[3] * c1[3]) * sc;
    o1b[0] = (x1b[0] * c2[0] - x2b[0] * c2[1]) * sc; o2b[0] = (x2b[0] * c2[0] + x1b[0] * c2[1]) * sc;
    o1b[1] = (x1b[1] * c2[2] - x2b[1] * c2[3]) * sc; o2b[1] = (x2b[1] * c2[2] + x1b[1] * c2[3]) * sc;
    o1b[2] = (x1b[2] * c3[0] - x2b[2] * c3[1]) * sc; o2b[2] = (x2b[2] * c3[0] + x1b[2] * c3[1]) * sc;
    o1b[3] = (x1b[3] * c3[2] - x2b[3] * c3[3]) * sc; o2b[3] = (x2b[3] * c3[2] + x1b[3] * c3[3]) * sc;
}
struct EpiRetIn {
    static constexpr bool PERM = true, AFTER_DRAIN = false;
    bf16_t *QR, *KR, *VR, *GR; const float* ropeA;
    __device__ __forceinline__ void operator()(const f32x4 (&acc)[2][2][4][2], const Unit& u, int wr, int wc, int fr, int fq) const {
        const int row0 = u.pm * BM + wr * 64 + fr;
        if (u.pn < 8) {
            bf16_t* dst = (u.pn < 4) ? QR : KR; const float sc = (u.pn < 4) ? 1.0f : 0.08838834764831845f;
            const int head = 2 * (u.pn & 3) + (wc >> 1), d0 = 32 * (wc & 1) + 8 * fq;
#pragma unroll
            for (int ai = 0; ai < 2; ++ai)
#pragma unroll
                for (int m = 0; m < 4; ++m) { const int row = row0 + ai * HALF + m * 16; const f32x4* rp = (const f32x4*)(ropeA + ((size_t)pidx_of(row) * 64 + d0) * 2);
                    f32x4 o1a, o1b, o2a, o2b; rot8(rp, acc[ai][0][m][0], acc[ai][0][m][1], acc[ai][1][m][0], acc[ai][1][m][1], sc, o1a, o1b, o2a, o2b);
                    bf16_t* rowp = dst + (size_t)row * 1024 + head * 128 + d0;
                    *(u32x4*)rowp = pack8(o1a, o1b); *(u32x4*)(rowp + 64) = pack8(o2a, o2b); }
        } else if (u.pn < 16) {
            const int col0 = (u.pn - 8) * BM + wc * 32 + 8 * fq;
#pragma unroll
            for (int ai = 0; ai < 2; ++ai)
#pragma unroll
                for (int m = 0; m < 4; ++m) { bf16_t* rowp = VR + (size_t)(row0 + ai * HALF + m * 16) * 2048 + col0;
#pragma unroll
                    for (int bj = 0; bj < 2; ++bj) *(u32x4*)(rowp + bj * HALF) = pack8(acc[ai][bj][m][0], acc[ai][bj][m][1]); }
        } else {
            const int col0 = (u.pn - 16) * BM + wc * 32 + 8 * fq;
#pragma unroll
            for (int ai = 0; ai < 2; ++ai)
#pragma unroll
                for (int m = 0; m < 4; ++m) { bf16_t* rowp = GR + (size_t)(row0 + ai * HALF + m * 16) * 2048 + col0;
#pragma unroll
                    for (int bj = 0; bj < 2; ++bj) *(u32x4*)(rowp + bj * HALF) = pack8(silu4(acc[ai][bj][m][0]), silu4(acc[ai][bj][m][1])); }
        }
    }
};
struct EpiKV {
    static constexpr bool PERM = true, AFTER_DRAIN = false;
    bf16_t *KB, *VB; float *Kp, *Ks, *Vp, *Vs; const float* ropeB;
    __device__ __forceinline__ void operator()(const f32x4 (&acc)[2][2][4][2], const Unit& u, int wr, int wc, int fr, int fq) const {
        const int row0 = u.pm * BM + wr * 64 + fr; const bool samp = u.pm >= 64;
        if (u.pn < 4) {
            const int grp = 4 * u.pn + wc, d0 = 8 * fq; float* ob = samp ? Ks - (size_t)16384 * 1024 : Kp;
#pragma unroll
            for (int ai = 0; ai < 2; ++ai)
#pragma unroll
                for (int m = 0; m < 4; ++m) { const int row = row0 + ai * HALF + m * 16; const f32x4* rp = (const f32x4*)(ropeB + ((size_t)pidx_of(row) * 32 + d0) * 2);
                    f32x4 o1a, o1b, o2a, o2b; rot8(rp, acc[ai][0][m][0], acc[ai][0][m][1], acc[ai][1][m][0], acc[ai][1][m][1], 1.0f, o1a, o1b, o2a, o2b);
                    const size_t off = (size_t)row * 1024 + grp * 64 + d0;
                    *(f32x4*)(ob + off) = o1a; *(f32x4*)(ob + off + 4) = o1b; *(f32x4*)(ob + off + 32) = o2a; *(f32x4*)(ob + off + 36) = o2b;
                    *(u32x4*)(KB + off) = pack8(o1a, o1b); *(u32x4*)(KB + off + 32) = pack8(o2a, o2b); }
        } else {
            const int col0 = (u.pn - 4) * BM + wc * 32 + 8 * fq; float* ob = samp ? Vs - (size_t)16384 * 1024 : Vp;
#pragma unroll
            for (int ai = 0; ai < 2; ++ai)
#pragma unroll
                for (int m = 0; m < 4; ++m) { const size_t off = (size_t)(row0 + ai * HALF + m * 16) * 1024 + col0;
#pragma unroll
                    for (int bj = 0; bj < 2; ++bj) { *(f32x4*)(ob + off + bj * HALF) = acc[ai][bj][m][0]; *(f32x4*)(ob + off + bj * HALF + 4) = acc[ai][bj][m][1];
                        *(u32x4*)(VB + off + bj * HALF) = pack8(acc[ai][bj][m][0], acc[ai][bj][m][1]); } }
        }
    }
};
struct EpiQ {
    static constexpr bool PERM = true, AFTER_DRAIN = false;
    bf16_t* QB; const float* ropeB; float qscale;
    __device__ __forceinline__ void operator()(const f32x4 (&acc)[2][2][4][2], const Unit& u, int wr, int wc, int fr, int fq) const {
        const int row0 = u.pm * BM + wr * 64 + fr; const int grp = 4 * u.pn + wc, d0 = 8 * fq;
#pragma unroll
        for (int ai = 0; ai < 2; ++ai)
#pragma unroll
            for (int m = 0; m < 4; ++m) { const int row = row0 + ai * HALF + m * 16; const f32x4* rp = (const f32x4*)(ropeB + ((size_t)pidx_of(row) * 32 + d0) * 2);
                f32x4 o1a, o1b, o2a, o2b; rot8(rp, acc[ai][0][m][0], acc[ai][0][m][1], acc[ai][1][m][0], acc[ai][1][m][1], qscale, o1a, o1b, o2a, o2b);
                const size_t off = (size_t)row * 1024 + grp * 64 + d0;
                *(u32x4*)(QB + off) = pack8(o1a, o1b); *(u32x4*)(QB + off + 32) = pack8(o2a, o2b); }
    }
};
template <class Epi, class Sched, bool ALIGN_EPI = false, bool SP2 = false>
__device__ __forceinline__ void gemm_phase(PG8_LAS unsigned char* lds, const Gemm g, const Sched& S, const Epi& E) {
    const int tid = threadIdx.x, wid = __builtin_amdgcn_readfirstlane(tid >> 6), lane = tid & 63, wr = wid >> 2, wc = wid & 3, fr = lane & 15, fq = lane >> 4;
    const int K = g.K, nt = K / BK;
    unsigned voffA[2], voffB[2];
#pragma unroll
    for (int i = 0; i < 2; ++i) { int R, C; stage_rc(tid * 16 + i * 8192, R, C); const int Rb = Epi::PERM ? ((R & ~31) + perm32(R & 31)) : R;
        voffA[i] = (unsigned)(R * K + C) * 2u; voffB[i] = (unsigned)(Rb * K + C) * 2u; }
    const size_t kstep = (size_t)(BK * 2);
    const size_t hstep = (size_t)HALF * K * 2;
    const size_t tstep = 2 * hstep;
    const unsigned ldsw = (unsigned)wid * 1024u;
    const int aoff = lds_byte(wr * 64 + fr, fq * 8), boff = lds_byte(wc * 32 + fr, fq * 8);
#define PG8_SA(b, h) (((b) * 2 + (h)) * HTB)
#define PG8_SB(b, h) ((4 + (b) * 2 + (h)) * HTB)
#define PG8_STAGE(bufoff, gbase, voff) do { _Pragma("unroll") for (int _i = 0; _i < 2; ++_i) \
        __builtin_amdgcn_global_load_lds((const unsigned*)((const char*)(gbase) + (voff)[_i]), (PG8_LAS unsigned*)(lds + (bufoff) + ldsw + _i * 8192), 16, 0, 0); } while (0)
#define PG8_LDA(dst, b, h) do { _Pragma("unroll") for (int m = 0; m < 4; ++m) _Pragma("unroll") for (int k = 0; k < 2; ++k) dst[m][k] = *(const PG8_LAS bf16x8*)(lds + PG8_SA(b, h) + aoff + m * 2048 + k * 1024); } while (0)
#define PG8_LDB(dst, b, h) do { _Pragma("unroll") for (int n = 0; n < 2; ++n) _Pragma("unroll") for (int k = 0; k < 2; ++k) dst[n][k] = *(const PG8_LAS bf16x8*)(lds + PG8_SB(b, h) + boff + n * 2048 + k * 1024); } while (0)
#define PG8_MMA(ai, bj, At, Bt) do { __builtin_amdgcn_s_setprio(1); _Pragma("unroll") for (int m = 0; m < 4; ++m) _Pragma("unroll") for (int n = 0; n < 2; ++n) _Pragma("unroll") for (int k = 0; k < 2; ++k) \
        acc[ai][bj][m][n] = __builtin_amdgcn_mfma_f32_16x16x32_bf16(Bt[n][k], At[m][k], acc[ai][bj][m][n], 0, 0, 0); __builtin_amdgcn_s_setprio(0); } while (0)
#define PG8_WAIT_V(n) asm volatile("s_waitcnt vmcnt(" #n ")" ::: "memory")
#define PG8_WAIT_L(n) asm volatile("s_waitcnt lgkmcnt(" #n ")" ::: "memory")
#define PG8_BAR __builtin_amdgcn_s_barrier()
#define PG8_SCHED __builtin_amdgcn_sched_barrier(0)
    Unit cur, nxt; int ui = 0;
    if (!S.next(0, cur)) return;
    f32x4 acc[2][2][4][2];
#pragma unroll
    for (int a = 0; a < 2; ++a)
#pragma unroll
        for (int b = 0; b < 2; ++b)
#pragma unroll
            for (int m = 0; m < 4; ++m)
#pragma unroll
                for (int n = 0; n < 2; ++n) acc[a][b][m][n] = (f32x4){0.f, 0.f, 0.f, 0.f};
    bf16x8 At[4][2], B0[2][2], B1[2][2];
    const char* cA = (const char*)g.A + (size_t)cur.pm * tstep; const char* cB = (const char*)g.Bt + (size_t)cur.pn * tstep;
    S.a_ready(cur);
    if constexpr (SP2) {
        PG8_STAGE(PG8_SB(0, 0), cB, voffB); PG8_STAGE(PG8_SB(0, 1), cB + hstep, voffB); PG8_STAGE(PG8_SA(0, 0), cA, voffA); PG8_STAGE(PG8_SA(0, 1), cA + hstep, voffA);
        if (wr == 1) PG8_BAR;
        PG8_WAIT_V(2); PG8_BAR;
        PG8_STAGE(PG8_SB(1, 0), cB + kstep, voffB); PG8_STAGE(PG8_SA(1, 0), cA + kstep, voffA); PG8_STAGE(PG8_SB(1, 1), cB + hstep + kstep, voffB);
        PG8_WAIT_V(6); PG8_BAR;
    } else {
        PG8_STAGE(PG8_SB(0, 0), cB, voffB); PG8_STAGE(PG8_SA(0, 0), cA, voffA); PG8_STAGE(PG8_SB(0, 1), cB + hstep, voffB); PG8_STAGE(PG8_SA(0, 1), cA + hstep, voffA);
        if (wr == 1) PG8_BAR;
        PG8_WAIT_V(4); PG8_BAR;
        PG8_STAGE(PG8_SB(1, 0), cB + kstep, voffB); PG8_STAGE(PG8_SA(1, 0), cA + kstep, voffA); PG8_STAGE(PG8_SB(1, 1), cB + hstep + kstep, voffB);
        PG8_WAIT_V(6); PG8_BAR;
    }
    for (;;) {
        const bool has_next = S.next(ui + 1, nxt);
        const char* nA = has_next ? (const char*)g.A + (size_t)nxt.pm * tstep : cA; const char* nB = has_next ? (const char*)g.Bt + (size_t)nxt.pn * tstep : cB;
        for (int t = 0; t < nt; t += 2) {
            const bool last = (t == nt - 2);
            const char* a1 = cA + (size_t)(t + 1) * kstep;
            const char* a2 = last ? nA : cA + (size_t)(t + 2) * kstep; const char* b2 = last ? nB : cB + (size_t)(t + 2) * kstep;
            const char* a3 = a2 + kstep; const char* b3 = b2 + kstep;
            if (last && has_next) S.a_ready(nxt);
            if constexpr (SP2) {
            PG8_LDB(B0, 0, 0); PG8_LDB(B1, 0, 1); PG8_SCHED; PG8_LDA(At, 0, 0); PG8_STAGE(PG8_SA(1, 1), a1 + hstep, voffA);
            PG8_WAIT_V(8); PG8_WAIT_L(0); PG8_BAR; PG8_MMA(0, 0, At, B0); PG8_MMA(0, 1, At, B1); PG8_BAR; PG8_SCHED;
            PG8_LDA(At, 0, 1); PG8_STAGE(PG8_SB(0, 0), b2, voffB); PG8_STAGE(PG8_SB(0, 1), b2 + hstep, voffB); PG8_STAGE(PG8_SA(0, 0), a2, voffA);
            PG8_WAIT_V(8); PG8_WAIT_L(0); PG8_BAR; PG8_MMA(1, 0, At, B0); PG8_MMA(1, 1, At, B1); PG8_BAR; PG8_SCHED;
            PG8_LDB(B0, 1, 0); PG8_LDB(B1, 1, 1); PG8_SCHED; PG8_LDA(At, 1, 0); PG8_STAGE(PG8_SA(0, 1), a2 + hstep, voffA);
            PG8_WAIT_V(8); PG8_WAIT_L(0); PG8_BAR; PG8_MMA(0, 0, At, B0); PG8_MMA(0, 1, At, B1); PG8_BAR; PG8_SCHED;
            PG8_LDA(At, 1, 1); PG8_STAGE(PG8_SB(1, 0), b3, voffB); PG8_STAGE(PG8_SB(1, 1), b3 + hstep, voffB); PG8_STAGE(PG8_SA(1, 0), a3, voffA);
            PG8_WAIT_V(8); PG8_WAIT_L(0); PG8_BAR; PG8_MMA(1, 0, At, B0); PG8_MMA(1, 1, At, B1); PG8_BAR; PG8_SCHED;
            } else {
            PG8_LDB(B0, 0, 0); PG8_SCHED; PG8_LDA(At, 0, 0); PG8_STAGE(PG8_SA(1, 1), a1 + hstep, voffA);
            PG8_WAIT_L(8); PG8_BAR; PG8_WAIT_L(0); PG8_MMA(0, 0, At, B0); PG8_BAR; PG8_SCHED;
            PG8_LDB(B1, 0, 1); PG8_STAGE(PG8_SB(0, 0), b2, voffB);
            PG8_BAR; PG8_WAIT_L(0); PG8_MMA(0, 1, At, B1); PG8_BAR;
            PG8_LDA(At, 0, 1); PG8_STAGE(PG8_SA(0, 0), a2, voffA);
            PG8_BAR; PG8_WAIT_L(0); PG8_MMA(1, 0, At, B0); PG8_BAR; PG8_SCHED;
            PG8_STAGE(PG8_SB(0, 1), b2 + hstep, voffB);
            PG8_WAIT_V(6); PG8_BAR; PG8_MMA(1, 1, At, B1); PG8_BAR;
            PG8_LDB(B0, 1, 0); PG8_SCHED; PG8_LDA(At, 1, 0); PG8_STAGE(PG8_SA(0, 1), a2 + hstep, voffA);
            PG8_WAIT_L(8); PG8_BAR; PG8_WAIT_L(0); PG8_MMA(0, 0, At, B0); PG8_BAR; PG8_SCHED;
            PG8_LDB(B1, 1, 1); PG8_STAGE(PG8_SB(1, 0), b3, voffB);
            PG8_BAR; PG8_WAIT_L(0); PG8_MMA(0, 1, At, B1); PG8_BAR;
            PG8_LDA(At, 1, 1); PG8_STAGE(PG8_SA(1, 0), a3, voffA);
            PG8_BAR; PG8_WAIT_L(0); PG8_MMA(1, 0, At, B0); PG8_BAR; PG8_SCHED;
            PG8_STAGE(PG8_SB(1, 1), b3 + hstep, voffB);
            PG8_WAIT_V(6); PG8_BAR; PG8_MMA(1, 1, At, B1); PG8_BAR;
            }
        }
        if constexpr (ALIGN_EPI) { if (wr == 0) PG8_BAR; }
        if constexpr (!Epi::AFTER_DRAIN) { E(acc, cur, wr, wc, fr, fq); S.done(cur); }
        if (!has_next) break;
#pragma unroll
        for (int a = 0; a < 2; ++a)
#pragma unroll
            for (int b = 0; b < 2; ++b)
#pragma unroll
                for (int m = 0; m < 4; ++m)
#pragma unroll
                    for (int n = 0; n < 2; ++n) acc[a][b][m][n] = (f32x4){0.f, 0.f, 0.f, 0.f};
        cur = nxt; cA = nA; cB = nB; ++ui;
        if constexpr (ALIGN_EPI) { if (wr == 1) PG8_BAR; }
    }
    PG8_WAIT_V(0);
    if constexpr (!ALIGN_EPI) { if (wr == 0) PG8_BAR; }
    PG8_BAR;
    if constexpr (Epi::AFTER_DRAIN) { E.fused(acc, cur, wr, wc, fr, fq, lds, wid, lane); S.done(cur); }
#undef PG8_SA
#undef PG8_SB
#undef PG8_STAGE
#undef PG8_LDA
#undef PG8_LDB
#undef PG8_MMA
#undef PG8_WAIT_V
#undef PG8_WAIT_L
#undef PG8_BAR
#undef PG8_SCHED
}
}
#include <hip/hip_bf16.h>
#include <cmath>
namespace attn_body {
using bf16=__hip_bfloat16;
using bf16x8=__attribute__((ext_vector_type(8)))short;
using s16x4=__attribute__((ext_vector_type(4)))short;
using f32x16=__attribute__((ext_vector_type(16)))float;
using u32x4=__attribute__((ext_vector_type(4)))unsigned;
constexpr int BATCH=8,NHEAD=16,SEQ=2048,D=64,DM=NHEAD*D;
constexpr int NW=8,QBLK=32,QB=QBLK*NW,KVBLK=64,NQB=SEQ/QB;
constexpr int ATTN_PITCH=DM, ATTN_UNIT_ROWS=QB;
__device__ __forceinline__ int crow(int r,int hi){return (r&3)+8*(r>>2)+4*hi;}
#define SBAR() __builtin_amdgcn_sched_barrier(0)
__device__ __forceinline__ void cmask(f32x16&p0,f32x16&p1,int jb,int wid){
  const float NEG=-INFINITY;
  if(jb>(wid>>1)){
    #pragma unroll
    for(int r=0;r<16;++r){p0[r]=NEG;p1[r]=NEG;}
  }
}

constexpr int NSLOT=3, SLOTB=8192;
constexpr int LDS_K=0, LDS_V=NSLOT*SLOTB, LDS_WS=2*NSLOT*SLOTB, LDS_OST=LDS_WS+NW*64*4, LDS_BYTES=LDS_OST+NW*4096;
constexpr float C2=0.125f*1.4426950408889634f;
__device__ __forceinline__ void glds16(const void*gsrc,unsigned lds_dst){unsigned keep;
  asm volatile("s_mov_b32 %0, m0\n\ts_mov_b32 m0, %2\n\ts_nop 0\n\tglobal_load_lds_dwordx4 %1, off\n\ts_mov_b32 m0, %0":"=&s"(keep):"v"(gsrc),"s"(lds_dst):"memory");}
__device__ __forceinline__ float max3f(float a,float b,float c){float r;asm("v_max3_f32 %0, %1, %2, %3":"=v"(r):"v"(a),"v"(b),"v"(c));return r;}
__device__ __forceinline__ float max2f(float a,float b){float r;asm("v_max_f32_e32 %0, %1, %2":"=v"(r):"v"(a),"v"(b));return r;}
__device__ __forceinline__ float fadd_s(float a,float b){float r;asm("v_add_f32_e32 %0, %1, %2":"=v"(r):"v"(a),"v"(b));return r;}
__device__ __forceinline__ float fsub_s(float a,float b){float r;asm("v_sub_f32_e32 %0, %1, %2":"=v"(r):"v"(a),"v"(b));return r;}
typedef float f32x2_t __attribute__((ext_vector_type(2))); typedef __bf16 bf16x2_t __attribute__((ext_vector_type(2)));
__device__ __forceinline__ unsigned cvtpk_s(float lo,float hi){f32x2_t v={lo,hi};bf16x2_t b=__builtin_convertvector(v,bf16x2_t);return __builtin_bit_cast(unsigned,b);}
#define WAIT_BAR(N) asm volatile("s_waitcnt vmcnt(" #N ") lgkmcnt(0)\n\ts_barrier":::"memory")

__device__ __forceinline__ void qkt(f32x16&p0,f32x16&p1,const char*Kslot,const bf16x8*qr,const f32x16&negm,int r32,int hi){
  const char*kb=Kslot+hi*1024+r32*16;
  #pragma unroll
  for(int d0=0;d0<4;++d0){
    const bf16x8 b0=*reinterpret_cast<const bf16x8*>(kb+d0*2048);
    const bf16x8 b1=*reinterpret_cast<const bf16x8*>(kb+d0*2048+512);
    if(d0==0){p0=__builtin_amdgcn_mfma_f32_32x32x16_bf16(b0,qr[0],negm,0,0,0);p1=__builtin_amdgcn_mfma_f32_32x32x16_bf16(b1,qr[0],negm,0,0,0);}
    else{p0=__builtin_amdgcn_mfma_f32_32x32x16_bf16(b0,qr[d0],p0,0,0,0);p1=__builtin_amdgcn_mfma_f32_32x32x16_bf16(b1,qr[d0],p1,0,0,0);}}
}
typedef __attribute__((address_space(3))) const char* lds_cptr;
typedef short v4i16_t __attribute__((ext_vector_type(4)));
__device__ __forceinline__ void kload8(bf16x8*kf,lds_cptr kp){
  kf[0]=*(const __attribute__((address_space(3))) bf16x8*)(kp);      kf[1]=*(const __attribute__((address_space(3))) bf16x8*)(kp+512);
  kf[2]=*(const __attribute__((address_space(3))) bf16x8*)(kp+2048); kf[3]=*(const __attribute__((address_space(3))) bf16x8*)(kp+2560);
  kf[4]=*(const __attribute__((address_space(3))) bf16x8*)(kp+4096); kf[5]=*(const __attribute__((address_space(3))) bf16x8*)(kp+4608);
  kf[6]=*(const __attribute__((address_space(3))) bf16x8*)(kp+6144); kf[7]=*(const __attribute__((address_space(3))) bf16x8*)(kp+6656);
}
__device__ __forceinline__ void kload2(bf16x8*kf,lds_cptr kp,int j){ kf[2*j]=*(const __attribute__((address_space(3))) bf16x8*)(kp+j*2048); kf[2*j+1]=*(const __attribute__((address_space(3))) bf16x8*)(kp+j*2048+512); }
__device__ __forceinline__ s16x4 vtr(lds_cptr p){ return __builtin_bit_cast(s16x4,__builtin_amdgcn_ds_read_tr16_b64_v4i16((__attribute__((address_space(3))) v4i16_t*)p)); }
__device__ __forceinline__ float rowmax(const f32x16&p0,const f32x16&p1){
  float a=max3f(p0[0],p0[1],p1[0]),b=max3f(p0[2],p0[3],p1[1]);a=max3f(a,p1[2],p1[3]);
  #pragma unroll
  for(int r=4;r<16;r+=4){a=max3f(a,p0[r],p0[r+1]);b=max3f(b,p0[r+2],p0[r+3]);a=max3f(a,p1[r],p1[r+1]);b=max3f(b,p1[r+2],p1[r+3]);}
  const float m=max2f(a,b);
  auto rr=__builtin_amdgcn_permlane32_swap(__float_as_uint(m),__float_as_uint(m),false,false);
  return max2f(__uint_as_float(rr[0]),__uint_as_float(rr[1]));
}
__device__ __forceinline__ void pv(f32x16*o,int vb,bf16x8 pa0,bf16x8 pa1,bf16x8 pa2,bf16x8 pa3){
  #pragma unroll
  for(int d0=0;d0<2;++d0){s16x4 lo[4],hi[4];
    #pragma unroll
    for(int ks=0;ks<4;++ks){
      asm volatile("ds_read_b64_tr_b16 %0,%1 offset:%c2":"=&v"(lo[ks]):"v"(vb),"i"(d0*4096+ks*1024):"memory");
      asm volatile("ds_read_b64_tr_b16 %0,%1 offset:%c2":"=&v"(hi[ks]):"v"(vb),"i"(d0*4096+ks*1024+512):"memory");}
    asm volatile("s_waitcnt lgkmcnt(0)":::"memory");SBAR();
    #define PK(k) (bf16x8){lo[k][0],lo[k][1],lo[k][2],lo[k][3],hi[k][0],hi[k][1],hi[k][2],hi[k][3]}
    o[d0]=__builtin_amdgcn_mfma_f32_32x32x16_bf16(pa0,PK(0),o[d0],0,0,0);
    o[d0]=__builtin_amdgcn_mfma_f32_32x32x16_bf16(pa1,PK(1),o[d0],0,0,0);
    o[d0]=__builtin_amdgcn_mfma_f32_32x32x16_bf16(pa2,PK(2),o[d0],0,0,0);
    o[d0]=__builtin_amdgcn_mfma_f32_32x32x16_bf16(pa3,PK(3),o[d0],0,0,0);
    #undef PK
  }
}

#ifndef ATTN_STORE16
#define ATTN_STORE16(p,v) (*(u32x4*)(p)=(v))
#endif
template<int THRL> __device__ __forceinline__ void attn_unit(int b,int h,int hv,int qb,const bf16*Q,const bf16*__restrict__ K,const bf16*__restrict__ V,bf16*O,char*shm){
  const int tid=threadIdx.x,lane=tid&63,r32=lane&31,hi=lane>>5; const int wid=__builtin_amdgcn_readfirstlane(tid>>6);
  const long rowbase=(long)b*SEQ; const int q0=qb*QB;
  const bf16*Qw=Q+(rowbase+q0+wid*QBLK)*DM+h*D;
  const bf16*Kh=K+rowbase*DM+h*D,*Vh=V+rowbase*DM+hv*D;
  const unsigned lds0=(unsigned)(uintptr_t)shm;
  float*wsf=(float*)(shm+LDS_WS)+wid*64;
  const bf16*ksrc=Kh+(long)lane*DM+wid*8;
  const bf16*vsrc=Vh+(long)(16*(wid&3)+(lane>>2))*DM+(wid>>2)*32+(lane&3)*8;
  const unsigned kdst=lds0+LDS_K+wid*1024, vdst=lds0+LDS_V+wid*1024;
  #define DMA_K(t,slot) glds16(ksrc+(long)(t)*KVBLK*DM,(unsigned)__builtin_amdgcn_readfirstlane(kdst+(slot)))
  #define DMA_V(t,slot) glds16(vsrc+(long)(t)*KVBLK*DM,(unsigned)__builtin_amdgcn_readfirstlane(vdst+(slot)))
  const int vb0=(int)(lds0+LDS_V)+((lane>>4)&1)*32+(lane&3)*8+(4*hi+((lane&15)>>2))*64;
  const char*Kbase=shm+LDS_K; bf16x8 kf[8];
  const lds_cptr shm3=(lds_cptr)shm; const lds_cptr kp0=shm3+LDS_K+hi*1024+r32*16; const lds_cptr vp0=shm3+LDS_V+((lane>>4)&1)*32+(lane&3)*8+(4*hi+((lane&15)>>2))*64;
  const int NT=(q0+QB)/KVBLK;
  DMA_K(0,0);DMA_V(0,0);DMA_K(1,SLOTB);
  bf16x8 qr[4];
  #pragma unroll
  for(int d0=0;d0<4;++d0)qr[d0]=*reinterpret_cast<const bf16x8*>(&Qw[(long)r32*DM+d0*16+hi*8]);
  float mhat=0.f,l_reg=0.f;f32x16 o[2];o[0]=f32x16{};o[1]=f32x16{};f32x16 negm=f32x16{};asm volatile("":"+v"(negm));

  #define CMASK(P0,P1,t) do{int jb_=(t)-(NT-4); if(jb_>=0)cmask(P0,P1,jb_,wid);}while(0)
  bool resc=false;
  #define START(P0,P1) do{ const float rm=rowmax(P0,P1); resc=false; \
    { const float dl=rm; mhat=fadd_s(mhat,dl); \
      _Pragma("unroll") for(int r=0;r<16;++r){P0[r]=fsub_s(P0[r],dl);P1[r]=fsub_s(P1[r],dl);} \
      _Pragma("unroll") for(int r=0;r<16;++r)negm[r]=-mhat; asm volatile("":"+v"(negm)); } \
    _Pragma("unroll") for(int r=0;r<16;++r)P0[r]=__builtin_amdgcn_exp2f(P0[r]); }while(0)
  #define RESC() do{ if(resc){ asm volatile("s_waitcnt lgkmcnt(0)":::"memory"); \
      _Pragma("unroll") for(int d_=0;d_<2;++d_) _Pragma("unroll") for(int r=0;r<16;++r)o[d_][r]*=wsf[crow(r,hi)]; } }while(0)
  f32x16 pA0,pA1,pB0,pB1;
  int sl_prev=0,sl_cur=0,sl_next=SLOTB;
  #define ROT() do{sl_prev=sl_cur;sl_cur=sl_next;sl_next=(sl_next==(NSLOT-1)*SLOTB)?0:sl_next+SLOTB;}while(0)
  DMA_K(2,2*SLOTB);
  WAIT_BAR(3);
  qkt(pA0,pA1,Kbase,qr,negm,r32,hi);asm volatile("s_nop 15\n\ts_nop 7":"+v"(pA0),"+v"(pA1));CMASK(pA0,pA1,0);
  START(pA0,pA1);
  _Pragma("unroll") for(int r=0;r<16;++r)pA1[r]=__builtin_amdgcn_exp2f(pA1[r]);
  WAIT_BAR(0);
  DMA_K(3,0);DMA_V(1,SLOTB);
  ROT();
  kload8(kf,kp0+sl_cur);
  WAIT_BAR(2);
  s16x4 vlo[8],vhi[8]; u32x4 pw0,pw1,pw2,pw3;
  #define PKW(P,B) cvtpk_s(P[B],P[B+1])
  #define PAF(k) __builtin_bit_cast(bf16x8,pw##k)
  #define VFR(i) (bf16x8){vlo[i][0],vlo[i][1],vlo[i][2],vlo[i][3],vhi[i][0],vhi[i][1],vhi[i][2],vhi[i][3]}
  #define PIN(x) asm volatile("":"+v"(x))
  #define MX3(a,b,c) __builtin_fmaxf(__builtin_fmaxf((a),(b)),(c))
  #define GAPA(MF,A0,A1,A2,A3,W0,W1,PW) do{ MF; sacc+=A0; sacc+=A1; sacc+=A2; sacc+=A3; PIN(sacc); W0; W1; PIN(PW); SBAR(); }while(0)
  #define EX(v) __builtin_amdgcn_exp2f(v)
  #define GAPB(MF,X,B) do{ MF; X[B]=EX(X[B]); X[B+1]=EX(X[B+1]); X[B+2]=EX(X[B+2]); X[B+3]=EX(X[B+3]); PIN(X); SBAR(); }while(0)
  #define VRD(i) do{ vlo[i]=vtr(vp_+(((i)>>2)*4096+((i)&3)*1024)); vhi[i]=vtr(vp_+(((i)>>2)*4096+((i)&3)*1024+512)); }while(0)
  #define KRD(G,j) do{ if(G){ kload2(kf,kp0+sl_next,j); SBAR(); } }while(0)
  #define STEP(C0,C1,P0,P1,t,GK,GV,GL) do{ SBAR(); \
    const lds_cptr vp_=vp0+sl_prev; \
    VRD(0); SBAR(); float sacc=(P0[0]+P0[1]); \
    GAPA(C0=__builtin_amdgcn_mfma_f32_32x32x16_bf16(kf[0],qr[0],negm,0,0,0), P0[2],P0[3],P0[4],P0[5],     pw0[0]=PKW(P0,0), pw0[1]=PKW(P0,2), pw0); \
    VRD(4); SBAR(); GAPA(C1=__builtin_amdgcn_mfma_f32_32x32x16_bf16(kf[1],qr[0],negm,0,0,0), P0[6],P0[7],P0[8],P0[9],     pw0[2]=PKW(P0,4), pw0[3]=PKW(P0,6), pw0); \
    VRD(1); SBAR(); GAPA(C0=__builtin_amdgcn_mfma_f32_32x32x16_bf16(kf[2],qr[1],C0,0,0,0),   P0[10],P0[11],P0[12],P0[13], pw1[0]=PKW(P0,8), pw1[1]=PKW(P0,10), pw1); \
    VRD(5); SBAR(); GAPA(C1=__builtin_amdgcn_mfma_f32_32x32x16_bf16(kf[3],qr[1],C1,0,0,0),   P0[14],P0[15],P1[0],P1[1],   pw1[2]=PKW(P0,12),pw1[3]=PKW(P0,14), pw1); \
    VRD(2); SBAR(); GAPA(C0=__builtin_amdgcn_mfma_f32_32x32x16_bf16(kf[4],qr[2],C0,0,0,0),   P1[2],P1[3],P1[4],P1[5],     pw2[0]=PKW(P1,0), pw2[1]=PKW(P1,2), pw2); \
    VRD(6); SBAR(); GAPA(C1=__builtin_amdgcn_mfma_f32_32x32x16_bf16(kf[5],qr[2],C1,0,0,0),   P1[6],P1[7],P1[8],P1[9],     pw2[2]=PKW(P1,4), pw2[3]=PKW(P1,6), pw2); \
    VRD(3); SBAR(); GAPA(C0=__builtin_amdgcn_mfma_f32_32x32x16_bf16(kf[6],qr[3],C0,0,0,0),   P1[10],P1[11],P1[12],P1[13], pw3[0]=PKW(P1,8), pw3[1]=PKW(P1,10), pw3); \
    VRD(7); SBAR(); GAPA(C1=__builtin_amdgcn_mfma_f32_32x32x16_bf16(kf[7],qr[3],C1,0,0,0),   P1[14],P1[15],0.f,0.f,       pw3[2]=PKW(P1,12),pw3[3]=PKW(P1,14), pw3); \
    l_reg+=sacc; \
    if(GK){DMA_K((t)+3,sl_cur);} if(GV){DMA_V((t)+1,sl_next);} \
    CMASK(C0,C1,t); \
    { float a=MX3(C0[0],C0[1],C1[0]),b=MX3(C0[2],C0[3],C1[1]); a=MX3(a,C1[2],C1[3]); \
      _Pragma("unroll") for(int r=4;r<16;r+=4){a=MX3(a,C0[r],C0[r+1]);b=MX3(b,C0[r+2],C0[r+3]);a=MX3(a,C1[r],C1[r+1]);b=MX3(b,C1[r+2],C1[r+3]);} \
      float rm=__builtin_fmaxf(a,b); { auto rr=__builtin_amdgcn_permlane32_swap(__float_as_uint(rm),__float_as_uint(rm),false,false); rm=__builtin_fmaxf(__uint_as_float(rr[0]),__uint_as_float(rr[1])); } \
      resc=false; \
      if(__builtin_expect(__any(rm>(float)THRL),0)){ const float dl=__builtin_fmaxf(rm,0.f); mhat+=dl; \
        _Pragma("unroll") for(int r=0;r<16;++r){C0[r]-=dl;C1[r]-=dl;} \
        _Pragma("unroll") for(int r=0;r<16;++r)negm[r]=-mhat; asm volatile("":"+v"(negm)); \
        const float f=__builtin_amdgcn_exp2f(-dl); l_reg*=f; if(hi==0)wsf[r32]=f; resc=true; } } \
    SBAR(); \
    GAPB(o[0]=__builtin_amdgcn_mfma_f32_32x32x16_bf16(PAF(0),VFR(0),o[0],0,0,0), C0,0); \
    GAPB(o[1]=__builtin_amdgcn_mfma_f32_32x32x16_bf16(PAF(0),VFR(4),o[1],0,0,0), C0,4); \
    KRD(GL,0); GAPB(o[0]=__builtin_amdgcn_mfma_f32_32x32x16_bf16(PAF(1),VFR(1),o[0],0,0,0), C0,8); \
    KRD(GL,1); GAPB(o[1]=__builtin_amdgcn_mfma_f32_32x32x16_bf16(PAF(1),VFR(5),o[1],0,0,0), C0,12); \
    KRD(GL,2); GAPB(o[0]=__builtin_amdgcn_mfma_f32_32x32x16_bf16(PAF(2),VFR(2),o[0],0,0,0), C1,0); \
    KRD(GL,3); GAPB(o[1]=__builtin_amdgcn_mfma_f32_32x32x16_bf16(PAF(2),VFR(6),o[1],0,0,0), C1,4); \
    GAPB(o[0]=__builtin_amdgcn_mfma_f32_32x32x16_bf16(PAF(3),VFR(3),o[0],0,0,0), C1,8); \
    GAPB(o[1]=__builtin_amdgcn_mfma_f32_32x32x16_bf16(PAF(3),VFR(7),o[1],0,0,0), C1,12); \
    }while(0)
  int t=1;
  #undef CMASK
  #define CMASK(P0,P1,t) do{}while(0)
  for(;t+5<NT;t+=2){
    STEP(pB0,pB1,pA0,pA1,t,true,true,true);     WAIT_BAR(2); RESC(); ROT();
    STEP(pA0,pA1,pB0,pB1,t+1,true,true,true);   WAIT_BAR(2); RESC(); ROT();
  }
  #undef CMASK
  #define CMASK(P0,P1,t) do{int jb_=(t)-(NT-4); if(jb_>=0)cmask(P0,P1,jb_,wid);}while(0)
  #define ENDW(tt) do{ if((tt)+3<NT){WAIT_BAR(2);} else if((tt)+2<NT){WAIT_BAR(1);} else {WAIT_BAR(0);} }while(0)
  for(;t+1<NT;t+=2){
    STEP(pB0,pB1,pA0,pA1,t,(t+3<NT),(t+1<NT),(t+1<NT));       ENDW(t);   RESC(); ROT();
    STEP(pA0,pA1,pB0,pB1,t+1,(t+4<NT),(t+2<NT),(t+2<NT));     ENDW(t+1); RESC(); ROT();
  }
  STEP(pB0,pB1,pA0,pA1,NT-1,false,false,false); RESC();
  { float sacc=pB0[0]+pB0[1]; _Pragma("unroll") for(int r=2;r<16;++r)sacc+=pB0[r]; _Pragma("unroll") for(int r=0;r<16;++r)sacc+=pB1[r]; l_reg+=sacc;
    pw0=(u32x4){PKW(pB0,0),PKW(pB0,2),PKW(pB0,4),PKW(pB0,6)};pw1=(u32x4){PKW(pB0,8),PKW(pB0,10),PKW(pB0,12),PKW(pB0,14)};pw2=(u32x4){PKW(pB1,0),PKW(pB1,2),PKW(pB1,4),PKW(pB1,6)};pw3=(u32x4){PKW(pB1,8),PKW(pB1,10),PKW(pB1,12),PKW(pB1,14)};
    SBAR(); pv(o,vb0+sl_cur,PAF(0),PAF(1),PAF(2),PAF(3)); }
  #undef PKW
  #undef PAF
  #undef VFR
  #undef PIN
  #undef MX3
  #undef GAPA
  #undef GAPB
  #undef EX
  #undef VRD
  #undef KRD
  #undef STEP
  #undef ENDW
  {auto rr=__builtin_amdgcn_permlane32_swap(__float_as_uint(l_reg),__float_as_uint(l_reg),false,false);l_reg=__uint_as_float(rr[0])+__uint_as_float(rr[1]);}
  if(hi==0)wsf[32+r32]=l_reg;asm volatile("s_waitcnt lgkmcnt(0)":::"memory");
  float rli[16];
  #pragma unroll
  for(int r=0;r<16;++r)rli[r]=__builtin_amdgcn_rcpf(wsf[32+crow(r,hi)]);
  bf16*Ow=O+(rowbase+q0+wid*QBLK)*DM+hv*D;
  { bf16*stg=(bf16*)(shm+LDS_OST)+wid*2048;
    #pragma unroll
    for(int r=0;r<16;++r){const int orow=crow(r,hi);
      #pragma unroll
      for(int d0=0;d0<2;++d0)stg[orow*64+d0*32+r32]=__float2bfloat16(o[d0][r]*rli[r]);}
    asm volatile("s_waitcnt lgkmcnt(0)":::"memory");
    #pragma unroll
    for(int i=0;i<4;++i){const int row=i*8+(lane>>3),ch=lane&7; const u32x4 v=*(const u32x4*)(stg+row*64+ch*8); ATTN_STORE16(Ow+(long)row*DM+ch*8,v);} }
  asm volatile("s_waitcnt lgkmcnt(0)\n\ts_barrier":::"memory");
  #undef DMA_K
  #undef DMA_V
  #undef CMASK
  #undef START
  #undef RESC
  #undef ROT
}
constexpr int ATTN_LDS_BYTES=LDS_BYTES;
struct AttnTensors { const bf16* Q; const bf16* K; const bf16* V; bf16* O0; bf16* O1; };
struct AttnUnit { int combo; int qb; };
struct StaticOrder {
  int vcu, G;
  __device__ __forceinline__ explicit StaticOrder(int grid,int vcu_):vcu(vcu_),G(grid){}
  __device__ __forceinline__ bool next(int i,AttnUnit&u)const{ const int c=vcu+(i>>3)*G; if(c>=BATCH*NHEAD*2)return false; u.combo=c; u.qb=7-(i&7); return true; }
  __device__ __forceinline__ void a_ready(const AttnUnit&)const{}
  __device__ __forceinline__ void done(const AttnUnit&)const{}
};
template<class Sched,int THRL=8> __device__ __forceinline__ void attn_phase(char*lds,const AttnTensors&T,const Sched&S){
  AttnUnit u;
  for(int i=0;S.next(i,u);++i){ S.a_ready(u); const int b=u.combo>>5, hq=(u.combo>>1)&15, vh=u.combo&1; attn_unit<THRL>(b,hq,(hq&~1)+vh,u.qb,T.Q,T.K,T.V,(hq&1)?T.O1:T.O0,lds); S.done(u); }
}
#undef SBAR
#undef WAIT_BAR
}
#define GAS __attribute__((address_space(1)))
#define LAS __attribute__((address_space(3)))
typedef unsigned short bf16;
typedef unsigned v4u __attribute__((ext_vector_type(4)));
typedef float f32x4 __attribute__((ext_vector_type(4)));
typedef short bf16x8 __attribute__((ext_vector_type(8)));
typedef GAS unsigned gu32;
typedef GAS unsigned long long gu64;
#define RLX_AGENT __ATOMIC_RELAXED, __HIP_MEMORY_SCOPE_AGENT
#define LDS_WAIT() asm volatile("s_waitcnt lgkmcnt(0)" ::: "memory")
#define VM_WAIT() asm volatile("s_waitcnt vmcnt(0)" ::: "memory")
__device__ __forceinline__ unsigned long long rt() { return __builtin_amdgcn_s_memrealtime(); }
__device__ __forceinline__ unsigned f2bf(float f) { unsigned u = __builtin_bit_cast(unsigned, f); return (u + 0x7fffu + ((u >> 16) & 1u)) >> 16; }
__device__ __forceinline__ unsigned pk2(float lo, float hi) { return f2bf(lo) | (f2bf(hi) << 16); }

#define XB_TMO      128
#define XB_XCNT(j)  (256  + 64 * (j))
#define XB_XSUB(j)  (1280 + 64 * (j))
#define XB_XGEN(j)  (2304 + 64 * (j))
#define XB_TOP      3328
#define XB_TOPGEN   3392
#define XCD_BAR_WORDS 3456
#define XB_SPIN_CAP (1u << 18)

__device__ __forceinline__ unsigned xb_ld(unsigned* p)              { return __hip_atomic_load(p, __ATOMIC_RELAXED, __HIP_MEMORY_SCOPE_AGENT); }
__device__ __forceinline__ unsigned xb_add(unsigned* p, unsigned v) { return __hip_atomic_fetch_add(p, v, __ATOMIC_RELAXED, __HIP_MEMORY_SCOPE_AGENT); }
__device__ __forceinline__ unsigned xb_xcc_id() { return (unsigned)__builtin_amdgcn_s_getreg((3 << 11) | 20) & 0xFu; }
#define XB_SPIN(cond, bar) do { unsigned _sp = 0; while (cond) { __builtin_amdgcn_s_sleep(1); \
    if ((++_sp & 255u) == 0u) { if (xb_ld(&(bar)[XB_TMO])) break; if (_sp > XB_SPIN_CAP) { atomicAdd(&(bar)[XB_TMO], 1u); break; } } } } while (0)

struct XcdBarrier {
    unsigned* bar; unsigned x;
    volatile LAS unsigned* st;
};

__device__ __forceinline__ XcdBarrier xcd_barrier_post(unsigned* bar, volatile LAS unsigned* st) {
    XcdBarrier b; b.bar = bar; b.x = xb_xcc_id(); b.st = st;
    if (threadIdx.x == 0) (void)xb_add(&bar[XB_XCNT(b.x)], 1u);
    return b;
}
__device__ __forceinline__ void xcd_barrier_complete(unsigned* bar, unsigned x, unsigned& nloc, unsigned& nx) {
    const unsigned G = gridDim.x * gridDim.y * gridDim.z;
    unsigned sum, cnt, mine, sp = 0u;
    for (;;) {
        sum = 0u; cnt = 0u; mine = 0u;
#pragma unroll
        for (unsigned j = 0; j < 16; ++j) { const unsigned c = xb_ld(&bar[XB_XCNT(j)]); sum += c; cnt += (c > 0u) ? 1u : 0u; mine = (j == x) ? c : mine; }
        if (sum == G) break;
        __builtin_amdgcn_s_sleep(1);
        if ((++sp & 255u) == 0u) { if (xb_ld(&bar[XB_TMO])) break; if (sp > XB_SPIN_CAP) { atomicAdd(&bar[XB_TMO], 1u); break; } }
    }
    nloc = mine > 0u ? mine : 1u; nx = cnt > 0u ? cnt : 1u;
}

__device__ __forceinline__ void xcd_barrier(const XcdBarrier& b) {
    asm volatile("s_waitcnt vmcnt(0)" ::: "memory");
    __syncthreads();
    if (threadIdx.x == 0) {
        unsigned* bar = b.bar;
        __builtin_amdgcn_s_waitcnt(0);
        unsigned nloc = b.st[0], nx = b.st[1];
        if (nloc == 0u) { xcd_barrier_complete(bar, b.x, nloc, nx); b.st[0] = nloc; b.st[1] = nx; }
        const unsigned old = xb_add(&bar[XB_XSUB(b.x)], 1u);
        const unsigned gen = old / nloc;
        if (old + 1u == (gen + 1u) * nloc) {
            __builtin_amdgcn_fence(__ATOMIC_RELEASE, "agent");
            asm volatile("s_waitcnt vmcnt(0)" ::: "memory");
            const unsigned og = xb_add(&bar[XB_TOP], 1u);
            const unsigned tg = og / nx;
            if (og + 1u == (tg + 1u) * nx) xb_add(&bar[XB_TOPGEN], 1u);
            else XB_SPIN(xb_ld(&bar[XB_TOPGEN]) == tg, bar);
            __builtin_amdgcn_fence(__ATOMIC_ACQUIRE, "agent");
            xb_add(&bar[XB_XGEN(b.x)], 1u);
            asm volatile("s_waitcnt vmcnt(0)" ::: "memory");
        } else {
            XB_SPIN(xb_ld(&bar[XB_XGEN(b.x)]) == gen, bar);
            __builtin_amdgcn_fence(__ATOMIC_ACQUIRE, "agent");
            asm volatile("s_waitcnt vmcnt(0)" ::: "memory");
        }
    }
    __syncthreads();
}

constexpr int NWAVES = 8;
constexpr int D = 1024, MP = 16384, MS = 1024, M = MP + MS;
constexpr int NSEQ = 40;
constexpr int DFF = 2816, AIN = 6144, NMODC = 20480;
constexpr int NPOS = 2080;
constexpr float EPS = 1e-6f;
constexpr float LAM_INIT = 0.35550906759096934f;
constexpr float QSCALE = 0.125f * 1.4426950408889634f;

constexpr size_t MiB = 1u << 20;
constexpr size_t WS_CTL = 0;
constexpr size_t WS_MOD = 1 * MiB;
constexpr size_t ZERO_BYTES = WS_MOD + (size_t)NSEQ * NMODC * 4;
constexpr size_t WS_ROPEA = 5 * MiB, WS_ROPEB = 7 * MiB;
constexpr size_t WS_WFI = 8 * MiB;
constexpr size_t SZ_WFI = (size_t)5632 * 1024 * 2;
constexpr size_t WS_WFO = WS_WFI + 4 * SZ_WFI;
constexpr size_t SZ_WFO = (size_t)1024 * 2816 * 2;
constexpr size_t WS_WIA = WS_WFO + 4 * SZ_WFO;
constexpr size_t WS_WOA = WS_WIA + (size_t)6144 * 1024 * 2;
constexpr size_t WS_WKV = WS_WOA + (size_t)1024 * 2048 * 2;
constexpr size_t WS_WQB = WS_WKV + (size_t)2048 * 1024 * 2;
constexpr size_t WS_WOB = WS_WQB + (size_t)1024 * 1024 * 2;
constexpr size_t WS_ACT = 128 * MiB;
constexpr size_t SZ_A1 = (size_t)M * 1024 * 2, SZ_A2 = (size_t)M * 2048 * 2, SZ_U = (size_t)M * 2816 * 2;
constexpr size_t WS_H = WS_ACT, WS_HKV = WS_H + SZ_A1, WS_Y = WS_HKV + SZ_A1, WS_U = WS_Y + SZ_A1;
constexpr size_t WS_QR = WS_U + SZ_U, WS_KR = WS_QR + SZ_A1, WS_VR = WS_KR + SZ_A1, WS_GR = WS_VR + SZ_A2, WS_OR = WS_GR + SZ_A2, WS_AR = WS_OR + SZ_A2;
constexpr size_t WS_KB = WS_AR + SZ_A2, WS_VB = WS_KB + SZ_A1, WS_QB = WS_VB + SZ_A1, WS_O0 = WS_QB + SZ_A1, WS_O1 = WS_O0 + SZ_A1, WS_AB = WS_O1 + SZ_A1;
constexpr size_t WS_END = WS_AB + SZ_A1;
static_assert(WS_WOB + (size_t)1024 * 1024 * 2 <= WS_ACT && ZERO_BYTES <= WS_ROPEA && WS_ROPEA + (size_t)NPOS * 64 * 8 <= WS_ROPEB && WS_ROPEB + (size_t)NPOS * 32 * 8 <= WS_WFI, "d_ws map");
constexpr size_t OUT_Y = 0, OUT_SRP = (size_t)M * 1024, OUT_KP = OUT_SRP + (size_t)8 * 8 * 128 * 256, OUT_VP = OUT_KP + (size_t)MP * 1024, OUT_SRS = OUT_VP + (size_t)MP * 1024,
                 OUT_KS = OUT_SRS + (size_t)32 * 8 * 128 * 256, OUT_VS = OUT_KS + (size_t)MS * 1024, OUT_END = OUT_VS + (size_t)MS * 1024;
static_assert(OUT_END == 63963136, "d_out map");
constexpr int CW_BAR = 4096;

constexpr int RING_OFF = 0, RING_BYTES = 131072;
constexpr int LDSCTL_OFF = RING_BYTES, MISC_OFF = LDSCTL_OFF + 320;
constexpr int LDS_BYTES = 147456;
static_assert(MISC_OFF + 128 <= LDS_BYTES, "LDS map");

static __device__ const double INVF[64] = {
 1.0, 0.8659643233600653, 0.7498942093324559, 0.6493816315762113, 0.5623413251903491, 0.4869675251658631, 0.4216965034285822, 0.3651741272548377, 0.31622776601683794, 0.27384196342643613, 0.23713737056616552, 0.2053525026457146, 0.1778279410038923, 0.1539926526059492, 0.1333521432163324, 0.11547819846894582,
 0.1, 0.08659643233600653, 0.07498942093324558, 0.06493816315762113, 0.05623413251903491, 0.04869675251658631, 0.042169650342858224, 0.03651741272548377, 0.03162277660168379, 0.027384196342643614, 0.023713737056616554, 0.02053525026457146, 0.01778279410038923, 0.01539926526059492, 0.01333521432163324, 0.011547819846894581,
 0.01, 0.008659643233600654, 0.007498942093324558, 0.006493816315762113, 0.005623413251903491, 0.004869675251658631, 0.004216965034285823, 0.003651741272548377, 0.0031622776601683794, 0.0027384196342643613, 0.0023713737056616554, 0.002053525026457146, 0.0017782794100389228, 0.001539926526059492, 0.001333521432163324, 0.0011547819846894581,
 0.001, 0.0008659643233600654, 0.0007498942093324559, 0.0006493816315762113, 0.0005623413251903491, 0.0004869675251658631, 0.00042169650342858224, 0.0003651741272548377, 0.00031622776601683794, 0.0002738419634264361, 0.00023713737056616554, 0.0002053525026457146, 0.00017782794100389227, 0.0001539926526059492, 0.0001333521432163324, 0.00011547819846894582 };
__device__ __forceinline__ float lg2gamma(int h) {
    switch (h) { case 0: return -0.04580368961312479f; case 1: return -0.02272007650008353f; case 2: return -0.011315313227834146f; case 3: return -0.005646563141142063f;
                 case 4: return -0.0028205190623786626f; case 5: return -0.0014095702546713536f; case 6: return -0.0007046129765893727f; default: return -0.0003522634716290214f; }
}
__device__ __forceinline__ float bf2f(unsigned short b) { return __builtin_bit_cast(float, (unsigned)b << 16); }
__device__ __forceinline__ float wave_sum(float v) {
#pragma unroll
    for (int o = 1; o < 64; o <<= 1) v += __shfl_xor(v, o);
    return v;
}
__device__ __forceinline__ void unpack8(const v4u w, float (&f)[8]) {
    f[0] = __builtin_bit_cast(float, w.x << 16); f[1] = __builtin_bit_cast(float, w.x & 0xffff0000u); f[2] = __builtin_bit_cast(float, w.y << 16); f[3] = __builtin_bit_cast(float, w.y & 0xffff0000u);
    f[4] = __builtin_bit_cast(float, w.z << 16); f[5] = __builtin_bit_cast(float, w.z & 0xffff0000u); f[6] = __builtin_bit_cast(float, w.w << 16); f[7] = __builtin_bit_cast(float, w.w & 0xffff0000u);
}
__device__ __forceinline__ v4u pack8f(const float (&f)[8]) { v4u o; o.x = pk2(f[0], f[1]); o.y = pk2(f[2], f[3]); o.z = pk2(f[4], f[5]); o.w = pk2(f[6], f[7]); return o; }
__device__ __forceinline__ void ld8(const float* p, float (&f)[8]) { const f32x4 a = *(const GAS f32x4*)p, b = *(const GAS f32x4*)(p + 4); f[0] = a[0]; f[1] = a[1]; f[2] = a[2]; f[3] = a[3]; f[4] = b[0]; f[5] = b[1]; f[6] = b[2]; f[7] = b[3]; }
__device__ __forceinline__ void st8(float* p, const float (&f)[8]) { *(GAS f32x4*)p = (f32x4){f[0], f[1], f[2], f[3]}; *(GAS f32x4*)(p + 4) = (f32x4){f[4], f[5], f[6], f[7]}; }

__device__ __forceinline__ void p0_transpose_item(const float* W, int K, int Nsrc, bf16* WT, int k0, int sc0, int dr0, LAS float* scr, int lane) {
#pragma unroll 8
    for (int i = 0; i < 32; ++i) { const int kk = 2 * i + (lane >> 5); scr[kk * 33 + (lane & 31)] = W[(size_t)(k0 + kk) * Nsrc + sc0 + (lane & 31)]; }
    LDS_WAIT(); asm volatile("" ::: "memory");
    const int c = lane & 7;
#pragma unroll
    for (int j = 0; j < 4; ++j) { const int n = (lane >> 3) + 8 * j; const LAS float* s = scr + (8 * c) * 33 + n;
        v4u o; o.x = pk2(s[0 * 33], s[1 * 33]); o.y = pk2(s[2 * 33], s[3 * 33]); o.z = pk2(s[4 * 33], s[5 * 33]); o.w = pk2(s[6 * 33], s[7 * 33]);
        *(GAS v4u*)(WT + (size_t)(dr0 + n) * K + k0 + 8 * c) = o; }
    LDS_WAIT(); asm volatile("" ::: "memory");
}
struct P0Args { const float *c_p, *c_s, *w_ada, *b_ada, *w_ffn_in, *w_ffn_out, *w_in_a, *w_out_a, *w_ada_kv, *b_ada_kv, *w_kv, *w_q_b, *w_out_b; unsigned char* ws; };
__device__ __forceinline__ void p0_prologue(const P0Args& A, LAS unsigned char* lds, int gw, int NGW, int lane, int wave) {
    LAS float* scr = (LAS float*)(lds + RING_OFF + wave * 16384);
    constexpr int I_FI = 16 * 176, I_FO = 44 * 32, I_IA = 16 * 192, I_OA = 32 * 32, I_KV = 16 * 64, I_QB = 16 * 32, I_OB = 16 * 32;
    constexpr int NITEMS = 4 * I_FI + 4 * I_FO + I_IA + I_OA + I_KV + I_QB + I_OB;
    for (int it = gw; it < NITEMS; it += NGW) {
        int r = it;
        if (r < 4 * I_FI) { const int mi = r / I_FI; r -= mi * I_FI; const int kb = r / 176, nb = r % 176, n0 = 32 * nb;
            const int pn = n0 >> 8, bj = (n0 >> 7) & 1, i0 = n0 & 127;
            p0_transpose_item(A.w_ffn_in + (size_t)mi * 1024 * 5632, 1024, 5632, (bf16*)(A.ws + WS_WFI + mi * SZ_WFI), 64 * kb, bj * 2816 + 128 * pn + i0, n0, scr, lane); continue; }
        r -= 4 * I_FI;
        if (r < 4 * I_FO) { const int mi = r / I_FO; r -= mi * I_FO; const int kb = r / 32, nb = r % 32;
            p0_transpose_item(A.w_ffn_out + (size_t)mi * 2816 * 1024, 2816, 1024, (bf16*)(A.ws + WS_WFO + mi * SZ_WFO), 64 * kb, 32 * nb, 32 * nb, scr, lane); continue; }
        r -= 4 * I_FO;
        if (r < I_IA) { const int kb = r / 192, nb = r % 192, n0 = 32 * nb; int sc0 = n0;
            if (n0 < 2048) { const int sec = n0 >> 10, pn4 = (n0 >> 8) & 3, bj = (n0 >> 7) & 1, hh = (n0 >> 6) & 1, d = n0 & 63;
                sc0 = sec * 1024 + (2 * pn4 + hh) * 128 + d + 64 * bj; }
            p0_transpose_item(A.w_in_a, 1024, 6144, (bf16*)(A.ws + WS_WIA), 64 * kb, sc0, n0, scr, lane); continue; }
        r -= I_IA;
        if (r < I_OA) { const int kb = r / 32, nb = r % 32; p0_transpose_item(A.w_out_a, 2048, 1024, (bf16*)(A.ws + WS_WOA), 64 * kb, 32 * nb, 32 * nb, scr, lane); continue; }
        r -= I_OA;
        if (r < I_KV) { const int kb = r / 64, nb = r % 64, n0 = 32 * nb; int sc0 = n0;
            if (n0 < 1024) { const int pn = n0 >> 8, bj = (n0 >> 7) & 1, g = (n0 >> 5) & 3; sc0 = (4 * pn + g) * 64 + 32 * bj; }
            p0_transpose_item(A.w_kv, 1024, 2048, (bf16*)(A.ws + WS_WKV), 64 * kb, sc0, n0, scr, lane); continue; }
        r -= I_KV;
        if (r < I_QB) { const int kb = r / 32, nb = r % 32, n0 = 32 * nb; const int pn = n0 >> 8, bj = (n0 >> 7) & 1, g = (n0 >> 5) & 3;
            p0_transpose_item(A.w_q_b, 1024, 1024, (bf16*)(A.ws + WS_WQB), 64 * kb, (4 * pn + g) * 64 + 32 * bj, n0, scr, lane); continue; }
        r -= I_QB;
        { const int kb = r / 32, nb = r % 32; p0_transpose_item(A.w_out_b, 1024, 1024, (bf16*)(A.ws + WS_WOB), 64 * kb, 32 * nb, 32 * nb, scr, lane); }
    }
    float* MOD = (float*)(A.ws + WS_MOD);
    for (int it = gw; it < 320 * 16; it += NGW) {
        const int cg = it % 320, ks = it / 320, col0 = 64 * cg, k0 = 64 * ks;
        const float* W; const float* bias; int N, col;
        if (col0 < 9216) { W = A.w_ada; bias = A.b_ada; N = 9216; col = col0; }
        else if (col0 < 18432) { W = A.w_ada + (size_t)1024 * 9216; bias = A.b_ada + 9216; N = 9216; col = col0 - 9216; }
        else { W = A.w_ada_kv; bias = A.b_ada_kv; N = 2048; col = col0 - 18432; }
#pragma unroll 4
        for (int s = 0; s < NSEQ; ++s) { const float cv = (s < 8) ? A.c_p[s * 1024 + k0 + lane] : A.c_s[(s - 8) * 1024 + k0 + lane]; scr[lane * 40 + s] = cv / (1.0f + __expf(-cv)); }
        LDS_WAIT(); asm volatile("" ::: "memory");
        float acc[NSEQ];
#pragma unroll
        for (int s = 0; s < NSEQ; ++s) acc[s] = 0.f;
#pragma unroll 2
        for (int k = 0; k < 64; ++k) { const float w = W[(size_t)(k0 + k) * N + col + lane];
#pragma unroll
            for (int s4 = 0; s4 < NSEQ / 4; ++s4) { const f32x4 sc = *(const LAS f32x4*)(scr + k * 40 + 4 * s4);
                acc[4 * s4 + 0] += w * sc[0]; acc[4 * s4 + 1] += w * sc[1]; acc[4 * s4 + 2] += w * sc[2]; acc[4 * s4 + 3] += w * sc[3]; } }
        const float bv = (ks == 0) ? bias[col + lane] : 0.f;
#pragma unroll
        for (int s = 0; s < NSEQ; ++s) unsafeAtomicAdd(MOD + (size_t)s * NMODC + col0 + lane, acc[s] + bv);
        LDS_WAIT(); asm volatile("" ::: "memory");
    }
    float* RA = (float*)(A.ws + WS_ROPEA); float* RB = (float*)(A.ws + WS_ROPEB);
    for (int e = gw * 64 + lane; e < NPOS * 64; e += NGW * 64) {
        const int pi = e >> 6, d = e & 63; const double pos = (double)(pi < 2048 ? pi : 4096 + (pi - 2048));
        const double t = pos * INVF[d] * 0.15915494309189535; const float fr = (float)(t - floor(t));
        const float cs = __builtin_amdgcn_cosf(fr), sn = __builtin_amdgcn_sinf(fr);
        RA[2 * e] = cs; RA[2 * e + 1] = sn;
        if ((d & 1) == 0) { const int eb = pi * 32 + (d >> 1); RB[2 * eb] = cs; RB[2 * eb + 1] = sn; }
    }
}

struct RowOut { const float* gn; int shift_off, scale_off; bf16* dst; };
template <bool HAS_Y, int NOUT>
__device__ __forceinline__ void rowpass(const float* xp, const float* xs  , const bf16* Y, const float* gw, int gate_off, float gs, float* xdst,
                                        const RowOut o0, const RowOut o1, const float* MOD, int gw_id, int NGW, int lane) {
    const int c0 = 8 * lane;
    for (int seg = 0; seg < 2; ++seg) {
        const int nblk = seg == 0 ? MP / 8 : MS;
        for (int bi = gw_id; bi < nblk; bi += NGW) {
            const int r0 = seg == 0 ? 8 * bi : MP + bi, nr = seg == 0 ? 8 : 1;
            const int seq = r0 < MP ? (r0 >> 11) : 8 + ((r0 - MP) >> 5);
            const float* mrow = MOD + (size_t)seq * NMODC;
            float A1[2][8], B0[2][8], S0[2][8], B1[2][8], S1[2][8];
#pragma unroll
            for (int j = 0; j < 2; ++j) {
                if (HAS_Y) { float g[8], t[8]; ld8(gw + c0 + 512 * j, g); ld8(mrow + gate_off + c0 + 512 * j, t);
#pragma unroll
                    for (int e = 0; e < 8; ++e) A1[j][e] = gs * t[e] * g[e]; }
                if (NOUT >= 1) { float g[8], t[8]; ld8(o0.gn + c0 + 512 * j, g); ld8(mrow + o0.scale_off + c0 + 512 * j, t); ld8(mrow + o0.shift_off + c0 + 512 * j, S0[j]);
#pragma unroll
                    for (int e = 0; e < 8; ++e) B0[j][e] = g[e] * (1.0f + t[e]); }
                if (NOUT >= 2) { float g[8], t[8]; ld8(o1.gn + c0 + 512 * j, g); ld8(mrow + o1.scale_off + c0 + 512 * j, t); ld8(mrow + o1.shift_off + c0 + 512 * j, S1[j]);
#pragma unroll
                    for (int e = 0; e < 8; ++e) B1[j][e] = g[e] * (1.0f + t[e]); }
            }
            for (int rr = 0; rr < nr; ++rr) {
                const int r = r0 + rr;
                const float* xrow = (r < MP) ? xp + (size_t)r * 1024 : xs + (size_t)(r - MP) * 1024;
                float x[2][8];
#pragma unroll
                for (int j = 0; j < 2; ++j) ld8(xrow + c0 + 512 * j, x[j]);
                if (HAS_Y) {
                    float y[2][8]; float ss = 0.f;
#pragma unroll
                    for (int j = 0; j < 2; ++j) { unpack8(*(const GAS v4u*)(Y + (size_t)r * 1024 + c0 + 512 * j), y[j]);
#pragma unroll
                        for (int e = 0; e < 8; ++e) ss += y[j][e] * y[j][e]; }
                    const float rstd = rsqrtf(wave_sum(ss) * (1.0f / 1024.0f) + EPS);
#pragma unroll
                    for (int j = 0; j < 2; ++j)
#pragma unroll
                        for (int e = 0; e < 8; ++e) x[j][e] += A1[j][e] * (y[j][e] * rstd);
                }
                if (xdst) {
#pragma unroll
                    for (int j = 0; j < 2; ++j) st8(xdst + (size_t)r * 1024 + c0 + 512 * j, x[j]);
                }
                if (NOUT >= 1) {
                    float ss = 0.f;
#pragma unroll
                    for (int j = 0; j < 2; ++j)
#pragma unroll
                        for (int e = 0; e < 8; ++e) ss += x[j][e] * x[j][e];
                    const float rstd = rsqrtf(wave_sum(ss) * (1.0f / 1024.0f) + EPS);
#pragma unroll
                    for (int j = 0; j < 2; ++j) { float h[8];
#pragma unroll
                        for (int e = 0; e < 8; ++e) h[e] = (x[j][e] * rstd) * B0[j][e] + S0[j][e];
                        *(GAS v4u*)(o0.dst + (size_t)r * 1024 + c0 + 512 * j) = pack8f(h);
                        if (NOUT >= 2) {
#pragma unroll
                            for (int e = 0; e < 8; ++e) h[e] = (x[j][e] * rstd) * B1[j][e] + S1[j][e];
                            *(GAS v4u*)(o1.dst + (size_t)r * 1024 + c0 + 512 * j) = pack8f(h); } }
                }
            }
        }
    }
}
__device__ __forceinline__ void gatenorm_pass(const bf16* OR_, const bf16* GR, const float* ggn, bf16* AR, int gw_id, int NGW, int lane) {
    float gg[4][8];
#pragma unroll
    for (int j = 0; j < 4; ++j) ld8(ggn + 8 * lane + 512 * j, gg[j]);
    for (int r = gw_id; r < M; r += NGW) {
#pragma unroll
        for (int j = 0; j < 4; ++j) { const size_t off = (size_t)r * 2048 + 8 * lane + 512 * j;
            float o[8], g[8]; unpack8(*(const GAS v4u*)(OR_ + off), o); unpack8(*(const GAS v4u*)(GR + off), g);
            float ss = 0.f;
#pragma unroll
            for (int e = 0; e < 8; ++e) ss += o[e] * o[e];
#pragma unroll
            for (int k = 1; k < 32; k <<= 1) ss += __shfl_xor(ss, k);
            const float rstd = rsqrtf(ss * (1.0f / 256.0f) + EPS);
            float a[8];
#pragma unroll
            for (int e = 0; e < 8; ++e) a[e] = g[e] * ((o[e] * rstd) * gg[j][e]);
            *(GAS v4u*)(AR + off) = pack8f(a); }
    }
}
__device__ __forceinline__ void diffnorm_pass(const bf16* O0, const bf16* O1, const float* lamp  , const float* gsub  , bf16* AB, int gw_id, int NGW, int lane) {
    const float s01 = wave_sum(lamp[lane] * lamp[64 + lane]), s23 = wave_sum(lamp[128 + lane] * lamp[192 + lane]);
    const float lam = expf(s01) - expf(s23) + LAM_INIT;
    float gs[8]; ld8(gsub + 8 * (lane & 15), gs);
#pragma unroll
    for (int e = 0; e < 8; ++e) gs[e] *= (1.0f - LAM_INIT);
    for (int r = gw_id; r < M; r += NGW) {
#pragma unroll
        for (int j = 0; j < 2; ++j) { const size_t off = (size_t)r * 1024 + 8 * lane + 512 * j;
            float a[8], b[8]; unpack8(*(const GAS v4u*)(O0 + off), a); unpack8(*(const GAS v4u*)(O1 + off), b);
            float ss = 0.f;
#pragma unroll
            for (int e = 0; e < 8; ++e) { a[e] -= lam * b[e]; ss += a[e] * a[e]; }
#pragma unroll
            for (int k = 1; k < 16; k <<= 1) ss += __shfl_xor(ss, k);
            const float rstd = rsqrtf(ss * (1.0f / 128.0f) + EPS);
#pragma unroll
            for (int e = 0; e < 8; ++e) a[e] = (a[e] * rstd) * gs[e];
            *(GAS v4u*)(AB + off) = pack8f(a); }
    }
}

typedef float f32x4_t __attribute__((ext_vector_type(4)));
__device__ __forceinline__ f32x4_t mfma16(const bf16x8 a, const bf16x8 b, const f32x4_t c) { return __builtin_amdgcn_mfma_f32_16x16x32_bf16(a, b, c, 0, 0, 0); }
#define WG_BAR() do { asm volatile("s_waitcnt vmcnt(0) lgkmcnt(0)" ::: "memory"); __builtin_amdgcn_s_barrier(); asm volatile("" ::: "memory"); } while (0)
#define WG_BAR_L() do { asm volatile("s_waitcnt lgkmcnt(0)" ::: "memory"); __builtin_amdgcn_s_barrier(); asm volatile("" ::: "memory"); } while (0)
template <int N>
__device__ __forceinline__ void ret_unit(LAS unsigned char* lds, const bf16* QR, const bf16* KR, const bf16* VR, bf16* OR_, const float* S_in, float* S_out,
                                         int row0, int nchunks, int h, int vs, int tid, int lane, int wave) {
    constexpr int QP = 136, NP = N + 8, NT16 = N / 16;
    constexpr int OFF_Q = 0, OFF_K = OFF_Q + N * QP * 2, OFF_KT = OFF_K + N * QP * 2, OFF_VT = OFF_KT + 128 * NP * 2, OFF_P = OFF_VT + 64 * NP * 2, OFF_ST = OFF_P + N * NP * 2;
    static_assert(OFF_ST + 64 * QP * 2 <= RING_BYTES, "retention LDS");
    LAS bf16* Qs = (LAS bf16*)(lds + OFF_Q); LAS bf16* Ks = (LAS bf16*)(lds + OFF_K); LAS bf16* KTs = (LAS bf16*)(lds + OFF_KT);
    LAS bf16* VTs = (LAS bf16*)(lds + OFF_VT); LAS bf16* Ps = (LAS bf16*)(lds + OFF_P); LAS bf16* STs = (LAS bf16*)(lds + OFF_ST);
    const float lg = lg2gamma(h);
    const int l15 = lane & 15, l4 = lane >> 4;
    constexpr int NPQ = N * 16 / 512;
    const bool has_v = tid < N * 8;
    f32x4_t Sacc[4];
#pragma unroll
    for (int tv = 0; tv < 4; ++tv) {
#pragma unroll
        for (int rg = 0; rg < 4; ++rg) Sacc[tv][rg] = S_in ? S_in[(size_t)(16 * wave + 4 * l4 + rg) * 256 + vs * 64 + 16 * tv + l15] : 0.f;
        unsigned long long w = (unsigned long long)pk2(Sacc[tv][0], Sacc[tv][1]) | ((unsigned long long)pk2(Sacc[tv][2], Sacc[tv][3]) << 32);
        *(LAS unsigned long long*)(STs + (16 * tv + l15) * QP + 16 * wave + 4 * l4) = w;
    }
    v4u qreg[NPQ], kreg[NPQ], vreg = (v4u){0u, 0u, 0u, 0u};
#define RET_FETCH(c) do { _Pragma("unroll") for (int i_ = 0; i_ < NPQ; ++i_) { const int p_ = tid + 512 * i_, row_ = p_ >> 4, c8_ = p_ & 15; const size_t g_ = (size_t)(row0 + (c) * N + row_) * 1024 + h * 128 + 8 * c8_; \
            qreg[i_] = *(const GAS v4u*)(QR + g_); kreg[i_] = *(const GAS v4u*)(KR + g_); } \
        if (has_v) { const int row_ = tid >> 3, c8_ = tid & 7; vreg = *(const GAS v4u*)(VR + (size_t)(row0 + (c) * N + row_) * 2048 + h * 256 + vs * 64 + 8 * c8_); } } while (0)
    RET_FETCH(0);
    const float cdec = __builtin_amdgcn_exp2f(lg * (float)N);
    for (int c = 0; c < nchunks; ++c) {
#pragma unroll
        for (int i = 0; i < NPQ; ++i) { const int p = tid + 512 * i, row = p >> 4, c8 = p & 15;
            *(LAS v4u*)(Qs + row * QP + 8 * c8) = qreg[i]; *(LAS v4u*)(Ks + row * QP + 8 * c8) = kreg[i];
            float kf[8]; unpack8(kreg[i], kf); const float kd = __builtin_amdgcn_exp2f(lg * (float)(N - row));
#pragma unroll
            for (int e = 0; e < 8; ++e) KTs[(8 * c8 + e) * NP + row] = (bf16)f2bf(kf[e] * kd); }
        if (has_v) { const int row = tid >> 3, c8 = tid & 7; const unsigned vw[4] = {vreg.x, vreg.y, vreg.z, vreg.w};
#pragma unroll
            for (int e = 0; e < 8; ++e) VTs[(8 * c8 + e) * NP + row] = (bf16)((vw[e >> 1] >> (16 * (e & 1))) & 0xffffu); }
        if (c + 1 < nchunks) RET_FETCH(c + 1);
        WG_BAR_L();
        for (int t = wave; t < NT16 * NT16; t += 8) { const int ti = t / NT16, tj = t % NT16; f32x4_t acc = (f32x4_t){0.f, 0.f, 0.f, 0.f};
#pragma unroll
            for (int ks = 0; ks < 4; ++ks) { const bf16x8 a = *(const LAS bf16x8*)(Qs + (16 * ti + l15) * QP + 32 * ks + 8 * l4), b = *(const LAS bf16x8*)(Ks + (16 * tj + l15) * QP + 32 * ks + 8 * l4); acc = mfma16(a, b, acc); }
#pragma unroll
            for (int rg = 0; rg < 4; ++rg) { const int i = 16 * ti + 4 * l4 + rg, j = 16 * tj + l15; const int dd = i > j ? i - j : j - i;
                Ps[i * NP + j] = (bf16)f2bf(acc[rg] * __builtin_amdgcn_exp2f(lg * (float)dd)); } }
        constexpr int NB = NT16 * 4 / 8;
        f32x4_t oacc[NB];
#pragma unroll
        for (int n = 0; n < NB; ++n) { const int t = wave + 8 * n, ti = t >> 2, tv = t & 3; f32x4_t acc = (f32x4_t){0.f, 0.f, 0.f, 0.f};
#pragma unroll
            for (int ks = 0; ks < 4; ++ks) { const bf16x8 a = *(const LAS bf16x8*)(Qs + (16 * ti + l15) * QP + 32 * ks + 8 * l4), b = *(const LAS bf16x8*)(STs + (16 * tv + l15) * QP + 32 * ks + 8 * l4); acc = mfma16(a, b, acc); }
#pragma unroll
            for (int rg = 0; rg < 4; ++rg) acc[rg] *= __builtin_amdgcn_exp2f(lg * (float)(16 * ti + 4 * l4 + rg));
            oacc[n] = acc; }
        WG_BAR_L();
#pragma unroll
        for (int n = 0; n < NB; ++n) { const int t = wave + 8 * n, ti = t >> 2, tv = t & 3;
#pragma unroll
            for (int ks = 0; ks < N / 32; ++ks) { const bf16x8 a = *(const LAS bf16x8*)(Ps + (16 * ti + l15) * NP + 32 * ks + 8 * l4), b = *(const LAS bf16x8*)(VTs + (16 * tv + l15) * NP + 32 * ks + 8 * l4); oacc[n] = mfma16(a, b, oacc[n]); }
#pragma unroll
            for (int rg = 0; rg < 4; ++rg) OR_[(size_t)(row0 + c * N + 16 * ti + 4 * l4 + rg) * 2048 + h * 256 + vs * 64 + 16 * tv + l15] = (bf16)f2bf(oacc[n][rg]); }
#pragma unroll
        for (int tv = 0; tv < 4; ++tv) { Sacc[tv] = Sacc[tv] * cdec;
#pragma unroll
            for (int ks = 0; ks < N / 32; ++ks) { const bf16x8 a = *(const LAS bf16x8*)(KTs + (16 * wave + l15) * NP + 32 * ks + 8 * l4), b = *(const LAS bf16x8*)(VTs + (16 * tv + l15) * NP + 32 * ks + 8 * l4); Sacc[tv] = mfma16(a, b, Sacc[tv]); }
            unsigned long long w = (unsigned long long)pk2(Sacc[tv][0], Sacc[tv][1]) | ((unsigned long long)pk2(Sacc[tv][2], Sacc[tv][3]) << 32);
            *(LAS unsigned long long*)(STs + (16 * tv + l15) * QP + 16 * wave + 4 * l4) = w; }
        WG_BAR_L();
    }
#undef RET_FETCH
#pragma unroll
    for (int tv = 0; tv < 4; ++tv)
#pragma unroll
        for (int rg = 0; rg < 4; ++rg) S_out[(size_t)(16 * wave + 4 * l4 + rg) * 256 + vs * 64 + 16 * tv + l15] = Sacc[tv][rg];
}

typedef float f32x16_t __attribute__((ext_vector_type(16)));
__device__ __forceinline__ bf16x8 cvt8(const f32x4 a, const f32x4 b) { const v4u w = {pg8::cvt_pk_bf16(a[0], a[1]), pg8::cvt_pk_bf16(a[2], a[3]), pg8::cvt_pk_bf16(b[0], b[1]), pg8::cvt_pk_bf16(b[2], b[3])}; return __builtin_bit_cast(bf16x8, w); }
__device__ __forceinline__ void sattn_unit(LAS unsigned char* lds, int b, int h, const bf16* QB, const float* ck, const float* cv, const float* knew, const float* vnew, bf16* O0, bf16* O1, int lane, int wave) {
    constexpr int NSLOT = 4, SLOT = 32768, NTILE = 129;
    static_assert(NSLOT * SLOT <= RING_BYTES, "sample attention LDS");
    const int t = wave >> 2, vb = wave & 3, r32 = lane & 31, hi = lane >> 5;
    const unsigned lds0 = (unsigned)(uintptr_t)lds;
    bf16x8 qf[4];
    { const bf16* qp = QB + (size_t)(MP + 32 * b + r32) * 1024 + (2 * h + t) * 64 + 8 * hi;
#pragma unroll
      for (int ks = 0; ks < 4; ++ks) qf[ks] = *(const GAS bf16x8*)(qp + 16 * ks);
      asm volatile("s_waitcnt vmcnt(0)" ::: "memory");
#pragma unroll
      for (int ks = 0; ks < 4; ++ks) asm volatile("" : "+v"(qf[ks])); }
    size_t koff[2], voff[2];
#pragma unroll
    for (int i = 0; i < 2; ++i) { const int key = 4 * wave + 2 * i + hi, pp = r32, p = (pp & 16) | ((pp ^ key) & 15);
        koff[i] = (size_t)key * 1024 + h * 128 + p * 4; voff[i] = (size_t)key * 1024 + h * 128 + pp * 4; }
    const float* kbase = ck + (size_t)b * 4096 * 1024; const float* vbase = cv + (size_t)b * 4096 * 1024;
    const float* knb = knew + (size_t)(32 * b) * 1024; const float* vnb = vnew + (size_t)(32 * b) * 1024;
#define SA_ISSUE(tile) do { const int tl_ = (tile); const float* kb_ = tl_ < 128 ? kbase + (size_t)tl_ * 32 * 1024 : knb; const float* vb_ = tl_ < 128 ? vbase + (size_t)tl_ * 32 * 1024 : vnb; \
        const unsigned sl_ = lds0 + (unsigned)((tl_ & (NSLOT - 1)) * SLOT) + (unsigned)(2 * wave) * 1024u; \
        attn_body::glds16(kb_ + koff[0], (unsigned)__builtin_amdgcn_readfirstlane(sl_)); attn_body::glds16(kb_ + koff[1], (unsigned)__builtin_amdgcn_readfirstlane(sl_ + 1024u)); \
        attn_body::glds16(vb_ + voff[0], (unsigned)__builtin_amdgcn_readfirstlane(sl_ + 16384u)); attn_body::glds16(vb_ + voff[1], (unsigned)__builtin_amdgcn_readfirstlane(sl_ + 16384u + 1024u)); } while (0)
    SA_ISSUE(0); SA_ISSUE(1); SA_ISSUE(2);
    float mrun = -1e30f, lrun = 0.f; f32x16_t o;
#pragma unroll
    for (int r = 0; r < 16; ++r) o[r] = 0.f;
    for (int tile = 0; tile < NTILE; ++tile) {
        if (tile + 2 < NTILE) asm volatile("s_waitcnt vmcnt(8) lgkmcnt(0)\n\ts_barrier" ::: "memory");
        else if (tile + 1 < NTILE) asm volatile("s_waitcnt vmcnt(4) lgkmcnt(0)\n\ts_barrier" ::: "memory");
        else asm volatile("s_waitcnt vmcnt(0) lgkmcnt(0)\n\ts_barrier" ::: "memory");
        if (tile + 3 < NTILE) SA_ISSUE(tile + 3);
        const LAS unsigned char* slot = lds + (tile & (NSLOT - 1)) * SLOT;
        f32x16_t s;
#pragma unroll
        for (int r = 0; r < 16; ++r) s[r] = 0.f;
#pragma unroll
        for (int ks = 0; ks < 4; ++ks) { const int p0 = 16 * t + 4 * ks + 2 * hi; const int ph0 = (p0 & 16) | ((p0 ^ r32) & 15), ph1 = ((p0 + 1) & 16) | (((p0 + 1) ^ r32) & 15);
            const f32x4 a0 = *(const LAS f32x4*)(slot + r32 * 512 + ph0 * 16), a1 = *(const LAS f32x4*)(slot + r32 * 512 + ph1 * 16);
            s = __builtin_amdgcn_mfma_f32_32x32x16_bf16(cvt8(a0, a1), qf[ks], s, 0, 0, 0); }
        float mx = s[0];
#pragma unroll
        for (int r = 1; r < 16; ++r) mx = fmaxf(mx, s[r]);
        mx = fmaxf(mx, __shfl_xor(mx, 32));
        const float mnew = fmaxf(mrun, mx), alpha = __builtin_amdgcn_exp2f(mrun - mnew); mrun = mnew;
        float rs = 0.f;
#pragma unroll
        for (int r = 0; r < 16; ++r) { s[r] = __builtin_amdgcn_exp2f(s[r] - mnew); rs += s[r]; }
        lrun = lrun * alpha + rs;
#pragma unroll
        for (int r = 0; r < 16; ++r) o[r] *= alpha;
        const LAS float* vcol = (const LAS float*)(slot + 16384) + 32 * vb + r32;
#pragma unroll
        for (int s2 = 0; s2 < 2; ++s2) { float vv[8];
#pragma unroll
            for (int j = 0; j < 8; ++j) vv[j] = vcol[(16 * s2 + 8 * (j >> 2) + 4 * hi + (j & 3)) * 128];
            const bf16x8 af = cvt8((f32x4){vv[0], vv[1], vv[2], vv[3]}, (f32x4){vv[4], vv[5], vv[6], vv[7]});
            const bf16x8 pf = cvt8((f32x4){s[8 * s2 + 0], s[8 * s2 + 1], s[8 * s2 + 2], s[8 * s2 + 3]}, (f32x4){s[8 * s2 + 4], s[8 * s2 + 5], s[8 * s2 + 6], s[8 * s2 + 7]});
            o = __builtin_amdgcn_mfma_f32_32x32x16_bf16(af, pf, o, 0, 0, 0); }
    }
#undef SA_ISSUE
    lrun += __shfl_xor(lrun, 32);
    const float inv = 1.0f / lrun;
    bf16* Ot = (t ? O1 : O0) + (size_t)(MP + 32 * b + r32) * 1024 + h * 128 + 32 * vb + 4 * hi;
#pragma unroll
    for (int g = 0; g < 4; ++g) { const unsigned long long w = (unsigned long long)pk2(o[4 * g] * inv, o[4 * g + 1] * inv) | ((unsigned long long)pk2(o[4 * g + 2] * inv, o[4 * g + 3] * inv) << 32);
        *(GAS unsigned long long*)(Ot + 8 * g) = w; }
    asm volatile("s_waitcnt lgkmcnt(0)\n\ts_barrier" ::: "memory");
}

#ifndef MK_N_LAUNCHES
#define MK_N_LAUNCHES 1
#endif
constexpr int NPHASE = 24;
constexpr int N_LAUNCHES = MK_N_LAUNCHES;
static_assert(N_LAUNCHES == 1 || N_LAUNCHES == NPHASE, "MK_N_LAUNCHES is 1 or 24");
struct Args { const float* in[23]; float* out; unsigned char* ws; int ph_lo, ph_hi; };
static_assert(sizeof(Args) == 25 * 8 + 8, "Args has no holes");

template <class Epi>
__device__ __forceinline__ void run_gemm(LAS unsigned char* lds, const bf16* A, const bf16* Bt, int N, int K, int G, int c, const Epi& E) {
    pg8::Gemm g{A, Bt, M, N, K}; pg8::StaticOrder S; S.init(M, N, G, c);
    pg8::gemm_phase<Epi, pg8::StaticOrder, true, true>(lds + RING_OFF, g, S, E);
}

__global__ void __launch_bounds__(NWAVES * 64, 2) yoco_fwd(Args args) {
    extern __shared__ __attribute__((aligned(16))) unsigned char lds_raw[];
    LAS unsigned char* lds = (LAS unsigned char*)lds_raw;
    volatile LAS unsigned* MISC = (volatile LAS unsigned*)(lds + MISC_OFF);
    const int tid = threadIdx.x, lane = tid & 63, wave = __builtin_amdgcn_readfirstlane(tid >> 6);
    const int G = gridDim.x; const int bx = blockIdx.x; const int vcu = (G % 8 == 0) ? (bx % 8) * (G / 8) + bx / 8 : bx;
    const int gw = vcu * NWAVES + wave, NGW = G * NWAVES;
    unsigned char* ws = args.ws; float* out = args.out;
    gu32* ctl = (gu32*)(ws + WS_CTL);
    for (int u = tid; u < (LDS_BYTES - LDSCTL_OFF) / 4; u += NWAVES * 64) ((LAS unsigned*)(lds + LDSCTL_OFF))[u] = 0u;
    __syncthreads();
    XcdBarrier bar; bar.bar = (unsigned*)(ctl + CW_BAR); bar.x = 0; bar.st = nullptr;
    if (N_LAUNCHES == 1) bar = xcd_barrier_post((unsigned*)(ctl + CW_BAR), MISC + 8);
#define GRID_BAR() do { if (N_LAUNCHES == 1) xcd_barrier(bar); } while (0)
    const int lo = args.ph_lo, hi = args.ph_hi;
#define IN(k) (lo <= (k) && (k) < hi)
#define SEAM(k) do { if (IN((k) + 1)) GRID_BAR(); } while (0)

    const float* x_p = args.in[0]; const float* x_s = args.in[1]; const float* state_ret = args.in[2]; const float* cache_k = args.in[3]; const float* cache_v = args.in[4];
    const float* g_norm = args.in[9]; const float* g_gn_a = args.in[13]; const float* g_kv = args.in[17]; const float* lam_b = args.in[20]; const float* g_sub = args.in[21];
    const float* MOD = (const float*)(ws + WS_MOD); const float* ropeA = (const float*)(ws + WS_ROPEA); const float* ropeB = (const float*)(ws + WS_ROPEB);
    bf16* H = (bf16*)(ws + WS_H); bf16* HKV = (bf16*)(ws + WS_HKV); bf16* Y = (bf16*)(ws + WS_Y); bf16* U = (bf16*)(ws + WS_U);
    bf16* QR = (bf16*)(ws + WS_QR); bf16* KR = (bf16*)(ws + WS_KR); bf16* VR = (bf16*)(ws + WS_VR); bf16* GR = (bf16*)(ws + WS_GR); bf16* OR_ = (bf16*)(ws + WS_OR); bf16* AR = (bf16*)(ws + WS_AR);
    bf16* KB = (bf16*)(ws + WS_KB); bf16* VB = (bf16*)(ws + WS_VB); bf16* QB = (bf16*)(ws + WS_QB); bf16* O0 = (bf16*)(ws + WS_O0); bf16* O1 = (bf16*)(ws + WS_O1); bf16* AB = (bf16*)(ws + WS_AB);
    float* X = out + OUT_Y;
    const RowOut none{nullptr, 0, 0, nullptr};
#define WFI(l, i) ((const bf16*)(ws + WS_WFI + (size_t)((l) * 2 + (i)) * SZ_WFI))
#define WFO(l, i) ((const bf16*)(ws + WS_WFO + (size_t)((l) * 2 + (i)) * SZ_WFO))
#define GN(l, j) (g_norm + ((l) * 6 + (j)) * 1024)
#define MC(l, j) (((l) * 9 + (j)) * 1024)

    if (IN(0)) { P0Args A{args.in[5], args.in[6], args.in[7], args.in[8], args.in[10], args.in[11], args.in[12], args.in[14], args.in[15], args.in[16], args.in[18], args.in[19], args.in[22], ws};
        p0_prologue(A, lds, gw, NGW, lane, wave); SEAM(0); }
    if (IN(1)) { rowpass<false, 1>(x_p, x_s, nullptr, nullptr, 0, 0.f, nullptr, RowOut{GN(0, 0), MC(0, 0), MC(0, 1), H}, none, MOD, gw, NGW, lane); SEAM(1); }
    if (IN(2)) { run_gemm(lds, H, WFI(0, 0), 2 * DFF, 1024, G, bx, pg8::EpiSwiglu{U, DFF}); SEAM(2); }
    if (IN(3)) { run_gemm(lds, U, WFO(0, 0), 1024, DFF, G, bx, pg8::EpiBf16{Y, 1024}); SEAM(3); }
    if (IN(4)) { rowpass<true, 1>(x_p, x_s, Y, GN(0, 1), MC(0, 2), 0.5f, X, RowOut{GN(0, 2), MC(0, 3), MC(0, 4), H}, none, MOD, gw, NGW, lane); SEAM(4); }
    if (IN(5)) { run_gemm(lds, H, (const bf16*)(ws + WS_WIA), AIN, 1024, G, bx, pg8::EpiRetIn{QR, KR, VR, GR, ropeA}); SEAM(5); }
    if (IN(6)) {
        for (int id = vcu; id < 256; id += G) { const int b = id >> 5, h = (id >> 2) & 7, vs = id & 3;
            ret_unit<64>(lds, QR, KR, VR, OR_, nullptr, out + OUT_SRP + (size_t)(b * 8 + h) * 128 * 256, 2048 * b, 32, h, vs, tid, lane, wave); }
        for (int id = vcu; id < 1024; id += G) { const int b = id >> 5, h = (id >> 2) & 7, vs = id & 3;
            ret_unit<32>(lds, QR, KR, VR, OR_, state_ret + (size_t)(b * 8 + h) * 128 * 256, out + OUT_SRS + (size_t)(b * 8 + h) * 128 * 256, MP + 32 * b, 1, h, vs, tid, lane, wave); }
        SEAM(6); }
    if (IN(7)) { gatenorm_pass(OR_, GR, g_gn_a, AR, gw, NGW, lane); SEAM(7); }
    if (IN(8)) { run_gemm(lds, AR, (const bf16*)(ws + WS_WOA), 1024, 2048, G, bx, pg8::EpiBf16{Y, 1024}); SEAM(8); }
    if (IN(9)) { rowpass<true, 1>(X, X + (size_t)MP * 1024, Y, GN(0, 3), MC(0, 5), 1.0f, X, RowOut{GN(0, 4), MC(0, 6), MC(0, 7), H}, none, MOD, gw, NGW, lane); SEAM(9); }
    if (IN(10)) { run_gemm(lds, H, WFI(0, 1), 2 * DFF, 1024, G, bx, pg8::EpiSwiglu{U, DFF}); SEAM(10); }
    if (IN(11)) { run_gemm(lds, U, WFO(0, 1), 1024, DFF, G, bx, pg8::EpiBf16{Y, 1024}); SEAM(11); }
    if (IN(12)) { rowpass<true, 2>(X, X + (size_t)MP * 1024, Y, GN(0, 5), MC(0, 8), 0.5f, X, RowOut{GN(1, 0), MC(1, 0), MC(1, 1), H}, RowOut{g_kv, 18432, 18432 + 1024, HKV}, MOD, gw, NGW, lane); SEAM(12); }
    if (IN(13)) { run_gemm(lds, H, WFI(1, 0), 2 * DFF, 1024, G, bx, pg8::EpiSwiglu{U, DFF});
        run_gemm(lds, HKV, (const bf16*)(ws + WS_WKV), 2048, 1024, G, (bx + G - (1496 % G)) % G, pg8::EpiKV{KB, VB, out + OUT_KP, out + OUT_KS, out + OUT_VP, out + OUT_VS, ropeB}); SEAM(13); }
    if (IN(14)) { run_gemm(lds, U, WFO(1, 0), 1024, DFF, G, bx, pg8::EpiBf16{Y, 1024}); SEAM(14); }
    if (IN(15)) { rowpass<true, 1>(X, X + (size_t)MP * 1024, Y, GN(1, 1), MC(1, 2), 0.5f, X, RowOut{GN(1, 2), MC(1, 3), MC(1, 4), H}, none, MOD, gw, NGW, lane); SEAM(15); }
    if (IN(16)) { run_gemm(lds, H, (const bf16*)(ws + WS_WQB), 1024, 1024, G, bx, pg8::EpiQ{QB, ropeB, QSCALE}); SEAM(16); }
    if (IN(17)) {
        const attn_body::AttnTensors AT{(const attn_body::bf16*)QB, (const attn_body::bf16*)KB, (const attn_body::bf16*)VB, (attn_body::bf16*)O0, (attn_body::bf16*)O1};
        const attn_body::StaticOrder S(G, vcu);
        attn_body::attn_phase<attn_body::StaticOrder>((char*)lds_raw + RING_OFF, AT, S);
        for (int id = vcu; id < 256; id += G) sattn_unit(lds, id >> 3, id & 7, QB, cache_k, cache_v, out + OUT_KS, out + OUT_VS, O0, O1, lane, wave);
        SEAM(17); }
    if (IN(18)) { diffnorm_pass(O0, O1, lam_b, g_sub, AB, gw, NGW, lane); SEAM(18); }
    if (IN(19)) { run_gemm(lds, AB, (const bf16*)(ws + WS_WOB), 1024, 1024, G, bx, pg8::EpiBf16{Y, 1024}); SEAM(19); }
    if (IN(20)) { rowpass<true, 1>(X, X + (size_t)MP * 1024, Y, GN(1, 3), MC(1, 5), 1.0f, X, RowOut{GN(1, 4), MC(1, 6), MC(1, 7), H}, none, MOD, gw, NGW, lane); SEAM(20); }
    if (IN(21)) { run_gemm(lds, H, WFI(1, 1), 2 * DFF, 1024, G, bx, pg8::EpiSwiglu{U, DFF}); SEAM(21); }
    if (IN(22)) { run_gemm(lds, U, WFO(1, 1), 1024, DFF, G, bx, pg8::EpiBf16{Y, 1024}); SEAM(22); }
    if (IN(23)) { rowpass<true, 0>(X, X + (size_t)MP * 1024, Y, GN(1, 5), MC(1, 8), 0.5f, X, none, none, MOD, gw, NGW, lane); }
#undef IN
#undef SEAM
#undef GRID_BAR
}

extern "C" void kernel_launch(void* const* d_in, const int* in_sizes, int n_in, void* d_out, int out_size, void* d_ws, size_t ws_size, hipStream_t stream) {
    static int grid = 0;
    if (grid == 0) {
        if (n_in != 23 || in_sizes[0] != MP * D || (size_t)out_size != OUT_END || ws_size < WS_END) { fprintf(stderr, "kernel_launch: unexpected shapes (n_in %d, in0 %d, out %d, ws %zu); nothing launched\n", n_in, n_in > 0 ? in_sizes[0] : -1, out_size, ws_size); grid = -1; return; }
        int dev = 0, cus = 0, per_cu = 0;
        if (hipGetDevice(&dev) != hipSuccess || hipDeviceGetAttribute(&cus, hipDeviceAttributeMultiprocessorCount, dev) != hipSuccess) { fprintf(stderr, "kernel_launch: device query failed\n"); grid = -1; return; }
        if (hipFuncSetAttribute((const void*)yoco_fwd, hipFuncAttributeMaxDynamicSharedMemorySize, LDS_BYTES) != hipSuccess) { fprintf(stderr, "kernel_launch: hipFuncSetAttribute failed\n"); grid = -1; return; }
        if (hipOccupancyMaxActiveBlocksPerMultiprocessor(&per_cu, (const void*)yoco_fwd, NWAVES * 64, LDS_BYTES) != hipSuccess || per_cu < 1)
            fprintf(stderr, "kernel_launch: note: occupancy query reports %d workgroups per CU\n", per_cu);
        (void)hipGetLastError();
        grid = cus;
    }
    if (grid < 0) return;
    if (hipMemsetAsync((char*)d_ws + WS_CTL, 0, ZERO_BYTES, stream) != hipSuccess) { fprintf(stderr, "kernel_launch: hipMemsetAsync failed\n"); return; }
    Args a{};
    for (int i = 0; i < 23; ++i) a.in[i] = (const float*)d_in[i];
    a.out = (float*)d_out; a.ws = (unsigned char*)d_ws;
    for (int li = 0; li < N_LAUNCHES; ++li) {
        a.ph_lo = (N_LAUNCHES == 1) ? 0 : li; a.ph_hi = (N_LAUNCHES == 1) ? NPHASE : li + 1;
        hipLaunchKernelGGL(yoco_fwd, dim3(grid), dim3(NWAVES * 64), LDS_BYTES, stream, a);
        const hipError_t le = hipPeekAtLastError();
        if (le != hipSuccess) { fprintf(stderr, "kernel_launch: launch %d failed: %s\n", li, hipGetErrorName(le)); break; }
    }
}
```

```cpp
#include <hip/hip_runtime.h>
#include <cstdio>
#include <cstdint>
namespace pg8 {
#define PG8_LAS __attribute__((address_space(3)))
typedef unsigned short bf16_t;
typedef short bf16x8 __attribute__((ext_vector_type(8)));
typedef float f32x4 __attribute__((ext_vector_type(4)));
typedef unsigned u32x4 __attribute__((ext_vector_type(4)));
constexpr int BM = 256, BK = 64, HALF = 128, HTB = HALF * BK * 2  , STAGE_BYTES = 8 * HTB, NXCD = 8, WGM = 8;

__host__ __device__ __forceinline__ int lds_byte(int r, int c) { const int st = (r >> 4) * 2 + (c >> 5), rr = r & 15, cc = c & 31, ob = rr * 64 + cc * 2; return st * 1024 + (ob ^ (((ob >> 9) & 1) << 5)); }
__host__ __device__ __forceinline__ void stage_rc(int b, int& R, int& C) { const int st = b / 1024, sb = b % 1024, swz = sb ^ (((sb >> 9) & 1) << 5); R = (st >> 1) * 16 + swz / 64; C = (st & 1) * 32 + (swz % 64) / 2; }
__host__ __device__ __forceinline__ int perm32(int rho) { const int n = rho >> 4, i = rho & 15; return 8 * (i >> 2) + 4 * n + (i & 3); }

struct Unit { int pm, pn, k0, nt, slot; };
struct Gemm { const bf16_t* A; const bf16_t* Bt; int M, N, K; };

struct StaticOrder {
    int nM, nN, nwg, G, c, ntK;
    __host__ __device__ void init(int M, int N, int K, int G_, int c_) { nM = M / BM; nN = N / BM; nwg = nM * nN; G = G_; c = c_; ntK = K / BK; }
    __host__ __device__ bool next(int i, Unit& u) const {
        const long L = (long)i * G + c; if (L >= nwg) return false;
        int wgid = (int)L; { const int q = nwg / NXCD, r = nwg % NXCD, xcd = wgid % NXCD, off = wgid / NXCD; wgid = (xcd < r ? xcd * (q + 1) : r * (q + 1) + (xcd - r) * q) + off; }
        const int nig = WGM * nN, gid = wgid / nig, fm = gid * WGM, gsz = (nM - fm) < WGM ? (nM - fm) : WGM;
        u.pm = fm + ((wgid % nig) % gsz); u.pn = (wgid % nig) / gsz; u.k0 = 0; u.nt = ntK; u.slot = 0; return true;
    }
    __device__ __forceinline__ void a_ready(const Unit&) const {}
    __device__ __forceinline__ void done(const Unit&) const {}
};


struct StreamK {
    int nN, nkp, W, G, v, b0, b1;
    __host__ __device__ void init(int M, int N, int K, int G_, int v_) { nN = N / BM; nkp = K / 128; const int nu = (M / BM) * nN; W = nu * nkp; G = G_ < nu ? G_ : nu; v = v_;
        b0 = v < G ? (int)(((long)v * W) / G) : W; b1 = v < G ? (int)(((long)(v + 1) * W) / G) : W; }
    __host__ __device__ int cu_of(int x) const { return (int)((((long)x + 1) * G - 1) / W); }
    __host__ __device__ int pieces(int un) const { return cu_of(un * nkp + nkp - 1) - cu_of(un * nkp) + 1; }
    __host__ __device__ bool next(int i, Unit& u) const {
        const int un = b0 / nkp + i, ks = un * nkp; const int a = b0 > ks ? b0 : ks, e = b1 < ks + nkp ? b1 : ks + nkp;
        if (a >= e) return false;
        u.pm = un / nN; u.pn = un % nN; u.k0 = 2 * (a - ks); u.nt = 2 * (e - a); u.slot = v - cu_of(ks); return true;
    }
    __device__ __forceinline__ void a_ready(const Unit&) const {}
    __device__ __forceinline__ void done(const Unit&) const {}
};

struct QSplit {
    StaticOrder P; int G, c, R;
    __host__ __device__ void init(int G_, int c_) { P.init(16384, 1024, 1024, G_, c_); G = G_; c = c_; R = (P.nwg + G_ - 1) / G_; }
    __host__ __device__ bool next(int i, Unit& u) const {
        if (i < R) { if (P.next(i, u)) return true; i = R; }
        const long j = (long)(i - R) * G + c; if (j >= 64) return false;
        const int s = (int)j >> 2; u.pm = 64 + (s >> 2); u.pn = s & 3; u.k0 = 4 * ((int)j & 3); u.nt = 4; u.slot = (int)j & 3; return true;
    }
    __device__ __forceinline__ void a_ready(const Unit&) const {}
    __device__ __forceinline__ void done(const Unit&) const {}
};

__device__ __forceinline__ unsigned cvt_pk_bf16(float lo, float hi) { unsigned r; asm volatile("v_cvt_pk_bf16_f32 %0, %1, %2" : "=v"(r) : "v"(lo), "v"(hi)); return r; }
__device__ __forceinline__ void stntf(f32x4* p, const f32x4 v) { __builtin_nontemporal_store(v, p); }
__device__ __forceinline__ u32x4 pack8(const f32x4 a, const f32x4 b) { u32x4 w; w.x = cvt_pk_bf16(a[0], a[1]); w.y = cvt_pk_bf16(a[2], a[3]); w.z = cvt_pk_bf16(b[0], b[1]); w.w = cvt_pk_bf16(b[2], b[3]); return w; }
__device__ __forceinline__ float silu_f(float a) { return a * __builtin_amdgcn_rcpf(1.0f + __builtin_amdgcn_exp2f(-1.4426950408889634f * a)); }
__device__ __forceinline__ float swi_f(float a, float b) { return (a * b) * __builtin_amdgcn_rcpf(1.0f + __builtin_amdgcn_exp2f(-a)); }
__device__ __forceinline__ f32x4 swi4(const f32x4 a, const f32x4 b) { f32x4 r; r[0] = swi_f(a[0], b[0]); r[1] = swi_f(a[1], b[1]); r[2] = swi_f(a[2], b[2]); r[3] = swi_f(a[3], b[3]); return r; }
__device__ __forceinline__ f32x4 silu4(const f32x4 a) { f32x4 r; r[0] = silu_f(a[0]); r[1] = silu_f(a[1]); r[2] = silu_f(a[2]); r[3] = silu_f(a[3]); return r; }
__device__ __forceinline__ int pidx_of(int r) { return r < 16384 ? (r & 2047) : 2048 + ((r - 16384) & 31); }

struct EpiBf16 {
    static constexpr bool PERM = true, AFTER_DRAIN = false;
    bf16_t* O; int ldc; size_t slot_stride;
    __device__ __forceinline__ void operator()(const f32x4 (&acc)[2][2][4][2], const Unit& u, int wr, int wc, int fr, int fq) const {
        const int row0 = u.pm * BM + wr * 64 + fr, col0 = u.pn * BM + wc * 32 + 8 * fq; bf16_t* Ob = O + (size_t)u.slot * slot_stride;
#pragma unroll
        for (int ai = 0; ai < 2; ++ai)
#pragma unroll
            for (int m = 0; m < 4; ++m) { bf16_t* rowp = Ob + (size_t)(row0 + ai * HALF + m * 16) * ldc + col0;
#pragma unroll
                for (int bj = 0; bj < 2; ++bj) *(u32x4*)(rowp + bj * HALF) = pack8(acc[ai][bj][m][0], acc[ai][bj][m][1]); }
    }
};
struct EpiSwiglu {
    static constexpr bool PERM = true, AFTER_DRAIN = false;
    bf16_t* U; int ldu;
    __device__ __forceinline__ void operator()(const f32x4 (&acc)[2][2][4][2], const Unit& u, int wr, int wc, int fr, int fq) const {
        const int row0 = u.pm * BM + wr * 64 + fr, col0 = u.pn * HALF + wc * 32 + 8 * fq;
#pragma unroll
        for (int ai = 0; ai < 2; ++ai)
#pragma unroll
            for (int m = 0; m < 4; ++m) { bf16_t* rowp = U + (size_t)(row0 + ai * HALF + m * 16) * ldu + col0;
                const f32x4 v0 = swi4(acc[ai][0][m][0], acc[ai][1][m][0]), v1 = swi4(acc[ai][0][m][1], acc[ai][1][m][1]);
                *(u32x4*)rowp = pack8(v0, v1); }
    }
};
__device__ __forceinline__ void rot8(const f32x4* rp, const f32x4 x1a, const f32x4 x1b, const f32x4 x2a, const f32x4 x2b, float sc, f32x4& o1a, f32x4& o1b, f32x4& o2a, f32x4& o2b) {
    const f32x4 c0 = rp[0], c1 = rp[1], c2 = rp[2], c3 = rp[3];
    o1a[0] = (x1a[0] * c0[0] - x2a[0] * c0[1]) * sc; o2a[0] = (x2a[0] * c0[0] + x1a[0] * c0[1]) * sc;
    o1a[1] = (x1a[1] * c0[2] - x2a[1] * c0[3]) * sc; o2a[1] = (x2a[1] * c0[2] + x1a[1] * c0[3]) * sc;
    o1a[2] = (x1a[2] * c1[0] - x2a[2] * c1[1]) * sc; o2a[2] = (x2a[2] * c1[0] + x1a[2] * c1[1]) * sc;
    o1a[3] = (x1a[3] * c1[2] - x2a[3] * c1[3]) * sc; o2a[3] = (x2a[3] * c1[2] + x1a[3] * c1[3]) * sc;
    o1b[0] = (x1b[0] * c2[0] - x2b[0] * c2[1]) * sc; o2b[0] = (x2b[0] * c2[0] + x1b[0] * c2[1]) * sc;
    o1b[1] = (x1b[1] * c2[2] - x2b[1] * c2[3]) * sc; o2b[1] = (x2b[1] * c2[2] + x1b[1] * c2[3]) * sc;
    o1b[2] = (x1b[2] * c3[0] - x2b[2] * c3[1]) * sc; o2b[2] = (x2b[2] * c3[0] + x1b[2] * c3[1]) * sc;
    o1b[3] = (x1b[3] * c3[2] - x2b[3] * c3[3]) * sc; o2b[3] = (x2b[3] * c3[2] + x1b[3] * c3[3]) * sc;
}
struct EpiRetIn {
    static constexpr bool PERM = true, AFTER_DRAIN = false;
    bf16_t *QR, *KR, *VR, *GR; const float* ropeA;
    __device__ __forceinline__ void operator()(const f32x4 (&acc)[2][2][4][2], const Unit& u, int wr, int wc, int fr, int fq) const {
        const int row0 = u.pm * BM + wr * 64 + fr;
        if (u.pn < 8) {
            bf16_t* dst = (u.pn < 4) ? QR : KR; const float sc = (u.pn < 4) ? 1.0f : 0.08838834764831845f;
            const int head = 2 * (u.pn & 3) + (wc >> 1), d0 = 32 * (wc & 1) + 8 * fq;
#pragma unroll
            for (int ai = 0; ai < 2; ++ai)
#pragma unroll
                for (int m = 0; m < 4; ++m) { const int row = row0 + ai * HALF + m * 16; const f32x4* rp = (const f32x4*)(ropeA + ((size_t)pidx_of(row) * 64 + d0) * 2);
                    f32x4 o1a, o1b, o2a, o2b; rot8(rp, acc[ai][0][m][0], acc[ai][0][m][1], acc[ai][1][m][0], acc[ai][1][m][1], sc, o1a, o1b, o2a, o2b);
                    bf16_t* rowp = dst + (size_t)row * 1024 + head * 128 + d0;
                    *(u32x4*)rowp = pack8(o1a, o1b); *(u32x4*)(rowp + 64) = pack8(o2a, o2b); }
        } else if (u.pn < 16) {
            const int col0 = (u.pn - 8) * BM + wc * 32 + 8 * fq;
#pragma unroll
            for (int ai = 0; ai < 2; ++ai)
#pragma unroll
                for (int m = 0; m < 4; ++m) { bf16_t* rowp = VR + (size_t)(row0 + ai * HALF + m * 16) * 2048 + col0;
#pragma unroll
                    for (int bj = 0; bj < 2; ++bj) *(u32x4*)(rowp + bj * HALF) = pack8(acc[ai][bj][m][0], acc[ai][bj][m][1]); }
        } else {
            const int col0 = (u.pn - 16) * BM + wc * 32 + 8 * fq;
#pragma unroll
            for (int ai = 0; ai < 2; ++ai)
#pragma unroll
                for (int m = 0; m < 4; ++m) { bf16_t* rowp = GR + (size_t)(row0 + ai * HALF + m * 16) * 2048 + col0;
#pragma unroll
                    for (int bj = 0; bj < 2; ++bj) *(u32x4*)(rowp + bj * HALF) = pack8(acc[ai][bj][m][0], acc[ai][bj][m][1]); }
        }
    }
};
struct EpiKV {
    static constexpr bool PERM = true, AFTER_DRAIN = false;
    bf16_t *KB, *VB; float *Kp, *Ks, *Vp, *Vs; const float* ropeB;
    __device__ __forceinline__ void operator()(const f32x4 (&acc)[2][2][4][2], const Unit& u, int wr, int wc, int fr, int fq) const {
        const int row0 = u.pm * BM + wr * 64 + fr; const bool samp = u.pm >= 64;
        if (u.pn < 4) {
            const int grp = 4 * u.pn + wc, d0 = 8 * fq; float* ob = samp ? Ks - (size_t)16384 * 1024 : Kp;
#pragma unroll
            for (int ai = 0; ai < 2; ++ai)
#pragma unroll
                for (int m = 0; m < 4; ++m) { const int row = row0 + ai * HALF + m * 16; const f32x4* rp = (const f32x4*)(ropeB + ((size_t)pidx_of(row) * 32 + d0) * 2);
                    f32x4 o1a, o1b, o2a, o2b; rot8(rp, acc[ai][0][m][0], acc[ai][0][m][1], acc[ai][1][m][0], acc[ai][1][m][1], 1.0f, o1a, o1b, o2a, o2b);
                    const size_t off = (size_t)row * 1024 + grp * 64 + d0;
                    stntf((f32x4*)(ob + off), o1a); stntf((f32x4*)(ob + off + 4), o1b); stntf((f32x4*)(ob + off + 32), o2a); stntf((f32x4*)(ob + off + 36), o2b);
                    *(u32x4*)(KB + off) = pack8(o1a, o1b); *(u32x4*)(KB + off + 32) = pack8(o2a, o2b); }
        } else {
            const int col0 = (u.pn - 4) * BM + wc * 32 + 8 * fq; float* ob = samp ? Vs - (size_t)16384 * 1024 : Vp;
#pragma unroll
            for (int ai = 0; ai < 2; ++ai)
#pragma unroll
                for (int m = 0; m < 4; ++m) { const size_t off = (size_t)(row0 + ai * HALF + m * 16) * 1024 + col0;
#pragma unroll
                    for (int bj = 0; bj < 2; ++bj) { stntf((f32x4*)(ob + off + bj * HALF), acc[ai][bj][m][0]); stntf((f32x4*)(ob + off + bj * HALF + 4), acc[ai][bj][m][1]);
                        *(u32x4*)(VB + off + bj * HALF) = pack8(acc[ai][bj][m][0], acc[ai][bj][m][1]); } }
        }
    }
};
struct EpiQ {
    static constexpr bool PERM = true, AFTER_DRAIN = false;
    bf16_t* QB; bf16_t* QB2; const float* ropeB; float qscale;
    __device__ __forceinline__ void operator()(const f32x4 (&acc)[2][2][4][2], const Unit& u, int wr, int wc, int fr, int fq) const {
        const int row0 = u.pm * BM + wr * 64 + fr; const int grp = 4 * u.pn + wc, d0 = 8 * fq; bf16_t* Qd = u.slot ? QB2 + (size_t)(u.slot - 1) * (1024 * 1024) : QB;
#pragma unroll
        for (int ai = 0; ai < 2; ++ai)
#pragma unroll
            for (int m = 0; m < 4; ++m) { const int row = row0 + ai * HALF + m * 16; const f32x4* rp = (const f32x4*)(ropeB + ((size_t)pidx_of(row) * 32 + d0) * 2);
                f32x4 o1a, o1b, o2a, o2b; rot8(rp, acc[ai][0][m][0], acc[ai][0][m][1], acc[ai][1][m][0], acc[ai][1][m][1], qscale, o1a, o1b, o2a, o2b);
                const size_t off = (size_t)row * 1024 + grp * 64 + d0;
                *(u32x4*)(Qd + off) = pack8(o1a, o1b); *(u32x4*)(Qd + off + 32) = pack8(o2a, o2b); }
    }
};
template <class Epi, class Sched, bool ALIGN_EPI = false, bool SP2 = false>
__device__ __forceinline__ void gemm_phase(PG8_LAS unsigned char* lds, const Gemm g, const Sched& S, const Epi& E) {
    const int tid = threadIdx.x, wid = __builtin_amdgcn_readfirstlane(tid >> 6), lane = tid & 63, wr = wid >> 2, wc = wid & 3, fr = lane & 15, fq = lane >> 4;
    const int K = g.K;
    unsigned voffA[2], voffB[2];
#pragma unroll
    for (int i = 0; i < 2; ++i) { int R, C; stage_rc(tid * 16 + i * 8192, R, C); const int Rb = Epi::PERM ? ((R & ~31) + perm32(R & 31)) : R;
        voffA[i] = (unsigned)(R * K + C) * 2u; voffB[i] = (unsigned)(Rb * K + C) * 2u; }
    const size_t kstep = (size_t)(BK * 2);
    const size_t hstep = (size_t)HALF * K * 2;
    const size_t tstep = 2 * hstep;
    const unsigned ldsw = (unsigned)wid * 1024u;
    const int aoff = lds_byte(wr * 64 + fr, fq * 8), boff = lds_byte(wc * 32 + fr, fq * 8);
#define PG8_SA(b, h) (((b) * 2 + (h)) * HTB)
#define PG8_SB(b, h) ((4 + (b) * 2 + (h)) * HTB)
#define PG8_STAGE(bufoff, gbase, voff) do { _Pragma("unroll") for (int _i = 0; _i < 2; ++_i) \
        __builtin_amdgcn_global_load_lds((const unsigned*)((const char*)(gbase) + (voff)[_i]), (PG8_LAS unsigned*)(lds + (bufoff) + ldsw + _i * 8192), 16, 0, 0); } while (0)
#define PG8_LDA(dst, b, h) do { _Pragma("unroll") for (int m = 0; m < 4; ++m) _Pragma("unroll") for (int k = 0; k < 2; ++k) dst[m][k] = *(const PG8_LAS bf16x8*)(lds + PG8_SA(b, h) + aoff + m * 2048 + k * 1024); } while (0)
#define PG8_LDB(dst, b, h) do { _Pragma("unroll") for (int n = 0; n < 2; ++n) _Pragma("unroll") for (int k = 0; k < 2; ++k) dst[n][k] = *(const PG8_LAS bf16x8*)(lds + PG8_SB(b, h) + boff + n * 2048 + k * 1024); } while (0)
#define PG8_MMA(ai, bj, At, Bt) do { __builtin_amdgcn_s_setprio(1); _Pragma("unroll") for (int m = 0; m < 4; ++m) _Pragma("unroll") for (int n = 0; n < 2; ++n) _Pragma("unroll") for (int k = 0; k < 2; ++k) \
        acc[ai][bj][m][n] = __builtin_amdgcn_mfma_f32_16x16x32_bf16(Bt[n][k], At[m][k], acc[ai][bj][m][n], 0, 0, 0); __builtin_amdgcn_s_setprio(0); } while (0)
#define PG8_WAIT_V(n) asm volatile("s_waitcnt vmcnt(" #n ")" ::: "memory")
#define PG8_WAIT_L(n) asm volatile("s_waitcnt lgkmcnt(" #n ")" ::: "memory")
#define PG8_BAR __builtin_amdgcn_s_barrier()
#define PG8_SCHED __builtin_amdgcn_sched_barrier(0)
    Unit cur, nxt; int ui = 0;
    if (!S.next(0, cur)) return;
    f32x4 acc[2][2][4][2];
#pragma unroll
    for (int a = 0; a < 2; ++a)
#pragma unroll
        for (int b = 0; b < 2; ++b)
#pragma unroll
            for (int m = 0; m < 4; ++m)
#pragma unroll
                for (int n = 0; n < 2; ++n) acc[a][b][m][n] = (f32x4){0.f, 0.f, 0.f, 0.f};
    bf16x8 At[4][2], B0[2][2], B1[2][2];
    const char* cA = (const char*)g.A + (size_t)cur.pm * tstep + (size_t)cur.k0 * kstep; const char* cB = (const char*)g.Bt + (size_t)cur.pn * tstep + (size_t)cur.k0 * kstep;
    S.a_ready(cur);
    if constexpr (SP2) {
        PG8_STAGE(PG8_SB(0, 0), cB, voffB); PG8_STAGE(PG8_SB(0, 1), cB + hstep, voffB); PG8_STAGE(PG8_SA(0, 0), cA, voffA); PG8_STAGE(PG8_SA(0, 1), cA + hstep, voffA);
        if (wr == 1) PG8_BAR;
        PG8_WAIT_V(2); PG8_BAR;
        PG8_STAGE(PG8_SB(1, 0), cB + kstep, voffB); PG8_STAGE(PG8_SA(1, 0), cA + kstep, voffA); PG8_STAGE(PG8_SB(1, 1), cB + hstep + kstep, voffB);
        PG8_WAIT_V(6); PG8_BAR;
    } else {
        PG8_STAGE(PG8_SB(0, 0), cB, voffB); PG8_STAGE(PG8_SA(0, 0), cA, voffA); PG8_STAGE(PG8_SB(0, 1), cB + hstep, voffB); PG8_STAGE(PG8_SA(0, 1), cA + hstep, voffA);
        if (wr == 1) PG8_BAR;
        PG8_WAIT_V(4); PG8_BAR;
        PG8_STAGE(PG8_SB(1, 0), cB + kstep, voffB); PG8_STAGE(PG8_SA(1, 0), cA + kstep, voffA); PG8_STAGE(PG8_SB(1, 1), cB + hstep + kstep, voffB);
        PG8_WAIT_V(6); PG8_BAR;
    }
    for (;;) {
        const bool has_next = S.next(ui + 1, nxt);
        const char* nA = has_next ? (const char*)g.A + (size_t)nxt.pm * tstep + (size_t)nxt.k0 * kstep : cA; const char* nB = has_next ? (const char*)g.Bt + (size_t)nxt.pn * tstep + (size_t)nxt.k0 * kstep : cB;
        const int nt = cur.nt;
        for (int t = 0; t < nt; t += 2) {
            const bool last = (t == nt - 2);
            const char* a1 = cA + (size_t)(t + 1) * kstep;
            const char* a2 = last ? nA : cA + (size_t)(t + 2) * kstep; const char* b2 = last ? nB : cB + (size_t)(t + 2) * kstep;
            const char* a3 = a2 + kstep; const char* b3 = b2 + kstep;
            if (last && has_next) S.a_ready(nxt);
            if constexpr (SP2) {
            PG8_LDB(B0, 0, 0); PG8_LDB(B1, 0, 1); PG8_SCHED; PG8_LDA(At, 0, 0); PG8_STAGE(PG8_SA(1, 1), a1 + hstep, voffA);
            PG8_WAIT_V(8); PG8_WAIT_L(0); PG8_BAR; PG8_MMA(0, 0, At, B0); PG8_MMA(0, 1, At, B1); PG8_BAR; PG8_SCHED;
            PG8_LDA(At, 0, 1); PG8_STAGE(PG8_SB(0, 0), b2, voffB); PG8_STAGE(PG8_SB(0, 1), b2 + hstep, voffB); PG8_STAGE(PG8_SA(0, 0), a2, voffA);
            PG8_WAIT_V(8); PG8_WAIT_L(0); PG8_BAR; PG8_MMA(1, 0, At, B0); PG8_MMA(1, 1, At, B1); PG8_BAR; PG8_SCHED;
            PG8_LDB(B0, 1, 0); PG8_LDB(B1, 1, 1); PG8_SCHED; PG8_LDA(At, 1, 0); PG8_STAGE(PG8_SA(0, 1), a2 + hstep, voffA);
            PG8_WAIT_V(8); PG8_WAIT_L(0); PG8_BAR; PG8_MMA(0, 0, At, B0); PG8_MMA(0, 1, At, B1); PG8_BAR; PG8_SCHED;
            PG8_LDA(At, 1, 1); PG8_STAGE(PG8_SB(1, 0), b3, voffB); PG8_STAGE(PG8_SB(1, 1), b3 + hstep, voffB); PG8_STAGE(PG8_SA(1, 0), a3, voffA);
            PG8_WAIT_V(8); PG8_WAIT_L(0); PG8_BAR; PG8_MMA(1, 0, At, B0); PG8_MMA(1, 1, At, B1); PG8_BAR; PG8_SCHED;
            } else {
            PG8_LDB(B0, 0, 0); PG8_SCHED; PG8_LDA(At, 0, 0); PG8_STAGE(PG8_SA(1, 1), a1 + hstep, voffA);
            PG8_WAIT_L(8); PG8_BAR; PG8_WAIT_L(0); PG8_MMA(0, 0, At, B0); PG8_BAR; PG8_SCHED;
            PG8_LDB(B1, 0, 1); PG8_STAGE(PG8_SB(0, 0), b2, voffB);
            PG8_BAR; PG8_WAIT_L(0); PG8_MMA(0, 1, At, B1); PG8_BAR;
            PG8_LDA(At, 0, 1); PG8_STAGE(PG8_SA(0, 0), a2, voffA);
            PG8_BAR; PG8_WAIT_L(0); PG8_MMA(1, 0, At, B0); PG8_BAR; PG8_SCHED;
            PG8_STAGE(PG8_SB(0, 1), b2 + hstep, voffB);
            PG8_WAIT_V(6); PG8_BAR; PG8_MMA(1, 1, At, B1); PG8_BAR;
            PG8_LDB(B0, 1, 0); PG8_SCHED; PG8_LDA(At, 1, 0); PG8_STAGE(PG8_SA(0, 1), a2 + hstep, voffA);
            PG8_WAIT_L(8); PG8_BAR; PG8_WAIT_L(0); PG8_MMA(0, 0, At, B0); PG8_BAR; PG8_SCHED;
            PG8_LDB(B1, 1, 1); PG8_STAGE(PG8_SB(1, 0), b3, voffB);
            PG8_BAR; PG8_WAIT_L(0); PG8_MMA(0, 1, At, B1); PG8_BAR;
            PG8_LDA(At, 1, 1); PG8_STAGE(PG8_SA(1, 0), a3, voffA);
            PG8_BAR; PG8_WAIT_L(0); PG8_MMA(1, 0, At, B0); PG8_BAR; PG8_SCHED;
            PG8_STAGE(PG8_SB(1, 1), b3 + hstep, voffB);
            PG8_WAIT_V(6); PG8_BAR; PG8_MMA(1, 1, At, B1); PG8_BAR;
            }
        }
        if constexpr (ALIGN_EPI) { if (wr == 0) PG8_BAR; }
        if constexpr (!Epi::AFTER_DRAIN) { E(acc, cur, wr, wc, fr, fq); S.done(cur); }
        if (!has_next) break;
#pragma unroll
        for (int a = 0; a < 2; ++a)
#pragma unroll
            for (int b = 0; b < 2; ++b)
#pragma unroll
                for (int m = 0; m < 4; ++m)
#pragma unroll
                    for (int n = 0; n < 2; ++n) acc[a][b][m][n] = (f32x4){0.f, 0.f, 0.f, 0.f};
        cur = nxt; cA = nA; cB = nB; ++ui;
        if constexpr (ALIGN_EPI) { if (wr == 1) PG8_BAR; }
    }
    PG8_WAIT_V(0);
    if constexpr (!ALIGN_EPI) { if (wr == 0) PG8_BAR; }
    PG8_BAR;
    if constexpr (Epi::AFTER_DRAIN) { E.fused(acc, cur, wr, wc, fr, fq, lds, wid, lane); S.done(cur); }
#undef PG8_SA
#undef PG8_SB
#undef PG8_STAGE
#undef PG8_LDA
#undef PG8_LDB
#undef PG8_MMA
#undef PG8_WAIT_V
#undef PG8_WAIT_L
#undef PG8_BAR
#undef PG8_SCHED
}
}
#include <hip/hip_bf16.h>
#include <cmath>
namespace attn_body {
using bf16=__hip_bfloat16;
using bf16x8=__attribute__((ext_vector_type(8)))short;
using s16x4=__attribute__((ext_vector_type(4)))short;
using f32x16=__attribute__((ext_vector_type(16)))float;
using u32x4=__attribute__((ext_vector_type(4)))unsigned;
constexpr int BATCH=8,NHEAD=16,SEQ=2048,D=64,DM=NHEAD*D;
constexpr int NW=8,QBLK=32,QB=QBLK*NW,KVBLK=64,NQB=SEQ/QB;
constexpr int ATTN_PITCH=DM, ATTN_UNIT_ROWS=QB;
__device__ __forceinline__ int crow(int r,int hi){return (r&3)+8*(r>>2)+4*hi;}
#define SBAR() __builtin_amdgcn_sched_barrier(0)
__device__ __forceinline__ void cmask(f32x16&p0,f32x16&p1,int jb,int wid){
  const float NEG=-INFINITY;
  if(jb>(wid>>1)){
    #pragma unroll
    for(int r=0;r<16;++r){p0[r]=NEG;p1[r]=NEG;}
  }
}

constexpr int NSLOT=3, SLOTB=8192;
constexpr int LDS_K=0, LDS_V=NSLOT*SLOTB, LDS_WS=2*NSLOT*SLOTB, LDS_OST=LDS_WS+NW*64*4, LDS_BYTES=LDS_OST+NW*4096;
constexpr float C2=0.125f*1.4426950408889634f;
__device__ __forceinline__ void glds16(const void*gsrc,unsigned lds_dst){unsigned keep;
  asm volatile("s_mov_b32 %0, m0\n\ts_mov_b32 m0, %2\n\ts_nop 0\n\tglobal_load_lds_dwordx4 %1, off\n\ts_mov_b32 m0, %0":"=&s"(keep):"v"(gsrc),"s"(lds_dst):"memory");}
__device__ __forceinline__ float max3f(float a,float b,float c){float r;asm("v_max3_f32 %0, %1, %2, %3":"=v"(r):"v"(a),"v"(b),"v"(c));return r;}
__device__ __forceinline__ float max2f(float a,float b){float r;asm("v_max_f32_e32 %0, %1, %2":"=v"(r):"v"(a),"v"(b));return r;}
__device__ __forceinline__ float fadd_s(float a,float b){float r;asm("v_add_f32_e32 %0, %1, %2":"=v"(r):"v"(a),"v"(b));return r;}
__device__ __forceinline__ float fsub_s(float a,float b){float r;asm("v_sub_f32_e32 %0, %1, %2":"=v"(r):"v"(a),"v"(b));return r;}
typedef float f32x2_t __attribute__((ext_vector_type(2))); typedef __bf16 bf16x2_t __attribute__((ext_vector_type(2)));
__device__ __forceinline__ unsigned cvtpk_s(float lo,float hi){f32x2_t v={lo,hi};bf16x2_t b=__builtin_convertvector(v,bf16x2_t);return __builtin_bit_cast(unsigned,b);}
#define WAIT_BAR(N) asm volatile("s_waitcnt vmcnt(" #N ") lgkmcnt(0)\n\ts_barrier":::"memory")

__device__ __forceinline__ void qkt(f32x16&p0,f32x16&p1,const char*Kslot,const bf16x8*qr,const f32x16&negm,int r32,int hi){
  const char*kb=Kslot+hi*1024+r32*16;
  #pragma unroll
  for(int d0=0;d0<4;++d0){
    const bf16x8 b0=*reinterpret_cast<const bf16x8*>(kb+d0*2048);
    const bf16x8 b1=*reinterpret_cast<const bf16x8*>(kb+d0*2048+512);
    if(d0==0){p0=__builtin_amdgcn_mfma_f32_32x32x16_bf16(b0,qr[0],negm,0,0,0);p1=__builtin_amdgcn_mfma_f32_32x32x16_bf16(b1,qr[0],negm,0,0,0);}
    else{p0=__builtin_amdgcn_mfma_f32_32x32x16_bf16(b0,qr[d0],p0,0,0,0);p1=__builtin_amdgcn_mfma_f32_32x32x16_bf16(b1,qr[d0],p1,0,0,0);}}
}
typedef __attribute__((address_space(3))) const char* lds_cptr;
typedef short v4i16_t __attribute__((ext_vector_type(4)));
__device__ __forceinline__ void kload8(bf16x8*kf,lds_cptr kp){
  kf[0]=*(const __attribute__((address_space(3))) bf16x8*)(kp);      kf[1]=*(const __attribute__((address_space(3))) bf16x8*)(kp+512);
  kf[2]=*(const __attribute__((address_space(3))) bf16x8*)(kp+2048); kf[3]=*(const __attribute__((address_space(3))) bf16x8*)(kp+2560);
  kf[4]=*(const __attribute__((address_space(3))) bf16x8*)(kp+4096); kf[5]=*(const __attribute__((address_space(3))) bf16x8*)(kp+4608);
  kf[6]=*(const __attribute__((address_space(3))) bf16x8*)(kp+6144); kf[7]=*(const __attribute__((address_space(3))) bf16x8*)(kp+6656);
}
__device__ __forceinline__ void kload2(bf16x8*kf,lds_cptr kp,int j){ kf[2*j]=*(const __attribute__((address_space(3))) bf16x8*)(kp+j*2048); kf[2*j+1]=*(const __attribute__((address_space(3))) bf16x8*)(kp+j*2048+512); }
__device__ __forceinline__ s16x4 vtr(lds_cptr p){ return __builtin_bit_cast(s16x4,__builtin_amdgcn_ds_read_tr16_b64_v4i16((__attribute__((address_space(3))) v4i16_t*)p)); }
__device__ __forceinline__ float rowmax(const f32x16&p0,const f32x16&p1){
  float a=max3f(p0[0],p0[1],p1[0]),b=max3f(p0[2],p0[3],p1[1]);a=max3f(a,p1[2],p1[3]);
  #pragma unroll
  for(int r=4;r<16;r+=4){a=max3f(a,p0[r],p0[r+1]);b=max3f(b,p0[r+2],p0[r+3]);a=max3f(a,p1[r],p1[r+1]);b=max3f(b,p1[r+2],p1[r+3]);}
  const float m=max2f(a,b);
  auto rr=__builtin_amdgcn_permlane32_swap(__float_as_uint(m),__float_as_uint(m),false,false);
  return max2f(__uint_as_float(rr[0]),__uint_as_float(rr[1]));
}
__device__ __forceinline__ void pv(f32x16*o,int vb,bf16x8 pa0,bf16x8 pa1,bf16x8 pa2,bf16x8 pa3){
  #pragma unroll
  for(int d0=0;d0<2;++d0){s16x4 lo[4],hi[4];
    #pragma unroll
    for(int ks=0;ks<4;++ks){
      asm volatile("ds_read_b64_tr_b16 %0,%1 offset:%c2":"=&v"(lo[ks]):"v"(vb),"i"(d0*4096+ks*1024):"memory");
      asm volatile("ds_read_b64_tr_b16 %0,%1 offset:%c2":"=&v"(hi[ks]):"v"(vb),"i"(d0*4096+ks*1024+512):"memory");}
    asm volatile("s_waitcnt lgkmcnt(0)":::"memory");SBAR();
    #define PK(k) (bf16x8){lo[k][0],lo[k][1],lo[k][2],lo[k][3],hi[k][0],hi[k][1],hi[k][2],hi[k][3]}
    o[d0]=__builtin_amdgcn_mfma_f32_32x32x16_bf16(pa0,PK(0),o[d0],0,0,0);
    o[d0]=__builtin_amdgcn_mfma_f32_32x32x16_bf16(pa1,PK(1),o[d0],0,0,0);
    o[d0]=__builtin_amdgcn_mfma_f32_32x32x16_bf16(pa2,PK(2),o[d0],0,0,0);
    o[d0]=__builtin_amdgcn_mfma_f32_32x32x16_bf16(pa3,PK(3),o[d0],0,0,0);
    #undef PK
  }
}

#ifndef ATTN_STORE16
#define ATTN_STORE16(p,v) (*(u32x4*)(p)=(v))
#endif
template<int THRL> __device__ __forceinline__ void attn_unit(int b,int h,int hv,int qb,const bf16*Q,const bf16*__restrict__ K,const bf16*__restrict__ V,bf16*O,char*shm){
  const int tid=threadIdx.x,lane=tid&63,r32=lane&31,hi=lane>>5; const int wid=__builtin_amdgcn_readfirstlane(tid>>6);
  const long rowbase=(long)b*SEQ; const int q0=qb*QB;
  const bf16*Qw=Q+(rowbase+q0+wid*QBLK)*DM+h*D;
  const bf16*Kh=K+rowbase*DM+h*D,*Vh=V+rowbase*DM+hv*D;
  const unsigned lds0=(unsigned)(uintptr_t)shm;
  float*wsf=(float*)(shm+LDS_WS)+wid*64;
  const bf16*ksrc=Kh+(long)lane*DM+wid*8;
  const bf16*vsrc=Vh+(long)(16*(wid&3)+(lane>>2))*DM+(wid>>2)*32+(lane&3)*8;
  const unsigned kdst=lds0+LDS_K+wid*1024, vdst=lds0+LDS_V+wid*1024;
  #define DMA_K(t,slot) glds16(ksrc+(long)(t)*KVBLK*DM,(unsigned)__builtin_amdgcn_readfirstlane(kdst+(slot)))
  #define DMA_V(t,slot) glds16(vsrc+(long)(t)*KVBLK*DM,(unsigned)__builtin_amdgcn_readfirstlane(vdst+(slot)))
  const int vb0=(int)(lds0+LDS_V)+((lane>>4)&1)*32+(lane&3)*8+(4*hi+((lane&15)>>2))*64;
  const char*Kbase=shm+LDS_K; bf16x8 kf[8];
  const lds_cptr shm3=(lds_cptr)shm; const lds_cptr kp0=shm3+LDS_K+hi*1024+r32*16; const lds_cptr vp0=shm3+LDS_V+((lane>>4)&1)*32+(lane&3)*8+(4*hi+((lane&15)>>2))*64;
  const int NT=(q0+QB)/KVBLK;
  DMA_K(0,0);DMA_V(0,0);DMA_K(1,SLOTB);
  bf16x8 qr[4];
  #pragma unroll
  for(int d0=0;d0<4;++d0)qr[d0]=*reinterpret_cast<const bf16x8*>(&Qw[(long)r32*DM+d0*16+hi*8]);
  float mhat=0.f,l_reg=0.f;f32x16 o[2];o[0]=f32x16{};o[1]=f32x16{};f32x16 negm=f32x16{};asm volatile("":"+v"(negm));

  #define CMASK(P0,P1,t) do{int jb_=(t)-(NT-4); if(jb_>=0)cmask(P0,P1,jb_,wid);}while(0)
  bool resc=false;
  #define START(P0,P1) do{ const float rm=rowmax(P0,P1); resc=false; \
    { const float dl=rm; mhat=fadd_s(mhat,dl); \
      _Pragma("unroll") for(int r=0;r<16;++r){P0[r]=fsub_s(P0[r],dl);P1[r]=fsub_s(P1[r],dl);} \
      _Pragma("unroll") for(int r=0;r<16;++r)negm[r]=-mhat; asm volatile("":"+v"(negm)); } \
    _Pragma("unroll") for(int r=0;r<16;++r)P0[r]=__builtin_amdgcn_exp2f(P0[r]); }while(0)
  #define RESC() do{ if(resc){ asm volatile("s_waitcnt lgkmcnt(0)":::"memory"); \
      _Pragma("unroll") for(int d_=0;d_<2;++d_) _Pragma("unroll") for(int r=0;r<16;++r)o[d_][r]*=wsf[crow(r,hi)]; } }while(0)
  f32x16 pA0,pA1,pB0,pB1;
  int sl_prev=0,sl_cur=0,sl_next=SLOTB;
  #define ROT() do{sl_prev=sl_cur;sl_cur=sl_next;sl_next=(sl_next==(NSLOT-1)*SLOTB)?0:sl_next+SLOTB;}while(0)
  DMA_K(2,2*SLOTB);
  WAIT_BAR(3);
  qkt(pA0,pA1,Kbase,qr,negm,r32,hi);asm volatile("s_nop 15\n\ts_nop 7":"+v"(pA0),"+v"(pA1));CMASK(pA0,pA1,0);
  START(pA0,pA1);
  _Pragma("unroll") for(int r=0;r<16;++r)pA1[r]=__builtin_amdgcn_exp2f(pA1[r]);
  WAIT_BAR(0);
  DMA_K(3,0);DMA_V(1,SLOTB);
  ROT();
  kload8(kf,kp0+sl_cur);
  WAIT_BAR(2);
  s16x4 vlo[8],vhi[8]; u32x4 pw0,pw1,pw2,pw3;
  #define PKW(P,B) cvtpk_s(P[B],P[B+1])
  #define PAF(k) __builtin_bit_cast(bf16x8,pw##k)
  #define VFR(i) (bf16x8){vlo[i][0],vlo[i][1],vlo[i][2],vlo[i][3],vhi[i][0],vhi[i][1],vhi[i][2],vhi[i][3]}
  #define PIN(x) asm volatile("":"+v"(x))
  #define MX3(a,b,c) __builtin_fmaxf(__builtin_fmaxf((a),(b)),(c))
  #define GAPA(MF,A0,A1,A2,A3,W0,W1,PW) do{ MF; sacc+=A0; sacc+=A1; sacc+=A2; sacc+=A3; PIN(sacc); W0; W1; PIN(PW); SBAR(); }while(0)
  #define EX(v) __builtin_amdgcn_exp2f(v)
  #define GAPB(MF,X,B) do{ MF; X[B]=EX(X[B]); X[B+1]=EX(X[B+1]); X[B+2]=EX(X[B+2]); X[B+3]=EX(X[B+3]); PIN(X); SBAR(); }while(0)
  #define VRD(i) do{ vlo[i]=vtr(vp_+(((i)>>2)*4096+((i)&3)*1024)); vhi[i]=vtr(vp_+(((i)>>2)*4096+((i)&3)*1024+512)); }while(0)
  #define KRD(G,j) do{ if(G){ kload2(kf,kp0+sl_next,j); SBAR(); } }while(0)
  #define STEP(C0,C1,P0,P1,t,GK,GV,GL) do{ SBAR(); \
    const lds_cptr vp_=vp0+sl_prev; \
    VRD(0); SBAR(); float sacc=(P0[0]+P0[1]); \
    GAPA(C0=__builtin_amdgcn_mfma_f32_32x32x16_bf16(kf[0],qr[0],negm,0,0,0), P0[2],P0[3],P0[4],P0[5],     pw0[0]=PKW(P0,0), pw0[1]=PKW(P0,2), pw0); \
    VRD(4); SBAR(); GAPA(C1=__builtin_amdgcn_mfma_f32_32x32x16_bf16(kf[1],qr[0],negm,0,0,0), P0[6],P0[7],P0[8],P0[9],     pw0[2]=PKW(P0,4), pw0[3]=PKW(P0,6), pw0); \
    VRD(1); SBAR(); GAPA(C0=__builtin_amdgcn_mfma_f32_32x32x16_bf16(kf[2],qr[1],C0,0,0,0),   P0[10],P0[11],P0[12],P0[13], pw1[0]=PKW(P0,8), pw1[1]=PKW(P0,10), pw1); \
    VRD(5); SBAR(); GAPA(C1=__builtin_amdgcn_mfma_f32_32x32x16_bf16(kf[3],qr[1],C1,0,0,0),   P0[14],P0[15],P1[0],P1[1],   pw1[2]=PKW(P0,12),pw1[3]=PKW(P0,14), pw1); \
    VRD(2); SBAR(); GAPA(C0=__builtin_amdgcn_mfma_f32_32x32x16_bf16(kf[4],qr[2],C0,0,0,0),   P1[2],P1[3],P1[4],P1[5],     pw2[0]=PKW(P1,0), pw2[1]=PKW(P1,2), pw2); \
    VRD(6); SBAR(); GAPA(C1=__builtin_amdgcn_mfma_f32_32x32x16_bf16(kf[5],qr[2],C1,0,0,0),   P1[6],P1[7],P1[8],P1[9],     pw2[2]=PKW(P1,4), pw2[3]=PKW(P1,6), pw2); \
    VRD(3); SBAR(); GAPA(C0=__builtin_amdgcn_mfma_f32_32x32x16_bf16(kf[6],qr[3],C0,0,0,0),   P1[10],P1[11],P1[12],P1[13], pw3[0]=PKW(P1,8), pw3[1]=PKW(P1,10), pw3); \
    VRD(7); SBAR(); GAPA(C1=__builtin_amdgcn_mfma_f32_32x32x16_bf16(kf[7],qr[3],C1,0,0,0),   P1[14],P1[15],0.f,0.f,       pw3[2]=PKW(P1,12),pw3[3]=PKW(P1,14), pw3); \
    l_reg+=sacc; \
    if(GK){DMA_K((t)+3,sl_cur);} if(GV){DMA_V((t)+1,sl_next);} \
    CMASK(C0,C1,t); \
    { float a=MX3(C0[0],C0[1],C1[0]),b=MX3(C0[2],C0[3],C1[1]); a=MX3(a,C1[2],C1[3]); \
      _Pragma("unroll") for(int r=4;r<16;r+=4){a=MX3(a,C0[r],C0[r+1]);b=MX3(b,C0[r+2],C0[r+3]);a=MX3(a,C1[r],C1[r+1]);b=MX3(b,C1[r+2],C1[r+3]);} \
      float rm=__builtin_fmaxf(a,b); { auto rr=__builtin_amdgcn_permlane32_swap(__float_as_uint(rm),__float_as_uint(rm),false,false); rm=__builtin_fmaxf(__uint_as_float(rr[0]),__uint_as_float(rr[1])); } \
      resc=false; \
      if(__builtin_expect(__any(rm>(float)THRL),0)){ const float dl=__builtin_fmaxf(rm,0.f); mhat+=dl; \
        _Pragma("unroll") for(int r=0;r<16;++r){C0[r]-=dl;C1[r]-=dl;} \
        _Pragma("unroll") for(int r=0;r<16;++r)negm[r]=-mhat; asm volatile("":"+v"(negm)); \
        const float f=__builtin_amdgcn_exp2f(-dl); l_reg*=f; if(hi==0)wsf[r32]=f; resc=true; } } \
    SBAR(); \
    GAPB(o[0]=__builtin_amdgcn_mfma_f32_32x32x16_bf16(PAF(0),VFR(0),o[0],0,0,0), C0,0); \
    GAPB(o[1]=__builtin_amdgcn_mfma_f32_32x32x16_bf16(PAF(0),VFR(4),o[1],0,0,0), C0,4); \
    KRD(GL,0); GAPB(o[0]=__builtin_amdgcn_mfma_f32_32x32x16_bf16(PAF(1),VFR(1),o[0],0,0,0), C0,8); \
    KRD(GL,1); GAPB(o[1]=__builtin_amdgcn_mfma_f32_32x32x16_bf16(PAF(1),VFR(5),o[1],0,0,0), C0,12); \
    KRD(GL,2); GAPB(o[0]=__builtin_amdgcn_mfma_f32_32x32x16_bf16(PAF(2),VFR(2),o[0],0,0,0), C1,0); \
    KRD(GL,3); GAPB(o[1]=__builtin_amdgcn_mfma_f32_32x32x16_bf16(PAF(2),VFR(6),o[1],0,0,0), C1,4); \
    GAPB(o[0]=__builtin_amdgcn_mfma_f32_32x32x16_bf16(PAF(3),VFR(3),o[0],0,0,0), C1,8); \
    GAPB(o[1]=__builtin_amdgcn_mfma_f32_32x32x16_bf16(PAF(3),VFR(7),o[1],0,0,0), C1,12); \
    }while(0)
  int t=1;
  #undef CMASK
  #define CMASK(P0,P1,t) do{}while(0)
  for(;t+5<NT;t+=2){
    STEP(pB0,pB1,pA0,pA1,t,true,true,true);     WAIT_BAR(2); RESC(); ROT();
    STEP(pA0,pA1,pB0,pB1,t+1,true,true,true);   WAIT_BAR(2); RESC(); ROT();
  }
  #undef CMASK
  #define CMASK(P0,P1,t) do{int jb_=(t)-(NT-4); if(jb_>=0)cmask(P0,P1,jb_,wid);}while(0)
  #define ENDW(tt) do{ if((tt)+3<NT){WAIT_BAR(2);} else if((tt)+2<NT){WAIT_BAR(1);} else {WAIT_BAR(0);} }while(0)
  for(;t+1<NT;t+=2){
    STEP(pB0,pB1,pA0,pA1,t,(t+3<NT),(t+1<NT),(t+1<NT));       ENDW(t);   RESC(); ROT();
    STEP(pA0,pA1,pB0,pB1,t+1,(t+4<NT),(t+2<NT),(t+2<NT));     ENDW(t+1); RESC(); ROT();
  }
  STEP(pB0,pB1,pA0,pA1,NT-1,false,false,false); RESC();
  { float sacc=pB0[0]+pB0[1]; _Pragma("unroll") for(int r=2;r<16;++r)sacc+=pB0[r]; _Pragma("unroll") for(int r=0;r<16;++r)sacc+=pB1[r]; l_reg+=sacc;
    pw0=(u32x4){PKW(pB0,0),PKW(pB0,2),PKW(pB0,4),PKW(pB0,6)};pw1=(u32x4){PKW(pB0,8),PKW(pB0,10),PKW(pB0,12),PKW(pB0,14)};pw2=(u32x4){PKW(pB1,0),PKW(pB1,2),PKW(pB1,4),PKW(pB1,6)};pw3=(u32x4){PKW(pB1,8),PKW(pB1,10),PKW(pB1,12),PKW(pB1,14)};
    SBAR(); pv(o,vb0+sl_cur,PAF(0),PAF(1),PAF(2),PAF(3)); }
  #undef PKW
  #undef PAF
  #undef VFR
  #undef PIN
  #undef MX3
  #undef GAPA
  #undef GAPB
  #undef EX
  #undef VRD
  #undef KRD
  #undef STEP
  #undef ENDW
  {auto rr=__builtin_amdgcn_permlane32_swap(__float_as_uint(l_reg),__float_as_uint(l_reg),false,false);l_reg=__uint_as_float(rr[0])+__uint_as_float(rr[1]);}
  if(hi==0)wsf[32+r32]=l_reg;asm volatile("s_waitcnt lgkmcnt(0)":::"memory");
  float rli[16];
  #pragma unroll
  for(int r=0;r<16;++r)rli[r]=__builtin_amdgcn_rcpf(wsf[32+crow(r,hi)]);
  bf16*Ow=O+(rowbase+q0+wid*QBLK)*DM+hv*D;
  { bf16*stg=(bf16*)(shm+LDS_OST)+wid*2048;
    #pragma unroll
    for(int r=0;r<16;++r){const int orow=crow(r,hi);
      #pragma unroll
      for(int d0=0;d0<2;++d0)stg[orow*64+d0*32+r32]=__float2bfloat16(o[d0][r]*rli[r]);}
    asm volatile("s_waitcnt lgkmcnt(0)":::"memory");
    #pragma unroll
    for(int i=0;i<4;++i){const int row=i*8+(lane>>3),ch=lane&7; const u32x4 v=*(const u32x4*)(stg+row*64+ch*8); ATTN_STORE16(Ow+(long)row*DM+ch*8,v);} }
  asm volatile("s_waitcnt lgkmcnt(0)\n\ts_barrier":::"memory");
  #undef DMA_K
  #undef DMA_V
  #undef CMASK
  #undef START
  #undef RESC
  #undef ROT
}
constexpr int ATTN_LDS_BYTES=LDS_BYTES;
struct AttnTensors { const bf16* Q; const bf16* K; const bf16* V; bf16* O0; bf16* O1; };
struct AttnUnit { int combo; int qb; };
struct StaticOrder {
  int vcu, G;
  __device__ __forceinline__ explicit StaticOrder(int grid,int vcu_):vcu(vcu_),G(grid){}
  __device__ __forceinline__ bool next(int i,AttnUnit&u)const{ const int c=vcu+(i>>3)*G; if(c>=BATCH*NHEAD*2)return false; u.combo=c; u.qb=7-(i&7); return true; }
  __device__ __forceinline__ void a_ready(const AttnUnit&)const{}
  __device__ __forceinline__ void done(const AttnUnit&)const{}
};
template<class Sched,int THRL=8> __device__ __forceinline__ void attn_phase(char*lds,const AttnTensors&T,const Sched&S){
  AttnUnit u;
  for(int i=0;S.next(i,u);++i){ S.a_ready(u); const int b=u.combo>>5, hq=(u.combo>>1)&15, vh=u.combo&1; attn_unit<THRL>(b,hq,(hq&~1)+vh,u.qb,T.Q,T.K,T.V,(hq&1)?T.O1:T.O0,lds); S.done(u); }
}
#undef SBAR
#undef WAIT_BAR
}
#define GAS __attribute__((address_space(1)))
#define LAS __attribute__((address_space(3)))
typedef unsigned short bf16;
typedef unsigned v4u __attribute__((ext_vector_type(4)));
typedef float f32x4 __attribute__((ext_vector_type(4)));
typedef short bf16x8 __attribute__((ext_vector_type(8)));
typedef GAS unsigned gu32;
typedef GAS unsigned long long gu64;
#define RLX_AGENT __ATOMIC_RELAXED, __HIP_MEMORY_SCOPE_AGENT
#define LDS_WAIT() asm volatile("s_waitcnt lgkmcnt(0)" ::: "memory")
#define VM_WAIT() asm volatile("s_waitcnt vmcnt(0)" ::: "memory")
__device__ __forceinline__ unsigned long long rt() { return __builtin_amdgcn_s_memrealtime(); }
__device__ __forceinline__ unsigned f2bf(float f) { unsigned u = __builtin_bit_cast(unsigned, f); return (u + 0x7fffu + ((u >> 16) & 1u)) >> 16; }
typedef float pk_f32x2 __attribute__((ext_vector_type(2))); typedef __bf16 pk_bf16x2 __attribute__((ext_vector_type(2)));
__device__ __forceinline__ unsigned pk2(float lo, float hi) { const pk_f32x2 v = {lo, hi}; return __builtin_bit_cast(unsigned, __builtin_convertvector(v, pk_bf16x2)); }

#define XB_TMO      128
#define XB_XCNT(j)  (256  + 64 * (j))
#define XB_XSUB(j)  (1280 + 64 * (j))
#define XB_XGEN(j)  (2304 + 64 * (j))
#define XB_TOP      3328
#define XB_TOPGEN   3392
#define XCD_BAR_WORDS 3456
#define XB_SPIN_CAP (1u << 18)

__device__ __forceinline__ unsigned xb_ld(unsigned* p)              { return __hip_atomic_load(p, __ATOMIC_RELAXED, __HIP_MEMORY_SCOPE_AGENT); }
__device__ __forceinline__ unsigned xb_add(unsigned* p, unsigned v) { return __hip_atomic_fetch_add(p, v, __ATOMIC_RELAXED, __HIP_MEMORY_SCOPE_AGENT); }
__device__ __forceinline__ unsigned xb_xcc_id() { return (unsigned)__builtin_amdgcn_s_getreg((3 << 11) | 20) & 0xFu; }
#define XB_SPIN(cond, bar) do { unsigned _sp = 0; while (cond) { __builtin_amdgcn_s_sleep(1); \
    if ((++_sp & 255u) == 0u) { if (xb_ld(&(bar)[XB_TMO])) break; if (_sp > XB_SPIN_CAP) { atomicAdd(&(bar)[XB_TMO], 1u); break; } } } } while (0)

struct XcdBarrier {
    unsigned* bar; unsigned x;
    volatile LAS unsigned* st;
};

__device__ __forceinline__ XcdBarrier xcd_barrier_post(unsigned* bar, volatile LAS unsigned* st) {
    XcdBarrier b; b.bar = bar; b.x = xb_xcc_id(); b.st = st;
    if (threadIdx.x == 0) (void)xb_add(&bar[XB_XCNT(b.x)], 1u);
    return b;
}
__device__ __forceinline__ void xcd_barrier_complete(unsigned* bar, unsigned x, unsigned& nloc, unsigned& nx) {
    const unsigned G = gridDim.x * gridDim.y * gridDim.z;
    unsigned sum, cnt, mine, sp = 0u;
    for (;;) {
        sum = 0u; cnt = 0u; mine = 0u;
#pragma unroll
        for (unsigned j = 0; j < 16; ++j) { const unsigned c = xb_ld(&bar[XB_XCNT(j)]); sum += c; cnt += (c > 0u) ? 1u : 0u; mine = (j == x) ? c : mine; }
        if (sum == G) break;
        __builtin_amdgcn_s_sleep(1);
        if ((++sp & 255u) == 0u) { if (xb_ld(&bar[XB_TMO])) break; if (sp > XB_SPIN_CAP) { atomicAdd(&bar[XB_TMO], 1u); break; } }
    }
    nloc = mine > 0u ? mine : 1u; nx = cnt > 0u ? cnt : 1u;
}

__device__ __forceinline__ unsigned xcd_barrier_arrive(const XcdBarrier& b) {
    asm volatile("s_waitcnt vmcnt(0)" ::: "memory");
    __syncthreads();
    unsigned target = 0u;
    if (threadIdx.x == 0) {
        unsigned* bar = b.bar;
        __builtin_amdgcn_s_waitcnt(0);
        unsigned nloc = b.st[0], nx = b.st[1];
        if (nloc == 0u) { xcd_barrier_complete(bar, b.x, nloc, nx); b.st[0] = nloc; b.st[1] = nx; }
        const unsigned old = xb_add(&bar[XB_XSUB(b.x)], 1u);
        const unsigned gen = old / nloc;
        if (old + 1u == (gen + 1u) * nloc) {
            __builtin_amdgcn_fence(__ATOMIC_RELEASE, "agent");
            asm volatile("s_waitcnt vmcnt(0)" ::: "memory");
            (void)xb_add(&bar[XB_TOP], 1u);
        }
        target = (gen + 1u) * nx;
    }
    return target;
}
__device__ __forceinline__ void xcd_barrier_wait(const XcdBarrier& b, unsigned target) {
    if (threadIdx.x == 0) {
        unsigned* bar = b.bar;
        XB_SPIN(xb_ld(&bar[XB_TOP]) < target, bar);
        __builtin_amdgcn_fence(__ATOMIC_ACQUIRE, "agent");
        asm volatile("s_waitcnt vmcnt(0)" ::: "memory");
    }
    __syncthreads();
}
__device__ __forceinline__ void xcd_barrier(const XcdBarrier& b) { const unsigned t = xcd_barrier_arrive(b); xcd_barrier_wait(b, t); }

constexpr int NWAVES = 8;
constexpr int D = 1024, MP = 16384, MS = 1024, M = MP + MS;
constexpr int NSEQ = 40;
constexpr int DFF = 2816, AIN = 6144, NMODC = 20480;
constexpr int NPOS = 2080;
constexpr float EPS = 1e-6f;
constexpr float LAM_INIT = 0.35550906759096934f;
constexpr float QSCALE = 0.125f * 1.4426950408889634f;

constexpr size_t MiB = 1u << 20;
constexpr size_t WS_CTL = 0;
constexpr size_t WS_MOD = 1 * MiB;
constexpr size_t ZERO_BYTES = 64 * 1024;
constexpr size_t WS_ROPEA = 5 * MiB, WS_ROPEB = 7 * MiB;
constexpr size_t WS_WFI = 8 * MiB;
constexpr size_t SZ_WFI = (size_t)5632 * 1024 * 2;
constexpr size_t WS_WFO = WS_WFI + 4 * SZ_WFI;
constexpr size_t SZ_WFO = (size_t)1024 * 2816 * 2;
constexpr size_t WS_WIA = WS_WFO + 4 * SZ_WFO;
constexpr size_t WS_WOA = WS_WIA + (size_t)6144 * 1024 * 2;
constexpr size_t WS_WKV = WS_WOA + (size_t)1024 * 2048 * 2;
constexpr size_t WS_WQB = WS_WKV + (size_t)2048 * 1024 * 2;
constexpr size_t WS_WOB = WS_WQB + (size_t)1024 * 1024 * 2;
constexpr size_t WS_ACT = 128 * MiB;
constexpr size_t SZ_A1 = (size_t)M * 1024 * 2, SZ_A2 = (size_t)M * 2048 * 2, SZ_U = (size_t)M * 2816 * 2;
constexpr size_t WS_H = WS_ACT, WS_HKV = WS_H + SZ_A1, WS_Y = WS_HKV + SZ_A1, WS_U = WS_Y + 2 * SZ_A1;
constexpr size_t WS_QR = WS_U + SZ_U, WS_KR = WS_QR + SZ_A1, WS_VR = WS_KR + SZ_A1, WS_GR = WS_VR + SZ_A2, WS_OR = WS_GR + SZ_A2, WS_AR = WS_OR + SZ_A2;
constexpr size_t WS_KB = WS_AR + SZ_A2, WS_VB = WS_KB + SZ_A1, WS_QB = WS_VB + SZ_A1, WS_O0 = WS_QB + SZ_A1, WS_O1 = WS_O0 + SZ_A1, WS_AB = WS_O1 + SZ_A1;
constexpr size_t WS_XB = WS_AB + SZ_A1;
constexpr size_t WS_END = WS_XB + SZ_A1;
static_assert(WS_WOB + (size_t)1024 * 1024 * 2 <= WS_ACT && ZERO_BYTES <= WS_MOD && WS_MOD + (size_t)NSEQ * NMODC * 4 <= WS_ROPEA && WS_ROPEA + (size_t)NPOS * 64 * 8 <= WS_ROPEB && WS_ROPEB + (size_t)NPOS * 32 * 8 <= WS_WFI, "d_ws map");
constexpr size_t OUT_Y = 0, OUT_SRP = (size_t)M * 1024, OUT_KP = OUT_SRP + (size_t)8 * 8 * 128 * 256, OUT_VP = OUT_KP + (size_t)MP * 1024, OUT_SRS = OUT_VP + (size_t)MP * 1024,
                 OUT_KS = OUT_SRS + (size_t)32 * 8 * 128 * 256, OUT_VS = OUT_KS + (size_t)MS * 1024, OUT_END = OUT_VS + (size_t)MS * 1024;
static_assert(OUT_END == 63963136, "d_out map");
constexpr int CW_BAR = 4096;
static_assert((CW_BAR + 3456) * 4 <= (int)ZERO_BYTES, "barrier words inside the zeroed region");

constexpr int RING_OFF = 0, RING_BYTES = 131072;
constexpr int LDSCTL_OFF = RING_BYTES, MISC_OFF = LDSCTL_OFF + 320;
constexpr int LDS_BYTES = 147456;
static_assert(MISC_OFF + 128 <= LDS_BYTES, "LDS map");

static __device__ const double INVF[64] = {
 1.0, 0.8659643233600653, 0.7498942093324559, 0.6493816315762113, 0.5623413251903491, 0.4869675251658631, 0.4216965034285822, 0.3651741272548377, 0.31622776601683794, 0.27384196342643613, 0.23713737056616552, 0.2053525026457146, 0.1778279410038923, 0.1539926526059492, 0.1333521432163324, 0.11547819846894582,
 0.1, 0.08659643233600653, 0.07498942093324558, 0.06493816315762113, 0.05623413251903491, 0.04869675251658631, 0.042169650342858224, 0.03651741272548377, 0.03162277660168379, 0.027384196342643614, 0.023713737056616554, 0.02053525026457146, 0.01778279410038923, 0.01539926526059492, 0.01333521432163324, 0.011547819846894581,
 0.01, 0.008659643233600654, 0.007498942093324558, 0.006493816315762113, 0.005623413251903491, 0.004869675251658631, 0.004216965034285823, 0.003651741272548377, 0.0031622776601683794, 0.0027384196342643613, 0.0023713737056616554, 0.002053525026457146, 0.0017782794100389228, 0.001539926526059492, 0.001333521432163324, 0.0011547819846894581,
 0.001, 0.0008659643233600654, 0.0007498942093324559, 0.0006493816315762113, 0.0005623413251903491, 0.0004869675251658631, 0.00042169650342858224, 0.0003651741272548377, 0.00031622776601683794, 0.0002738419634264361, 0.00023713737056616554, 0.0002053525026457146, 0.00017782794100389227, 0.0001539926526059492, 0.0001333521432163324, 0.00011547819846894582 };
__device__ __forceinline__ float lg2gamma(int h) {
    switch (h) { case 0: return -0.04580368961312479f; case 1: return -0.02272007650008353f; case 2: return -0.011315313227834146f; case 3: return -0.005646563141142063f;
                 case 4: return -0.0028205190623786626f; case 5: return -0.0014095702546713536f; case 6: return -0.0007046129765893727f; default: return -0.0003522634716290214f; }
}
__device__ __forceinline__ float bf2f(unsigned short b) { return __builtin_bit_cast(float, (unsigned)b << 16); }
__device__ __forceinline__ float wave_sum(float v) {
#pragma unroll
    for (int o = 1; o < 64; o <<= 1) v += __shfl_xor(v, o);
    return v;
}
__device__ __forceinline__ void unpack8(const v4u w, float (&f)[8]) {
    f[0] = __builtin_bit_cast(float, w.x << 16); f[1] = __builtin_bit_cast(float, w.x & 0xffff0000u); f[2] = __builtin_bit_cast(float, w.y << 16); f[3] = __builtin_bit_cast(float, w.y & 0xffff0000u);
    f[4] = __builtin_bit_cast(float, w.z << 16); f[5] = __builtin_bit_cast(float, w.z & 0xffff0000u); f[6] = __builtin_bit_cast(float, w.w << 16); f[7] = __builtin_bit_cast(float, w.w & 0xffff0000u);
}
__device__ __forceinline__ v4u pack8f(const float (&f)[8]) { v4u o; o.x = pk2(f[0], f[1]); o.y = pk2(f[2], f[3]); o.z = pk2(f[4], f[5]); o.w = pk2(f[6], f[7]); return o; }
__device__ __forceinline__ v4u ldnt16(const void* p) { return __builtin_nontemporal_load((const GAS v4u*)p); }
__device__ __forceinline__ void ld8nt(const float* p, float (&f)[8]) { const f32x4 a = __builtin_nontemporal_load((const GAS f32x4*)p), b = __builtin_nontemporal_load((const GAS f32x4*)(p + 4)); f[0] = a[0]; f[1] = a[1]; f[2] = a[2]; f[3] = a[3]; f[4] = b[0]; f[5] = b[1]; f[6] = b[2]; f[7] = b[3]; }
__device__ __forceinline__ void ld8(const float* p, float (&f)[8]) { const f32x4 a = *(const GAS f32x4*)p, b = *(const GAS f32x4*)(p + 4); f[0] = a[0]; f[1] = a[1]; f[2] = a[2]; f[3] = a[3]; f[4] = b[0]; f[5] = b[1]; f[6] = b[2]; f[7] = b[3]; }
__device__ __forceinline__ void st8(float* p, const float (&f)[8]) { *(GAS f32x4*)p = (f32x4){f[0], f[1], f[2], f[3]}; *(GAS f32x4*)(p + 4) = (f32x4){f[4], f[5], f[6], f[7]}; }

typedef float f32x16_t __attribute__((ext_vector_type(16)));
__device__ __forceinline__ bf16x8 cvt8(const f32x4 a, const f32x4 b) { const v4u w = {pg8::cvt_pk_bf16(a[0], a[1]), pg8::cvt_pk_bf16(a[2], a[3]), pg8::cvt_pk_bf16(b[0], b[1]), pg8::cvt_pk_bf16(b[2], b[3])}; return __builtin_bit_cast(bf16x8, w); }
struct P0Args { const float *c_p, *c_s, *w_ada, *b_ada, *w_ffn_in, *w_ffn_out, *w_in_a, *w_out_a, *w_ada_kv, *b_ada_kv, *w_kv, *w_q_b, *w_out_b; unsigned char* ws; };
struct TItem { const float* src; bf16* dst; int K, Nsrc, k0, sc0, dr0; float mul; };
constexpr int I_FI = 16 * 176, I_FO = 44 * 32, I_IA = 16 * 192, I_OA = 32 * 32, I_KV = 16 * 64, I_QB = 16 * 32, I_OB = 16 * 32;
constexpr int P0_SET0 = I_FI, P0_SET1 = I_OA + I_FI + I_FO, P0_SET2 = I_OB + I_FI + I_FO, P0_SET3 = 2 * I_FO + I_IA + I_FI + I_KV + I_QB;
constexpr int P0_NITEMS = P0_SET0 + P0_SET1 + P0_SET2 + P0_SET3;
static_assert(P0_NITEMS == 4 * I_FI + 4 * I_FO + I_IA + I_OA + I_KV + I_QB + I_OB, "item sets");
__device__ __forceinline__ TItem p0_item_fi(const P0Args& A, int mi, int r) { TItem t; const int kb = r / 176, nb = r % 176, n0 = 32 * nb;
    const int pn = n0 >> 8, bj = (n0 >> 7) & 1, i0 = n0 & 127;
    t.src = A.w_ffn_in + (size_t)mi * 1024 * 5632; t.dst = (bf16*)(A.ws + WS_WFI + mi * SZ_WFI); t.K = 1024; t.Nsrc = 5632; t.k0 = 64 * kb; t.sc0 = bj * 2816 + 128 * pn + i0; t.dr0 = n0; t.mul = bj ? 0.6931471805599453f : 1.4426950408889634f; return t; }
__device__ __forceinline__ TItem p0_item_fo(const P0Args& A, int mi, int r) { TItem t; const int kb = r / 32, nb = r % 32;
    t.src = A.w_ffn_out + (size_t)mi * 2816 * 1024; t.dst = (bf16*)(A.ws + WS_WFO + mi * SZ_WFO); t.K = 2816; t.Nsrc = 1024; t.k0 = 64 * kb; t.sc0 = 32 * nb; t.dr0 = 32 * nb; t.mul = 1.0f; return t; }
__device__ __forceinline__ TItem p0_item_sq(const float* src, bf16* dst, int K, int r) { TItem t; const int kb = r / 32, nb = r % 32;
    t.src = src; t.dst = dst; t.K = K; t.Nsrc = 1024; t.k0 = 64 * kb; t.sc0 = 32 * nb; t.dr0 = 32 * nb; t.mul = 1.0f; return t; }
template <int SET> __device__ __forceinline__ TItem p0_decode(const P0Args& A, int r  ) {
    TItem t;
    if (SET == 0) { return p0_item_fi(A, 0, r);
    } else if (SET == 3) {
    if (r < I_FO) return p0_item_fo(A, 0, r); r -= I_FO;
    if (r < I_IA) { const int kb = r / 192, nb = r % 192, n0 = 32 * nb; int sc0 = n0;
        if (n0 < 2048) { const int sec = n0 >> 10, pn4 = (n0 >> 8) & 3, bj = (n0 >> 7) & 1, hh = (n0 >> 6) & 1, d = n0 & 63;
            sc0 = sec * 1024 + (2 * pn4 + hh) * 128 + d + 64 * bj; }
        t.src = A.w_in_a; t.dst = (bf16*)(A.ws + WS_WIA); t.K = 1024; t.Nsrc = 6144; t.k0 = 64 * kb; t.sc0 = sc0; t.dr0 = n0; t.mul = 1.0f; return t; }
    r -= I_IA;
    if (r < I_FI) return p0_item_fi(A, 2, r); r -= I_FI;
    if (r < I_KV) { const int kb = r / 64, nb = r % 64, n0 = 32 * nb; int sc0 = n0;
        if (n0 < 1024) { const int pn = n0 >> 8, bj = (n0 >> 7) & 1, g = (n0 >> 5) & 3; sc0 = (4 * pn + g) * 64 + 32 * bj; }
        t.src = A.w_kv; t.dst = (bf16*)(A.ws + WS_WKV); t.K = 1024; t.Nsrc = 2048; t.k0 = 64 * kb; t.sc0 = sc0; t.dr0 = n0; t.mul = 1.0f; return t; }
    r -= I_KV;
    if (r < I_FO) return p0_item_fo(A, 2, r); r -= I_FO;
    { const int kb = r / 32, nb = r % 32, n0 = 32 * nb; const int pn = n0 >> 8, bj = (n0 >> 7) & 1, g = (n0 >> 5) & 3;
        t.src = A.w_q_b; t.dst = (bf16*)(A.ws + WS_WQB); t.K = 1024; t.Nsrc = 1024; t.k0 = 64 * kb; t.sc0 = (4 * pn + g) * 64 + 32 * bj; t.dr0 = n0; t.mul = 1.0f; return t; }
    } else if (SET == 1) {
    if (r < I_OA) return p0_item_sq(A.w_out_a, (bf16*)(A.ws + WS_WOA), 2048, r); r -= I_OA;
    if (r < I_FI) return p0_item_fi(A, 1, r); r -= I_FI;
    return p0_item_fo(A, 1, r);
    } else {
    if (r < I_OB) return p0_item_sq(A.w_out_b, (bf16*)(A.ws + WS_WOB), 1024, r); r -= I_OB;
    if (r < I_FI) return p0_item_fi(A, 3, r); r -= I_FI;
    return p0_item_fo(A, 3, r);
    }
}
__device__ __forceinline__ void p0_tload(const TItem& t, f32x4 (&v)[8], int lane) {
    const float* p = t.src + (size_t)(t.k0 + (lane >> 3)) * t.Nsrc + t.sc0 + 4 * (lane & 7);
#pragma unroll
    for (int i = 0; i < 8; ++i) v[i] = __builtin_nontemporal_load((const GAS f32x4*)(p + (size_t)(8 * i) * t.Nsrc));
}
__device__ __forceinline__ void p0_tstore(const TItem& t, const f32x4 (&v)[8], LAS float* scr, int lane) {
    { const int kr = lane >> 3, c4 = 4 * (lane & 7);
#pragma unroll
      for (int i = 0; i < 8; ++i) { LAS float* d = scr + (kr + 8 * i) * 33 + c4; d[0] = v[i][0]; d[1] = v[i][1]; d[2] = v[i][2]; d[3] = v[i][3]; } }
    LDS_WAIT(); asm volatile("" ::: "memory");
    const int c = lane & 7;
#pragma unroll
    for (int j = 0; j < 4; ++j) { const int n = (lane >> 3) + 8 * j; const LAS float* s = scr + (8 * c) * 33 + n;
        const float ml = t.mul; v4u o; o.x = pk2(s[0 * 33] * ml, s[1 * 33] * ml); o.y = pk2(s[2 * 33] * ml, s[3 * 33] * ml); o.z = pk2(s[4 * 33] * ml, s[5 * 33] * ml); o.w = pk2(s[6 * 33] * ml, s[7 * 33] * ml);
        *(GAS v4u*)(t.dst + (size_t)(t.dr0 + n) * t.K + t.k0 + 8 * c) = o; }
    LDS_WAIT(); asm volatile("" ::: "memory");
}
template <int SET> __device__ __forceinline__ void p0_convert(const P0Args& A, LAS unsigned char* lds, int gw, int NGW, int lane, int wave, int it0 = 0, int it1 = (SET == 0 ? P0_SET0 : SET == 1 ? P0_SET1 : SET == 2 ? P0_SET2 : P0_SET3)) {
    LAS float* scr = (LAS float*)(lds + RING_OFF + wave * 16384);
    int it = it0 + gw; f32x4 cur[8], nxt[8]; TItem tc, tn;
    if (it < it1) { tc = p0_decode<SET>(A, it); p0_tload(tc, cur, lane); }
    while (it < it1) {
        const int nit = it + NGW;
        if (nit < it1) { tn = p0_decode<SET>(A, nit); p0_tload(tn, nxt, lane); }
        p0_tstore(tc, cur, scr, lane);
#pragma unroll
        for (int i = 0; i < 8; ++i) cur[i] = nxt[i];
        tc = tn; it = nit;
    }
}
typedef float f32x2_t __attribute__((ext_vector_type(2)));
__device__ __forceinline__ void p0_mod(const P0Args& A, LAS unsigned char* lds, int first, int last, int start, int step, int tid, int lane, int wave) {
    {   LAS float* red = (LAS float*)(lds + RING_OFF);
        float* MODw = (float*)(A.ws + WS_MOD);
        const int r32 = lane & 31, hi = lane >> 5;
        for (int jt = first + start; jt < last; jt += step) {
            const int g = jt >> 5, gc = g < 11 ? g : (g < 13 ? g + 7 : g - 2);
            const int col0 = 1024 * gc + 32 * (jt & 31); const float* W; const float* bias; int N, col;
            if (col0 < 9216) { W = A.w_ada; bias = A.b_ada; N = 9216; col = col0; }
            else if (col0 < 18432) { W = A.w_ada + (size_t)1024 * 9216; bias = A.b_ada + 9216; N = 9216; col = col0 - 9216; }
            else { W = A.w_ada_kv; bias = A.b_ada_kv; N = 2048; col = col0 - 18432; }
            const int kw = 128 * wave; const int loff = hi * 8 * N + r32;
            const float* c0p = (r32 < 8 ? A.c_p + r32 * 1024 : A.c_s + (r32 - 8) * 1024) + kw + 8 * hi;
            const float* c1p = A.c_s + (24 + (r32 & 7)) * 1024 + kw + 8 * hi;
            f32x16_t acc0, acc1;
#pragma unroll
            for (int r = 0; r < 16; ++r) { acc0[r] = 0.f; acc1[r] = 0.f; }
#pragma nounroll
            for (int hf = 0; hf < 2; ++hf) {
                float wv[4][8];
#pragma unroll
                for (int st = 0; st < 4; ++st)
#pragma unroll
                    for (int j = 0; j < 8; ++j) { const float* rowb = W + (size_t)(kw + 64 * hf + 16 * st + j) * N + col; wv[st][j] = __builtin_nontemporal_load((const GAS float*)(rowb + loff)); }
#pragma unroll
                for (int st = 0; st < 4; ++st) {
                    float ca[8], cb[8]; ld8(c0p + 64 * hf + 16 * st, ca); ld8(c1p + 64 * hf + 16 * st, cb);
#pragma unroll
                    for (int j = 0; j < 8; ++j) { ca[j] = ca[j] / (1.0f + __expf(-ca[j])); cb[j] = (r32 < 8) ? cb[j] / (1.0f + __expf(-cb[j])) : 0.f; }
                    const bf16x8 bfr = cvt8((f32x4){wv[st][0], wv[st][1], wv[st][2], wv[st][3]}, (f32x4){wv[st][4], wv[st][5], wv[st][6], wv[st][7]});
                    acc0 = __builtin_amdgcn_mfma_f32_32x32x16_bf16(cvt8((f32x4){ca[0], ca[1], ca[2], ca[3]}, (f32x4){ca[4], ca[5], ca[6], ca[7]}), bfr, acc0, 0, 0, 0);
                    acc1 = __builtin_amdgcn_mfma_f32_32x32x16_bf16(cvt8((f32x4){cb[0], cb[1], cb[2], cb[3]}, (f32x4){cb[4], cb[5], cb[6], cb[7]}), bfr, acc1, 0, 0, 0);
                }
            }
#pragma unroll
            for (int r = 0; r < 16; ++r) { const int sq = (r & 3) + 8 * (r >> 2) + 4 * hi; red[(wave * 40 + sq) * 32 + r32] = acc0[r]; if (sq < 8) red[(wave * 40 + 32 + sq) * 32 + r32] = acc1[r]; }
            __syncthreads();
            for (int u = tid; u < NSEQ * 32; u += NWAVES * 64) { float v = bias[col + (u & 31)];
#pragma unroll
                for (int w8 = 0; w8 < 8; ++w8) v += red[w8 * 40 * 32 + u];
                MODw[(size_t)(u >> 5) * NMODC + col0 + (u & 31)] = v; }
            __syncthreads();
        }
    }
}
__device__ __forceinline__ void p0_rest(const P0Args& A, LAS unsigned char* lds, int vcu, int G, int tid, int lane, int wave) {
    const int gw = vcu * NWAVES + wave, NGW = G * NWAVES;
    p0_convert<0>(A, lds, gw, NGW, lane, wave);
    float* RA = (float*)(A.ws + WS_ROPEA); float* RB = (float*)(A.ws + WS_ROPEB);
    for (int e = gw * 64 + lane; e < NPOS * 64; e += NGW * 64) {
        const int pi = e >> 6, d = e & 63; const double pos = (double)(pi < 2048 ? pi : 4096 + (pi - 2048));
        const double t = pos * INVF[d] * 0.15915494309189535; const float fr = (float)(t - floor(t));
        const float cs = __builtin_amdgcn_cosf(fr), sn = __builtin_amdgcn_sinf(fr);
        RA[2 * e] = cs; RA[2 * e + 1] = sn;
        if ((d & 1) == 0) { const int eb = pi * 32 + (d >> 1); RB[2 * eb] = cs; RB[2 * eb + 1] = sn; }
    }
}

struct RowOut { const float* gn; int shift_off, scale_off; bf16* dst; };
template <bool HAS_Y, int NOUT, bool XIN_BF, int XOUT  >
__device__ __forceinline__ void rowpass(const float* xp, const float* xs  , bf16* xb  , const bf16* Y, const float* gw, int gate_off, float gs, float* xdst,
                                        const RowOut o0, const RowOut o1, const float* MOD, int gw_id, int NGW, int lane, int ykdim, int G) {
    const int c0 = 8 * lane;
    pg8::StreamK SK; if (HAS_Y) SK.init(M, 1024, ykdim, G, 0);
    for (int seg = 0; seg < 2; ++seg) {
        const int nblk = seg == 0 ? MP / 8 : MS;
        for (int bi = gw_id; bi < nblk; bi += NGW) {
            const int r0 = seg == 0 ? 8 * bi : MP + bi, nr = seg == 0 ? 8 : 1;
            const int seq = r0 < MP ? (r0 >> 11) : 8 + ((r0 - MP) >> 5);
            const float* mrow = MOD + (size_t)seq * NMODC;
            bool two[2] = {false, false};
            if (HAS_Y) { _Pragma("unroll") for (int j = 0; j < 2; ++j) two[j] = SK.pieces((r0 >> 8) * 4 + (lane >> 5) + 2 * j) > 1; }
            float A1[2][8], B0[2][8], S0[2][8], B1[2][8], S1[2][8];
#pragma unroll
            for (int j = 0; j < 2; ++j) {
                if (HAS_Y) { float g[8], t[8]; ld8(gw + c0 + 512 * j, g); ld8(mrow + gate_off + c0 + 512 * j, t);
#pragma unroll
                    for (int e = 0; e < 8; ++e) A1[j][e] = gs * t[e] * g[e]; }
                if (NOUT >= 1) { float g[8], t[8]; ld8(o0.gn + c0 + 512 * j, g); ld8(mrow + o0.scale_off + c0 + 512 * j, t); ld8(mrow + o0.shift_off + c0 + 512 * j, S0[j]);
#pragma unroll
                    for (int e = 0; e < 8; ++e) B0[j][e] = g[e] * (1.0f + t[e]); }
                if (NOUT >= 2) { float g[8], t[8]; ld8(o1.gn + c0 + 512 * j, g); ld8(mrow + o1.scale_off + c0 + 512 * j, t); ld8(mrow + o1.shift_off + c0 + 512 * j, S1[j]);
#pragma unroll
                    for (int e = 0; e < 8; ++e) B1[j][e] = g[e] * (1.0f + t[e]); }
            }
            for (int rr = 0; rr < nr; ++rr) {
                const int r = r0 + rr;
                float x[2][8];
                if (XIN_BF) {
#pragma unroll
                    for (int j = 0; j < 2; ++j) unpack8(ldnt16(xb + (size_t)r * 1024 + c0 + 512 * j), x[j]);
                } else { const float* xrow = (r < MP) ? xp + (size_t)r * 1024 : xs + (size_t)(r - MP) * 1024;
#pragma unroll
                    for (int j = 0; j < 2; ++j) ld8nt(xrow + c0 + 512 * j, x[j]); }
                if (HAS_Y) {
                    float y[2][8]; float ss = 0.f;
#pragma unroll
                    for (int j = 0; j < 2; ++j) { unpack8(ldnt16(Y + (size_t)r * 1024 + c0 + 512 * j), y[j]);
                        if (two[j]) { float y2[8]; unpack8(ldnt16(Y + SZ_A1 / 2 + (size_t)r * 1024 + c0 + 512 * j), y2); _Pragma("unroll") for (int e = 0; e < 8; ++e) y[j][e] += y2[e]; }
#pragma unroll
                        for (int e = 0; e < 8; ++e) ss += y[j][e] * y[j][e]; }
                    const float rstd = rsqrtf(wave_sum(ss) * (1.0f / 1024.0f) + EPS);
#pragma unroll
                    for (int j = 0; j < 2; ++j)
#pragma unroll
                        for (int e = 0; e < 8; ++e) x[j][e] += A1[j][e] * (y[j][e] * rstd);
                }
                if (XOUT == 2) {
#pragma unroll
                    for (int j = 0; j < 2; ++j) st8(xdst + (size_t)r * 1024 + c0 + 512 * j, x[j]);
                }
                if (XOUT == 1) {
#pragma unroll
                    for (int j = 0; j < 2; ++j) __builtin_nontemporal_store(pack8f(x[j]), (GAS v4u*)(xb + (size_t)r * 1024 + c0 + 512 * j));
                }
                if (NOUT >= 1) {
                    float ss = 0.f;
#pragma unroll
                    for (int j = 0; j < 2; ++j)
#pragma unroll
                        for (int e = 0; e < 8; ++e) ss += x[j][e] * x[j][e];
                    const float rstd = rsqrtf(wave_sum(ss) * (1.0f / 1024.0f) + EPS);
#pragma unroll
                    for (int j = 0; j < 2; ++j) { float h[8];
#pragma unroll
                        for (int e = 0; e < 8; ++e) h[e] = (x[j][e] * rstd) * B0[j][e] + S0[j][e];
                        *(GAS v4u*)(o0.dst + (size_t)r * 1024 + c0 + 512 * j) = pack8f(h);
                        if (NOUT >= 2) {
#pragma unroll
                            for (int e = 0; e < 8; ++e) h[e] = (x[j][e] * rstd) * B1[j][e] + S1[j][e];
                            *(GAS v4u*)(o1.dst + (size_t)r * 1024 + c0 + 512 * j) = pack8f(h); } }
                }
            }
        }
    }
}
__device__ __forceinline__ void gatenorm_pass(const bf16* OR_, const bf16* GR, const float* ggn, bf16* AR, int gw_id, int NGW, int lane) {
    float gg[4][8];
#pragma unroll
    for (int j = 0; j < 4; ++j) ld8(ggn + 8 * lane + 512 * j, gg[j]);
    for (int r = gw_id; r < M; r += NGW) {
#pragma unroll
        for (int j = 0; j < 4; ++j) { const size_t off = (size_t)r * 2048 + 8 * lane + 512 * j;
            float o[8], g[8]; unpack8(ldnt16(OR_ + off), o); unpack8(ldnt16(GR + off), g);
            float ss = 0.f;
#pragma unroll
            for (int e = 0; e < 8; ++e) ss += o[e] * o[e];
#pragma unroll
            for (int k = 1; k < 32; k <<= 1) ss += __shfl_xor(ss, k);
            const float rstd = rsqrtf(ss * (1.0f / 256.0f) + EPS);
            float a[8];
#pragma unroll
            for (int e = 0; e < 8; ++e) a[e] = pg8::silu_f(g[e]) * ((o[e] * rstd) * gg[j][e]);
            *(GAS v4u*)(AR + off) = pack8f(a); }
    }
}
__device__ __forceinline__ void diffnorm_pass(const bf16* O0, const bf16* O1, const float* lamp  , const float* gsub  , bf16* AB, int gw_id, int NGW, int lane) {
    const float s01 = wave_sum(lamp[lane] * lamp[64 + lane]), s23 = wave_sum(lamp[128 + lane] * lamp[192 + lane]);
    const float lam = expf(s01) - expf(s23) + LAM_INIT;
    float gs[8]; ld8(gsub + 8 * (lane & 15), gs);
#pragma unroll
    for (int e = 0; e < 8; ++e) gs[e] *= (1.0f - LAM_INIT);
    for (int r = gw_id; r < M; r += NGW) {
#pragma unroll
        for (int j = 0; j < 2; ++j) { const size_t off = (size_t)r * 1024 + 8 * lane + 512 * j;
            float a[8], b[8]; unpack8(ldnt16(O0 + off), a); unpack8(ldnt16(O1 + off), b);
            float ss = 0.f;
#pragma unroll
            for (int e = 0; e < 8; ++e) { a[e] -= lam * b[e]; ss += a[e] * a[e]; }
#pragma unroll
            for (int k = 1; k < 16; k <<= 1) ss += __shfl_xor(ss, k);
            const float rstd = rsqrtf(ss * (1.0f / 128.0f) + EPS);
#pragma unroll
            for (int e = 0; e < 8; ++e) a[e] = (a[e] * rstd) * gs[e];
            *(GAS v4u*)(AB + off) = pack8f(a); }
    }
}

typedef float f32x4_t __attribute__((ext_vector_type(4)));
typedef short v4s_t __attribute__((ext_vector_type(4)));
__device__ __forceinline__ f32x4_t mfma16(const bf16x8 a, const bf16x8 b, const f32x4_t c) { return __builtin_amdgcn_mfma_f32_16x16x32_bf16(a, b, c, 0, 0, 0); }
__device__ __forceinline__ bf16x8 tr16(const LAS unsigned char* p, int skip_bytes) {
    const v4s_t lo = __builtin_amdgcn_ds_read_tr16_b64_v4i16((LAS v4s_t*)p), hi = __builtin_amdgcn_ds_read_tr16_b64_v4i16((LAS v4s_t*)(p + skip_bytes));
    return (bf16x8){lo[0], lo[1], lo[2], lo[3], hi[0], hi[1], hi[2], hi[3]};
}
#define WG_BAR_L() do { asm volatile("s_waitcnt lgkmcnt(0)" ::: "memory"); __builtin_amdgcn_s_barrier(); asm volatile("" ::: "memory"); } while (0)
template <int N, int NVT, bool DB>
__device__ __forceinline__ void ret_unit(LAS unsigned char* lds, const bf16* QR_, const bf16* KR_, const bf16* VR_, bf16* ORo, const float* S_in, float* S_out,
                                         int row0, int nchunks, int h, int vbase, int tid, int lane, int wave) {
    constexpr int QP = 136, VP = NVT * 16 + 8, NTI = N / 16, WPT = 8 / NTI, TVW = NVT / WPT, NKS = N / 32;
    constexpr int OFF_K = N * QP * 2, OFF_V = 2 * N * QP * 2, SETB = OFF_V + N * VP * 2, NSET = DB ? 2 : 1, STB = NVT * 16 * QP * 2, OFF_ST = NSET * SETB;
    static_assert(OFF_ST + NSET * STB <= RING_BYTES, "retention LDS");
    const float lg = lg2gamma(h);
    const int l15 = lane & 15, l4 = lane >> 4, trq = (lane & 15) >> 2, trp = lane & 3;
    const int ti = wave / WPT, tv0 = TVW * (wave % WPT);
    constexpr int NPQ = N * 16 / 512;
    constexpr int VPR = NVT * 2;
    constexpr int NPV = (N * VPR + 511) / 512;
    f32x4_t Sacc[NVT];
    if (DB) {
#pragma unroll
        for (int tv = 0; tv < NVT; ++tv) Sacc[tv] = (f32x4_t){0.f, 0.f, 0.f, 0.f};
    } else {
#pragma unroll
        for (int tv = 0; tv < NVT; ++tv)
#pragma unroll
            for (int rg = 0; rg < 4; ++rg) Sacc[tv][rg] = __builtin_nontemporal_load((const GAS float*)(S_in + (size_t)(16 * wave + 4 * l4 + rg) * 256 + vbase + 16 * tv + l15));
    }
#pragma unroll
    for (int tv = 0; tv < NVT; ++tv) {
        unsigned long long w = (unsigned long long)pk2(Sacc[tv][0], Sacc[tv][1]) | ((unsigned long long)pk2(Sacc[tv][2], Sacc[tv][3]) << 32);
        *(LAS unsigned long long*)(lds + OFF_ST + ((16 * tv + l15) * QP + 16 * wave + 4 * l4) * 2) = w;
    }
    const float qdec = __builtin_amdgcn_exp2f(lg * (float)(16 * ti + l15)), cdec = __builtin_amdgcn_exp2f(lg * (float)N);
    float kdec[NKS][8];
#pragma unroll
    for (int ks = 0; ks < NKS; ++ks)
#pragma unroll
        for (int e = 0; e < 8; ++e) kdec[ks][e] = __builtin_amdgcn_exp2f(lg * (float)(N - (32 * ks + 8 * l4 + e)));
    v4u qreg[NPQ], kreg[NPQ], vreg[NPV];
#define RET_FETCH(c) do { _Pragma("unroll") for (int i_ = 0; i_ < NPQ; ++i_) { const int p_ = tid + 512 * i_, row_ = p_ >> 4, c8_ = p_ & 15; const size_t g_ = (size_t)(row0 + (c) * N + row_) * 1024 + h * 128 + 8 * c8_; \
            qreg[i_] = *(const GAS v4u*)(QR_ + g_); kreg[i_] = *(const GAS v4u*)(KR_ + g_); } \
        _Pragma("unroll") for (int i_ = 0; i_ < NPV; ++i_) { const int p_ = tid + 512 * i_; if (p_ < N * VPR) { const int row_ = p_ / VPR, c8_ = p_ % VPR; vreg[i_] = __builtin_nontemporal_load((const GAS v4u*)(VR_ + (size_t)(row0 + (c) * N + row_) * 2048 + h * 256 + vbase + 8 * c8_)); } } } while (0)
#define RET_STAGE(set) do { LAS unsigned char* sb_ = lds + (set) * SETB; \
        _Pragma("unroll") for (int i_ = 0; i_ < NPQ; ++i_) { const int p_ = tid + 512 * i_, row_ = p_ >> 4, c8_ = p_ & 15; *(LAS v4u*)(sb_ + (row_ * QP + 8 * c8_) * 2) = qreg[i_]; *(LAS v4u*)(sb_ + OFF_K + (row_ * QP + 8 * c8_) * 2) = kreg[i_]; } \
        _Pragma("unroll") for (int i_ = 0; i_ < NPV; ++i_) { const int p_ = tid + 512 * i_; if (p_ < N * VPR) { const int row_ = p_ / VPR, c8_ = p_ % VPR; *(LAS v4u*)(sb_ + OFF_V + (row_ * VP + 8 * c8_) * 2) = vreg[i_]; } } } while (0)
    RET_FETCH(0); RET_STAGE(0);
    if (nchunks > 1) RET_FETCH(1);
    WG_BAR_L();
    for (int c = 0; c < nchunks; ++c) {
        const int set = DB ? (c & 1) : 0;
        const LAS unsigned char* Qs = lds + set * SETB; const LAS unsigned char* Ks = Qs + OFF_K; const LAS unsigned char* Vs = Qs + OFF_V;
        const LAS unsigned char* STr = lds + OFF_ST + set * STB; LAS unsigned char* STw = lds + OFF_ST + (DB ? (set ^ 1) : 0) * STB;
        bf16x8 qf[4];
#pragma unroll
        for (int ks = 0; ks < 4; ++ks) qf[ks] = *(const LAS bf16x8*)(Qs + ((16 * ti + l15) * QP + 32 * ks + 8 * l4) * 2);
        bf16x8 pfr[NKS];
        { f32x4_t sT[NTI];
#pragma unroll
          for (int tj = 0; tj < NTI; ++tj) { f32x4_t acc = (f32x4_t){0.f, 0.f, 0.f, 0.f};
#pragma unroll
              for (int ks = 0; ks < 4; ++ks) acc = mfma16(*(const LAS bf16x8*)(Ks + ((16 * tj + l15) * QP + 32 * ks + 8 * l4) * 2), qf[ks], acc);
#pragma unroll
              for (int rg = 0; rg < 4; ++rg) { const int i = 16 * ti + l15, j = 16 * tj + 4 * l4 + rg; const int dd = i > j ? i - j : j - i; acc[rg] *= __builtin_amdgcn_exp2f(lg * (float)dd); }
              sT[tj] = acc; }
#pragma unroll
          for (int s2 = 0; s2 < NKS; ++s2) pfr[s2] = cvt8(sT[2 * s2], sT[2 * s2 + 1]); }
#pragma unroll
        for (int n = 0; n < TVW; ++n) { const int tv = tv0 + n; f32x4_t acc = (f32x4_t){0.f, 0.f, 0.f, 0.f};
#pragma unroll
            for (int ks = 0; ks < 4; ++ks) acc = mfma16(*(const LAS bf16x8*)(STr + ((16 * tv + l15) * QP + 32 * ks + 8 * l4) * 2), qf[ks], acc);
            acc = acc * qdec;
#pragma unroll
            for (int s2 = 0; s2 < NKS; ++s2) acc = mfma16(tr16(Vs + ((32 * s2 + 4 * l4 + trq) * VP + 16 * tv + 4 * trp) * 2, 16 * VP * 2), pfr[s2], acc);
            const unsigned long long w = (unsigned long long)pk2(acc[0], acc[1]) | ((unsigned long long)pk2(acc[2], acc[3]) << 32);
            *(GAS unsigned long long*)(ORo + (size_t)(row0 + c * N + 16 * ti + l15) * 2048 + h * 256 + vbase + 16 * tv + 4 * l4) = w; }
        { bf16x8 ka[NKS];
#pragma unroll
          for (int ks = 0; ks < NKS; ++ks) { const bf16x8 kr = tr16(Ks + ((32 * ks + 8 * l4 + trq) * QP + 16 * wave + 4 * trp) * 2, 4 * QP * 2);
              float kf[8]; unpack8(__builtin_bit_cast(v4u, kr), kf);
#pragma unroll
              for (int e = 0; e < 8; ++e) kf[e] *= kdec[ks][e];
              ka[ks] = cvt8((f32x4){kf[0], kf[1], kf[2], kf[3]}, (f32x4){kf[4], kf[5], kf[6], kf[7]}); }
#pragma unroll
          for (int tv = 0; tv < NVT; ++tv) { Sacc[tv] = Sacc[tv] * cdec;
#pragma unroll
            for (int ks = 0; ks < NKS; ++ks) Sacc[tv] = mfma16(ka[ks], tr16(Vs + ((32 * ks + 8 * l4 + trq) * VP + 16 * tv + 4 * trp) * 2, 4 * VP * 2), Sacc[tv]);
            if (DB) { const unsigned long long w = (unsigned long long)pk2(Sacc[tv][0], Sacc[tv][1]) | ((unsigned long long)pk2(Sacc[tv][2], Sacc[tv][3]) << 32);
                *(LAS unsigned long long*)(STw + ((16 * tv + l15) * QP + 16 * wave + 4 * l4) * 2) = w; } } }
        if (DB && c + 1 < nchunks) { RET_STAGE(set ^ 1); if (c + 2 < nchunks) RET_FETCH(c + 2); }
        WG_BAR_L();
    }
#undef RET_FETCH
#undef RET_STAGE
#pragma unroll
    for (int tv = 0; tv < NVT; ++tv)
#pragma unroll
        for (int rg = 0; rg < 4; ++rg) __builtin_nontemporal_store(Sacc[tv][rg], (GAS float*)(S_out + (size_t)(16 * wave + 4 * l4 + rg) * 256 + vbase + 16 * tv + l15));
}

__device__ __forceinline__ void sattn_unit(LAS unsigned char* lds, int b, int h, const bf16* QB_, const bf16* Q2_  , const float* ck, const float* cv, const float* knew, const float* vnew, bf16* O0_, bf16* O1_, int tid, int lane, int wave) {
    constexpr int NSL = 3, KPITCH = 272, VPITCH = 320, VOFF = 64 * KPITCH, SLOT = VOFF + 64 * VPITCH, NST = 65, PD = 3;
    static_assert(NSL * SLOT <= RING_BYTES && PD == 3 && SLOT % 16 == 0, "sample attention LDS / the counted wait is (PD - 1) * 8 = 16");
    const int t = wave >> 2, kh = (wave >> 1) & 1, vh2 = wave & 1, r32 = lane & 31, hi = lane >> 5;
    bf16x8 qf[4];
    { const bf16* qp = QB_ + (size_t)(MP + 32 * b + r32) * 1024 + (2 * h + t) * 64 + 8 * hi;
      const bf16* qp2 = Q2_ + (size_t)(32 * b + r32) * 1024 + (2 * h + t) * 64 + 8 * hi;
#pragma unroll
      for (int ks = 0; ks < 4; ++ks) { float qa[8]; unpack8(*(const GAS v4u*)(qp + 16 * ks), qa);
#pragma unroll
          for (int pc = 0; pc < 3; ++pc) { float qb2[8]; unpack8(*(const GAS v4u*)(qp2 + (size_t)pc * (1024 * 1024) + 16 * ks), qb2);
#pragma unroll
              for (int e = 0; e < 8; ++e) qa[e] += qb2[e]; }
          qf[ks] = __builtin_bit_cast(bf16x8, pack8f(qa)); }
      asm volatile("s_waitcnt vmcnt(0)" ::: "memory");
#pragma unroll
      for (int ks = 0; ks < 4; ++ks) asm volatile("" : "+v"(qf[ks])); }
    size_t gko[4], gkn[4]; int lko[4], lvo[4];
#pragma unroll
    for (int i = 0; i < 4; ++i) { const int key = (tid >> 5) + 16 * i, pp = tid & 31;
        gko[i] = (size_t)key * 1024 + h * 128 + pp * 4; gkn[i] = (size_t)(key & 31) * 1024 + h * 128 + pp * 4;
        lko[i] = key * KPITCH + pp * 8; lvo[i] = VOFF + key * VPITCH + pp * 8; }
    const float* kbase = ck + (size_t)b * 4096 * 1024; const float* vbase = cv + (size_t)b * 4096 * 1024;
    const float* knb = knew + (size_t)(32 * b) * 1024; const float* vnb = vnew + (size_t)(32 * b) * 1024;
    f32x4 st[PD][8];
#define SA_LOAD(stile, sg) do { const int s_i = (stile) < NST ? (stile) : NST - 1; const bool lastt = s_i == NST - 1; \
        const float* kb_ = lastt ? knb : kbase + (size_t)s_i * 64 * 1024; const float* vb_ = lastt ? vnb : vbase + (size_t)s_i * 64 * 1024; \
        _Pragma("unroll") for (int i_ = 0; i_ < 4; ++i_) { \
            asm volatile("global_load_dwordx4 %0, %1, off nt" : "=&v"(st[sg][i_]) : "v"(kb_ + (lastt ? gkn[i_] : gko[i_])) : "memory"); \
            asm volatile("global_load_dwordx4 %0, %1, off nt" : "=&v"(st[sg][4 + i_]) : "v"(vb_ + (lastt ? gkn[i_] : gko[i_])) : "memory"); } } while (0)
#define SA_WRITE(stile, sg) do { LAS unsigned char* sl_ = lds + ((stile) % NSL) * SLOT; \
        asm volatile("s_waitcnt vmcnt(16)" : "+v"(st[sg][0]), "+v"(st[sg][1]), "+v"(st[sg][2]), "+v"(st[sg][3]), "+v"(st[sg][4]), "+v"(st[sg][5]), "+v"(st[sg][6]), "+v"(st[sg][7]) :: "memory"); \
        _Pragma("unroll") for (int i_ = 0; i_ < 4; ++i_) { \
            *(LAS unsigned long long*)(sl_ + lko[i_]) = (unsigned long long)pg8::cvt_pk_bf16(st[sg][i_][0], st[sg][i_][1]) | ((unsigned long long)pg8::cvt_pk_bf16(st[sg][i_][2], st[sg][i_][3]) << 32); \
            *(LAS unsigned long long*)(sl_ + lvo[i_]) = (unsigned long long)pg8::cvt_pk_bf16(st[sg][4 + i_][0], st[sg][4 + i_][1]) | ((unsigned long long)pg8::cvt_pk_bf16(st[sg][4 + i_][2], st[sg][4 + i_][3]) << 32); } } while (0)
#pragma unroll
    for (int k = 0; k < PD; ++k) SA_LOAD(k, k);
    SA_WRITE(0, 0); SA_LOAD(PD, 0);
    asm volatile("s_waitcnt lgkmcnt(0)" ::: "memory"); __builtin_amdgcn_s_barrier(); asm volatile("" ::: "memory");
    float mrun = -1e30f, lrun = 0.f; f32x16_t o0, o1;
#pragma unroll
    for (int r = 0; r < 16; ++r) { o0[r] = 0.f; o1[r] = 0.f; }
    const int koffs = (32 * kh + r32) * KPITCH + (64 * t + 8 * hi) * 2;
    const int voffs = VOFF + (32 * kh + 4 * hi + ((lane & 15) >> 2)) * VPITCH + (64 * vh2 + 16 * ((lane >> 4) & 1) + 4 * (lane & 3)) * 2;
    for (int t0 = 0; t0 < (NST + PD - 1) / PD * PD; t0 += PD) {
#pragma unroll
      for (int u = 0; u < PD; ++u) { const int stile = t0 + u;
        SA_WRITE(stile + 1, (u + 1) % PD); SA_LOAD(stile + 1 + PD, (u + 1) % PD);
        if (stile < NST - kh) {
        const LAS unsigned char* slot = lds + (stile % NSL) * SLOT;
        f32x16_t s_;
#pragma unroll
        for (int r = 0; r < 16; ++r) s_[r] = 0.f;
#pragma unroll
        for (int ks = 0; ks < 4; ++ks) s_ = __builtin_amdgcn_mfma_f32_32x32x16_bf16(*(const LAS bf16x8*)(slot + koffs + 32 * ks), qf[ks], s_, 0, 0, 0);
        bf16x8 vf[2][2];
#pragma unroll
        for (int s2 = 0; s2 < 2; ++s2)
#pragma unroll
            for (int bk = 0; bk < 2; ++bk) vf[s2][bk] = tr16(slot + voffs + (16 * s2) * VPITCH + (32 * bk) * 2, 8 * VPITCH);
        float mx = s_[0];
#pragma unroll
        for (int r = 1; r < 16; ++r) mx = fmaxf(mx, s_[r]);
        mx = fmaxf(mx, __shfl_xor(mx, 32));
        const float mnew = fmaxf(mrun, mx), alpha = __builtin_amdgcn_exp2f(mrun - mnew); mrun = mnew;
        float rs = 0.f;
#pragma unroll
        for (int r = 0; r < 16; ++r) { s_[r] = __builtin_amdgcn_exp2f(s_[r] - mnew); rs += s_[r]; }
        lrun = lrun * alpha + rs;
#pragma unroll
        for (int r = 0; r < 16; ++r) { o0[r] *= alpha; o1[r] *= alpha; }
#pragma unroll
        for (int s2 = 0; s2 < 2; ++s2) {
            const bf16x8 pf = cvt8((f32x4){s_[8 * s2 + 0], s_[8 * s2 + 1], s_[8 * s2 + 2], s_[8 * s2 + 3]}, (f32x4){s_[8 * s2 + 4], s_[8 * s2 + 5], s_[8 * s2 + 6], s_[8 * s2 + 7]});
            o0 = __builtin_amdgcn_mfma_f32_32x32x16_bf16(vf[s2][0], pf, o0, 0, 0, 0);
            o1 = __builtin_amdgcn_mfma_f32_32x32x16_bf16(vf[s2][1], pf, o1, 0, 0, 0); }
        }
        asm volatile("s_waitcnt lgkmcnt(0)" ::: "memory"); __builtin_amdgcn_s_barrier(); asm volatile("" ::: "memory");
      }
    }
#undef SA_LOAD
#undef SA_WRITE
    asm volatile("s_waitcnt vmcnt(0)" ::: "memory");
    lrun += __shfl_xor(lrun, 32);
    LAS float* mg = (LAS float*)(lds + (wave & ~2) * 8704);
    if (kh == 1) {
#pragma unroll
        for (int r = 0; r < 16; ++r) { mg[r * 64 + lane] = o0[r]; mg[(16 + r) * 64 + lane] = o1[r]; }
        mg[32 * 64 + lane] = mrun; mg[33 * 64 + lane] = lrun; }
    asm volatile("s_waitcnt lgkmcnt(0)" ::: "memory"); __builtin_amdgcn_s_barrier(); asm volatile("" ::: "memory");
    if (kh == 0) {
        const float m1 = mg[32 * 64 + lane], l1 = mg[33 * 64 + lane];
        const float mm = fmaxf(mrun, m1), a0 = __builtin_amdgcn_exp2f(mrun - mm), a1 = __builtin_amdgcn_exp2f(m1 - mm);
        const float inv = 1.0f / (lrun * a0 + l1 * a1);
#pragma unroll
        for (int r = 0; r < 16; ++r) { o0[r] = (o0[r] * a0 + mg[r * 64 + lane] * a1) * inv; o1[r] = (o1[r] * a0 + mg[(16 + r) * 64 + lane] * a1) * inv; }
        bf16* Ot = (t ? O1_ : O0_) + (size_t)(MP + 32 * b + r32) * 1024 + h * 128 + 64 * vh2 + 4 * hi;
#pragma unroll
        for (int g = 0; g < 4; ++g) {
            *(GAS unsigned long long*)(Ot + 8 * g) = (unsigned long long)pk2(o0[4 * g], o0[4 * g + 1]) | ((unsigned long long)pk2(o0[4 * g + 2], o0[4 * g + 3]) << 32);
            *(GAS unsigned long long*)(Ot + 32 + 8 * g) = (unsigned long long)pk2(o1[4 * g], o1[4 * g + 1]) | ((unsigned long long)pk2(o1[4 * g + 2], o1[4 * g + 3]) << 32); } }
    asm volatile("s_waitcnt lgkmcnt(0)" ::: "memory"); __builtin_amdgcn_s_barrier(); asm volatile("" ::: "memory");
}

#ifndef PROBE_MASK
#define PROBE_MASK 0u
#endif
#ifndef PROBE_REPS
#define PROBE_REPS 2
#endif
#ifndef MK_N_LAUNCHES
#define MK_N_LAUNCHES 1
#endif
constexpr int NPHASE = 25;
constexpr int N_LAUNCHES = MK_N_LAUNCHES;
static_assert(N_LAUNCHES == 1 || N_LAUNCHES == NPHASE, "MK_N_LAUNCHES is 1 or 25");
struct Args { const float* in[23]; float* out; unsigned char* ws; int ph_lo, ph_hi; };
static_assert(sizeof(Args) == 25 * 8 + 8, "Args has no holes");

template <class Epi>
__device__ __forceinline__ void run_gemm(LAS unsigned char* lds, const bf16* A, const bf16* Bt, int N, int K, int G, int c, const Epi& E) {
    pg8::Gemm g{A, Bt, M, N, K}; pg8::StaticOrder S; S.init(M, N, K, G, c);
    pg8::gemm_phase<Epi, pg8::StaticOrder, true, true>(lds + RING_OFF, g, S, E);
}
template <class Epi>
__device__ __forceinline__ void run_gemm_q(LAS unsigned char* lds, const bf16* A, const bf16* Bt, int G, int c, const Epi& E) {
    pg8::Gemm g{A, Bt, M, 1024, 1024}; pg8::QSplit S; S.init(G, c);
    pg8::gemm_phase<Epi, pg8::QSplit, true, true>(lds + RING_OFF, g, S, E);
}
template <class Epi>
__device__ __forceinline__ void run_gemm_sk(LAS unsigned char* lds, const bf16* A, const bf16* Bt, int N, int K, int G, int v, const Epi& E) {
    pg8::Gemm g{A, Bt, M, N, K}; pg8::StreamK S; S.init(M, N, K, G, v);
    pg8::gemm_phase<Epi, pg8::StreamK, true, true>(lds + RING_OFF, g, S, E);
}

__global__ void __launch_bounds__(NWAVES * 64, 2) yoco_fwd(Args args) {
    extern __shared__ __attribute__((aligned(16))) unsigned char lds_raw[];
    LAS unsigned char* lds = (LAS unsigned char*)lds_raw;
    volatile LAS unsigned* MISC = (volatile LAS unsigned*)(lds + MISC_OFF);
    const int tid = threadIdx.x, lane = tid & 63, wave = __builtin_amdgcn_readfirstlane(tid >> 6);
    const int G = gridDim.x; const int bx = blockIdx.x; const int vcu = (G % 8 == 0) ? (bx % 8) * (G / 8) + bx / 8 : bx;
    const int gw = vcu * NWAVES + wave, NGW = G * NWAVES;
    unsigned char* ws = args.ws; float* out = args.out;
    gu32* ctl = (gu32*)(ws + WS_CTL);
    for (int u = tid; u < (LDS_BYTES - LDSCTL_OFF) / 4; u += NWAVES * 64) ((LAS unsigned*)(lds + LDSCTL_OFF))[u] = 0u;
    __syncthreads();
    XcdBarrier bar; bar.bar = (unsigned*)(ctl + CW_BAR); bar.x = 0; bar.st = nullptr;
    if (N_LAUNCHES == 1) bar = xcd_barrier_post((unsigned*)(ctl + CW_BAR), MISC + 8);
#define GRID_BAR() do { if (N_LAUNCHES == 1) xcd_barrier(bar); } while (0)
    const int lo = args.ph_lo, hi = args.ph_hi;
#define IN(k) (lo <= (k) && (k) < hi)
#define SEAM(k) do { if (IN((k) + 1)) GRID_BAR(); } while (0)
#define SEAMF(k, a, b) do { const bool inl_ = (N_LAUNCHES == 1) && IN((k) + 1); unsigned t_ = 0u; if (inl_) t_ = xcd_barrier_arrive(bar); \
        { const P0Args A_ = P0ARGS; p0_convert<3>(A_, lds, gw, NGW, lane, wave, (a), (b)); } if (inl_) xcd_barrier_wait(bar, t_); } while (0)

#define x_p (args.in[0])
#define x_s (args.in[1])
#define state_ret (args.in[2])
#define cache_k (args.in[3])
#define cache_v (args.in[4])
#define g_norm (args.in[9])
#define g_gn_a (args.in[13])
#define g_kv (args.in[17])
#define lam_b (args.in[20])
#define g_sub (args.in[21])
#define MOD ((const float*)(ws + WS_MOD))
#define ropeA ((const float*)(ws + WS_ROPEA))
#define ropeB ((const float*)(ws + WS_ROPEB))
#define H ((bf16*)(ws + WS_H))
#define HKV ((bf16*)(ws + WS_HKV))
#define Y ((bf16*)(ws + WS_Y))
#define U ((bf16*)(ws + WS_U))
#define QR ((bf16*)(ws + WS_QR))
#define KR ((bf16*)(ws + WS_KR))
#define VR ((bf16*)(ws + WS_VR))
#define GR ((bf16*)(ws + WS_GR))
#define OR_ ((bf16*)(ws + WS_OR))
#define AR ((bf16*)(ws + WS_AR))
#define KB ((bf16*)(ws + WS_KB))
#define VB ((bf16*)(ws + WS_VB))
#define QB ((bf16*)(ws + WS_QB))
#define O0 ((bf16*)(ws + WS_O0))
#define O1 ((bf16*)(ws + WS_O1))
#define AB ((bf16*)(ws + WS_AB))
#define XB ((bf16*)(ws + WS_XB))
#define X (out + OUT_Y)
    const RowOut none{nullptr, 0, 0, nullptr};
#define WFI(l, i) ((const bf16*)(ws + WS_WFI + (size_t)((l) * 2 + (i)) * SZ_WFI))
#define WFO(l, i) ((const bf16*)(ws + WS_WFO + (size_t)((l) * 2 + (i)) * SZ_WFO))
#define GN(l, j) (g_norm + ((l) * 6 + (j)) * 1024)
#define MC(l, j) (((l) * 9 + (j)) * 1024)

#define P0ARGS P0Args{args.in[5], args.in[6], args.in[7], args.in[8], args.in[10], args.in[11], args.in[12], args.in[14], args.in[15], args.in[16], args.in[18], args.in[19], args.in[22], ws}
    const bool mspread = (G == 256);
    if (IN(0)) { const P0Args A = P0ARGS; p0_mod(A, lds, 0, mspread ? 64 : NMODC / 32, bx, G, tid, lane, wave);
        const bool split = (N_LAUNCHES == 1) && IN(1); unsigned tgt = 0u;
        if (split) tgt = xcd_barrier_arrive(bar);
        p0_rest(A, lds, vcu, G, tid, lane, wave);
        if (split) xcd_barrier_wait(bar, tgt); }
    if (IN(1)) { rowpass<false, 1, false, 0>(x_p, x_s, nullptr, nullptr, nullptr, 0, 0.f, nullptr, RowOut{GN(0, 0), MC(0, 0), MC(0, 1), H}, none, MOD, gw, NGW, lane, 0, G); SEAMF(1, 0, 1408); }
    if (IN(2)) { if (mspread && bx >= 216) { const P0Args A = P0ARGS; p0_mod(A, lds, 64, 256, bx - 216, 40, tid, lane, wave); }
        run_gemm(lds, H, WFI(0, 0), 2 * DFF, 1024, G, bx, pg8::EpiSwiglu{U, DFF}); SEAMF(2, 1408, 2944); }
    if (IN(3)) { run_gemm_sk(lds, U, WFO(0, 0), 1024, DFF, G, vcu, pg8::EpiBf16{Y, 1024, SZ_A1 / 2}); SEAMF(3, 2944, 4480); }
    if (IN(4)) { rowpass<true, 1, false, 1>(x_p, x_s, XB, Y, GN(0, 1), MC(0, 2), 0.5f, nullptr, RowOut{GN(0, 2), MC(0, 3), MC(0, 4), H}, none, MOD, gw, NGW, lane, DFF, G); SEAMF(4, 4480, 5064); }
    if (IN(5)) { run_gemm(lds, H, (const bf16*)(ws + WS_WIA), AIN, 1024, G, bx, pg8::EpiRetIn{QR, KR, VR, GR, ropeA});
        { const int nu = 68 * 24, full = nu / G, rem = nu - full * G;
          const int f0 = rem ? rem : 0, nf = G - f0; if (bx >= f0) { const P0Args A = P0ARGS; p0_convert<1>(A, lds, (bx - f0) * NWAVES + wave, nf * NWAVES, lane, wave);
              if (mspread) { __syncthreads(); p0_mod(A, lds, 256, 512, bx - 96, 160, tid, lane, wave); } } }
        SEAMF(5, 5064, 5648); }
    if (IN(6)) {
        for (int id = vcu; id < 256; id += G) { const int b = id >> 5, h = (id >> 2) & 7, vs = id & 3;
            ret_unit<64, 4, true>(lds, QR, KR, VR, OR_, nullptr, out + OUT_SRP + (size_t)(b * 8 + h) * 128 * 256, 2048 * b, 32, h, 64 * vs, tid, lane, wave); }
        for (int id = vcu; id < 256; id += G) { const int b = id >> 3, h = id & 7;
            ret_unit<32, 16, false>(lds, QR, KR, VR, OR_, state_ret + (size_t)(b * 8 + h) * 128 * 256, out + OUT_SRS + (size_t)(b * 8 + h) * 128 * 256, MP + 32 * b, 1, h, 0, tid, lane, wave); }
        SEAMF(6, 5648, 6232); }
    if (IN(7)) { gatenorm_pass(OR_, GR, g_gn_a, AR, gw, NGW, lane); SEAMF(7, 6232, 6816); }
    if (IN(8)) { run_gemm_sk(lds, AR, (const bf16*)(ws + WS_WOA), 1024, 2048, G, vcu, pg8::EpiBf16{Y, 1024, SZ_A1 / 2}); SEAMF(8, 6816, 7400); }
    if (IN(9)) { rowpass<true, 1, true, 1>(nullptr, nullptr, XB, Y, GN(0, 3), MC(0, 5), 1.0f, nullptr, RowOut{GN(0, 4), MC(0, 6), MC(0, 7), H}, none, MOD, gw, NGW, lane, 2048, G); SEAMF(9, 7400, 7984); }
    if (IN(10)) { if (mspread && bx >= 216) { const P0Args A = P0ARGS; p0_mod(A, lds, 512, 640, bx - 216, 40, tid, lane, wave); }
        run_gemm(lds, H, WFI(0, 1), 2 * DFF, 1024, G, bx, pg8::EpiSwiglu{U, DFF}); SEAMF(10, 7984, 8568); }
    if (IN(11)) { run_gemm_sk(lds, U, WFO(0, 1), 1024, DFF, G, vcu, pg8::EpiBf16{Y, 1024, SZ_A1 / 2}); SEAMF(11, 8568, 9152); }
    if (IN(12)) { rowpass<true, 2, true, 1>(nullptr, nullptr, XB, Y, GN(0, 5), MC(0, 8), 0.5f, nullptr, RowOut{GN(1, 0), MC(1, 0), MC(1, 1), H}, RowOut{g_kv, 18432, 18432 + 1024, HKV}, MOD, gw, NGW, lane, DFF, G); SEAMF(12, 9152, 9728); }
    if (IN(13)) { run_gemm(lds, H, WFI(1, 0), 2 * DFF, 1024, G, bx, pg8::EpiSwiglu{U, DFF});
        const bool inl_ = (N_LAUNCHES == 1) && IN(14); unsigned t_ = 0u; if (inl_) t_ = xcd_barrier_arrive(bar);
        run_gemm(lds, HKV, (const bf16*)(ws + WS_WKV), 2048, 1024, G, (bx + G - (1496 % G)) % G, pg8::EpiKV{KB, VB, out + OUT_KP, out + OUT_KS, out + OUT_VP, out + OUT_VS, ropeB});
        { const P0Args A_ = P0ARGS; p0_convert<3>(A_, lds, gw, NGW, lane, wave, 9728, 9984); }
        if (inl_) xcd_barrier_wait(bar, t_); }
    if (IN(14)) { run_gemm_sk(lds, U, WFO(1, 0), 1024, DFF, G, vcu, pg8::EpiBf16{Y, 1024, SZ_A1 / 2}); SEAMF(14, 9984, 10240); }
    if (IN(15)) { rowpass<true, 1, true, 1>(nullptr, nullptr, XB, Y, GN(1, 1), MC(1, 2), 0.5f, nullptr, RowOut{GN(1, 2), MC(1, 3), MC(1, 4), H}, none, MOD, gw, NGW, lane, DFF, G); SEAM(15); }
    if (IN(16)) { run_gemm_q(lds, H, (const bf16*)(ws + WS_WQB), G, bx, pg8::EpiQ{QB, Y - (size_t)MP * 1024, ropeB, QSCALE});
        { const int f0 = G > 64 ? 64 : 0, nf = G - f0;
          if (bx >= f0) { const P0Args A = P0ARGS; p0_convert<2>(A, lds, (bx - f0) * NWAVES + wave, nf * NWAVES, lane, wave); } }
        SEAM(16); }
    const bool sfirst = IN(17) && IN(18) && ((vcu >> 3) & 1);
    if (IN(18) && sfirst) { for (int id = vcu; id < 256; id += G) sattn_unit(lds, id >> 3, id & 7, QB, Y, cache_k, cache_v, out + OUT_KS, out + OUT_VS, O0, O1, tid, lane, wave); }
    if (IN(17)) {
        const attn_body::AttnTensors AT{(const attn_body::bf16*)QB, (const attn_body::bf16*)KB, (const attn_body::bf16*)VB, (attn_body::bf16*)O0, (attn_body::bf16*)O1};
        const attn_body::StaticOrder S(G, vcu);
        attn_body::attn_phase<attn_body::StaticOrder>((char*)lds_raw + RING_OFF, AT, S); }
    if (IN(18)) {
        if (!sfirst) { for (int id = vcu; id < 256; id += G) sattn_unit(lds, id >> 3, id & 7, QB, Y, cache_k, cache_v, out + OUT_KS, out + OUT_VS, O0, O1, tid, lane, wave); }
        SEAM(18); }
    if (IN(19)) { diffnorm_pass(O0, O1, lam_b, g_sub, AB, gw, NGW, lane); SEAM(19); }
    if (IN(20)) { run_gemm_sk(lds, AB, (const bf16*)(ws + WS_WOB), 1024, 1024, G, vcu, pg8::EpiBf16{Y, 1024, SZ_A1 / 2}); SEAM(20); }
    if (IN(21)) { rowpass<true, 1, true, 1>(nullptr, nullptr, XB, Y, GN(1, 3), MC(1, 5), 1.0f, nullptr, RowOut{GN(1, 4), MC(1, 6), MC(1, 7), H}, none, MOD, gw, NGW, lane, 1024, G); SEAM(21); }
    if (IN(22)) { run_gemm(lds, H, WFI(1, 1), 2 * DFF, 1024, G, bx, pg8::EpiSwiglu{U, DFF}); SEAM(22); }
    if (IN(23)) { run_gemm_sk(lds, U, WFO(1, 1), 1024, DFF, G, vcu, pg8::EpiBf16{Y, 1024, SZ_A1 / 2}); SEAM(23); }
    if (IN(24)) { rowpass<true, 0, true, 2>(nullptr, nullptr, XB, Y, GN(1, 5), MC(1, 8), 0.5f, out + OUT_Y, none, none, MOD, gw, NGW, lane, DFF, G); }
#undef IN
#undef SEAM
#undef SEAMF
#undef GRID_BAR
}

extern "C" void kernel_launch(void* const* d_in, const int* in_sizes, int n_in, void* d_out, int out_size, void* d_ws, size_t ws_size, hipStream_t stream) {
    static int grid = 0;
    if (grid == 0) {
        if (n_in != 23 || in_sizes[0] != MP * D || (size_t)out_size != OUT_END || ws_size < WS_END) { fprintf(stderr, "kernel_launch: unexpected shapes (n_in %d, in0 %d, out %d, ws %zu); nothing launched\n", n_in, n_in > 0 ? in_sizes[0] : -1, out_size, ws_size); grid = -1; return; }
        int dev = 0, cus = 0, per_cu = 0;
        if (hipGetDevice(&dev) != hipSuccess || hipDeviceGetAttribute(&cus, hipDeviceAttributeMultiprocessorCount, dev) != hipSuccess) { fprintf(stderr, "kernel_launch: device query failed\n"); grid = -1; return; }
        if (hipFuncSetAttribute((const void*)yoco_fwd, hipFuncAttributeMaxDynamicSharedMemorySize, LDS_BYTES) != hipSuccess) { fprintf(stderr, "kernel_launch: hipFuncSetAttribute failed\n"); grid = -1; return; }
        if (hipOccupancyMaxActiveBlocksPerMultiprocessor(&per_cu, (const void*)yoco_fwd, NWAVES * 64, LDS_BYTES) != hipSuccess || per_cu < 1)
            fprintf(stderr, "kernel_launch: note: occupancy query reports %d workgroups per CU\n", per_cu);
        (void)hipGetLastError();
        grid = cus;
    }
    if (grid < 0) return;
    if (hipMemsetAsync((char*)d_ws + WS_CTL, 0, ZERO_BYTES, stream) != hipSuccess) { fprintf(stderr, "kernel_launch: hipMemsetAsync failed\n"); return; }
    Args a{};
    for (int i = 0; i < 23; ++i) a.in[i] = (const float*)d_in[i];
    a.out = (float*)d_out; a.ws = (unsigned char*)d_ws;
    for (int li = 0; li < N_LAUNCHES; ++li) {
        a.ph_lo = (N_LAUNCHES == 1) ? 0 : li; a.ph_hi = (N_LAUNCHES == 1) ? NPHASE : li + 1;
        for (int rp = 0; rp < 1 + ((N_LAUNCHES != 1 && ((PROBE_MASK >> li) & 1u)) ? PROBE_REPS : 0); ++rp)
        hipLaunchKernelGGL(yoco_fwd, dim3(grid), dim3(NWAVES * 64), LDS_BYTES, stream, a);
        const hipError_t le = hipPeekAtLastError();
        if (le != hipSuccess) { fprintf(stderr, "kernel_launch: launch %d failed: %s\n", li, hipGetErrorName(le)); break; }
    }
}
```

```cpp
#include <hip/hip_runtime.h>
#include <cstdio>
#include <cstdint>
namespace pg8 {
#define PG8_LAS __attribute__((address_space(3)))
typedef unsigned short bf16_t;
typedef short bf16x8 __attribute__((ext_vector_type(8)));
typedef float f32x4 __attribute__((ext_vector_type(4)));
typedef unsigned u32x4 __attribute__((ext_vector_type(4)));
constexpr int BM = 256, BK = 64, HALF = 128, HTB = HALF * BK * 2  , STAGE_BYTES = 8 * HTB, NXCD = 8, WGM = 8;

__host__ __device__ __forceinline__ int lds_byte(int r, int c) { const int st = (r >> 4) * 2 + (c >> 5), rr = r & 15, cc = c & 31, ob = rr * 64 + cc * 2; return st * 1024 + (ob ^ (((ob >> 9) & 1) << 5)); }
__host__ __device__ __forceinline__ void stage_rc(int b, int& R, int& C) { const int st = b / 1024, sb = b % 1024, swz = sb ^ (((sb >> 9) & 1) << 5); R = (st >> 1) * 16 + swz / 64; C = (st & 1) * 32 + (swz % 64) / 2; }
__host__ __device__ __forceinline__ int perm32(int rho) { const int n = rho >> 4, i = rho & 15; return 8 * (i >> 2) + 4 * n + (i & 3); }

struct Unit { int pm, pn, k0, nt, slot; };
struct Gemm { const bf16_t* A; const bf16_t* Bt; int M, N, K; };

struct StaticOrder {
    int nM, nN, nwg, G, c, ntK;
    __host__ __device__ void init(int M, int N, int K, int G_, int c_) { nM = M / BM; nN = N / BM; nwg = nM * nN; G = G_; c = c_; ntK = K / BK; }
    __host__ __device__ bool next(int i, Unit& u) const {
        const long L = (long)i * G + c; if (L >= nwg) return false;
        int wgid = (int)L; { const int q = nwg / NXCD, r = nwg % NXCD, xcd = wgid % NXCD, off = wgid / NXCD; wgid = (xcd < r ? xcd * (q + 1) : r * (q + 1) + (xcd - r) * q) + off; }
        const int nig = WGM * nN, gid = wgid / nig, fm = gid * WGM, gsz = (nM - fm) < WGM ? (nM - fm) : WGM;
        u.pm = fm + ((wgid % nig) % gsz); u.pn = (wgid % nig) / gsz; u.k0 = 0; u.nt = ntK; u.slot = 0; return true;
    }
    __device__ __forceinline__ void a_ready(const Unit&) const {}
    __device__ __forceinline__ void done(const Unit&) const {}
};


struct StreamK {
    int nN, nkp, W, G, v, b0, b1;
    __host__ __device__ void init(int M, int N, int K, int G_, int v_) { nN = N / BM; nkp = K / 128; const int nu = (M / BM) * nN; W = nu * nkp; G = G_ < nu ? G_ : nu; v = v_;
        b0 = v < G ? (int)(((long)v * W) / G) : W; b1 = v < G ? (int)(((long)(v + 1) * W) / G) : W; }
    __host__ __device__ int cu_of(int x) const { return (int)((((long)x + 1) * G - 1) / W); }
    __host__ __device__ int pieces(int un) const { return cu_of(un * nkp + nkp - 1) - cu_of(un * nkp) + 1; }
    __host__ __device__ bool next(int i, Unit& u) const {
        const int un = b0 / nkp + i, ks = un * nkp; const int a = b0 > ks ? b0 : ks, e = b1 < ks + nkp ? b1 : ks + nkp;
        if (a >= e) return false;
        u.pm = un / nN; u.pn = un % nN; u.k0 = 2 * (a - ks); u.nt = 2 * (e - a); u.slot = v - cu_of(ks); return true;
    }
    __device__ __forceinline__ void a_ready(const Unit&) const {}
    __device__ __forceinline__ void done(const Unit&) const {}
};

struct QSplit {
    StaticOrder P; int G, c, R;
    __host__ __device__ void init(int G_, int c_) { P.init(16384, 1024, 1024, G_, c_); G = G_; c = c_; R = (P.nwg + G_ - 1) / G_; }
    __host__ __device__ bool next(int i, Unit& u) const {
        if (i < R) { if (P.next(i, u)) return true; i = R; }
        const long j = (long)(i - R) * G + c; if (j >= 64) return false;
        const int s = (int)j >> 2; u.pm = 64 + (s >> 2); u.pn = s & 3; u.k0 = 4 * ((int)j & 3); u.nt = 4; u.slot = (int)j & 3; return true;
    }
    __device__ __forceinline__ void a_ready(const Unit&) const {}
    __device__ __forceinline__ void done(const Unit&) const {}
};

__device__ __forceinline__ unsigned cvt_pk_bf16(float lo, float hi) { unsigned r; asm volatile("v_cvt_pk_bf16_f32 %0, %1, %2" : "=v"(r) : "v"(lo), "v"(hi)); return r; }
__device__ __forceinline__ void stntf(f32x4* p, const f32x4 v) { __builtin_nontemporal_store(v, p); }
__device__ __forceinline__ u32x4 pack8(const f32x4 a, const f32x4 b) { u32x4 w; w.x = cvt_pk_bf16(a[0], a[1]); w.y = cvt_pk_bf16(a[2], a[3]); w.z = cvt_pk_bf16(b[0], b[1]); w.w = cvt_pk_bf16(b[2], b[3]); return w; }
__device__ __forceinline__ float silu_f(float a) { return a * __builtin_amdgcn_rcpf(1.0f + __builtin_amdgcn_exp2f(-1.4426950408889634f * a)); }
__device__ __forceinline__ float swi_f(float a, float b) { return (a * b) * __builtin_amdgcn_rcpf(1.0f + __builtin_amdgcn_exp2f(-a)); }
__device__ __forceinline__ f32x4 swi4(const f32x4 a, const f32x4 b) { f32x4 r; r[0] = swi_f(a[0], b[0]); r[1] = swi_f(a[1], b[1]); r[2] = swi_f(a[2], b[2]); r[3] = swi_f(a[3], b[3]); return r; }
__device__ __forceinline__ f32x4 silu4(const f32x4 a) { f32x4 r; r[0] = silu_f(a[0]); r[1] = silu_f(a[1]); r[2] = silu_f(a[2]); r[3] = silu_f(a[3]); return r; }
__device__ __forceinline__ int pidx_of(int r) { return r < 16384 ? (r & 2047) : 2048 + ((r - 16384) & 31); }

struct EpiBf16 {
    static constexpr bool PERM = true, AFTER_DRAIN = false;
    bf16_t* O; int ldc; size_t slot_stride;
    __device__ __forceinline__ void operator()(const f32x4 (&acc)[2][2][4][2], const Unit& u, int wr, int wc, int fr, int fq) const {
        const int row0 = u.pm * BM + wr * 64 + fr, col0 = u.pn * BM + wc * 32 + 8 * fq; bf16_t* Ob = O + (size_t)u.slot * slot_stride;
#pragma unroll
        for (int ai = 0; ai < 2; ++ai)
#pragma unroll
            for (int m = 0; m < 4; ++m) { bf16_t* rowp = Ob + (size_t)(row0 + ai * HALF + m * 16) * ldc + col0;
#pragma unroll
                for (int bj = 0; bj < 2; ++bj) *(u32x4*)(rowp + bj * HALF) = pack8(acc[ai][bj][m][0], acc[ai][bj][m][1]); }
    }
};
struct EpiSwiglu {
    static constexpr bool PERM = true, AFTER_DRAIN = false;
    bf16_t* U; int ldu;
    __device__ __forceinline__ void operator()(const f32x4 (&acc)[2][2][4][2], const Unit& u, int wr, int wc, int fr, int fq) const {
        const int row0 = u.pm * BM + wr * 64 + fr, col0 = u.pn * HALF + wc * 32 + 8 * fq;
#pragma unroll
        for (int ai = 0; ai < 2; ++ai)
#pragma unroll
            for (int m = 0; m < 4; ++m) { bf16_t* rowp = U + (size_t)(row0 + ai * HALF + m * 16) * ldu + col0;
                const f32x4 v0 = swi4(acc[ai][0][m][0], acc[ai][1][m][0]), v1 = swi4(acc[ai][0][m][1], acc[ai][1][m][1]);
                *(u32x4*)rowp = pack8(v0, v1); }
    }
};
__device__ __forceinline__ void rot8(const f32x4* rp, const f32x4 x1a, const f32x4 x1b, const f32x4 x2a, const f32x4 x2b, float sc, f32x4& o1a, f32x4& o1b, f32x4& o2a, f32x4& o2b) {
    const f32x4 c0 = rp[0], c1 = rp[1], c2 = rp[2], c3 = rp[3];
    o1a[0] = (x1a[0] * c0[0] - x2a[0] * c0[1]) * sc; o2a[0] = (x2a[0] * c0[0] + x1a[0] * c0[1]) * sc;
    o1a[1] = (x1a[1] * c0[2] - x2a[1] * c0[3]) * sc; o2a[1] = (x2a[1] * c0[2] + x1a[1] * c0[3]) * sc;
    o1a[2] = (x1a[2] * c1[0] - x2a[2] * c1[1]) * sc; o2a[2] = (x2a[2] * c1[0] + x1a[2] * c1[1]) * sc;
    o1a[3] = (x1a[3] * c1[2] - x2a[3] * c1[3]) * sc; o2a[3] = (x2a[3] * c1[2] + x1a[3] * c1[3]) * sc;
    o1b[0] = (x1b[0] * c2[0] - x2b[0] * c2[1]) * sc; o2b[0] = (x2b[0] * c2[0] + x1b[0] * c2[1]) * sc;
    o1b[1] = (x1b[1] * c2[2] - x2b[1] * c2[3]) * sc; o2b[1] = (x2b[1] * c2[2] + x1b[1] * c2[3]) * sc;
    o1b[2] = (x1b[2] * c3[0] - x2b[2] * c3[1]) * sc; o2b[2] = (x2b[2] * c3[0] + x1b[2] * c3[1]) * sc;
    o1b[3] = (x1b[3] * c3[2] - x2b[3] * c3[3]) * sc; o2b[3] = (x2b[3] * c3[2] + x1b[3] * c3[3]) * sc;
}
struct EpiRetIn {
    static constexpr bool PERM = true, AFTER_DRAIN = false;
    bf16_t *QR, *KR, *VR, *GR; const float* ropeA;
    __device__ __forceinline__ void operator()(const f32x4 (&acc)[2][2][4][2], const Unit& u, int wr, int wc, int fr, int fq) const {
        const int row0 = u.pm * BM + wr * 64 + fr;
        if (u.pn < 8) {
            bf16_t* dst = (u.pn < 4) ? QR : KR; const float sc = (u.pn < 4) ? 1.0f : 0.08838834764831845f;
            const int head = 2 * (u.pn & 3) + (wc >> 1), d0 = 32 * (wc & 1) + 8 * fq;
#pragma unroll
            for (int ai = 0; ai < 2; ++ai)
#pragma unroll
                for (int m = 0; m < 4; ++m) { const int row = row0 + ai * HALF + m * 16; const f32x4* rp = (const f32x4*)(ropeA + ((size_t)pidx_of(row) * 64 + d0) * 2);
                    f32x4 o1a, o1b, o2a, o2b; rot8(rp, acc[ai][0][m][0], acc[ai][0][m][1], acc[ai][1][m][0], acc[ai][1][m][1], sc, o1a, o1b, o2a, o2b);
                    bf16_t* rowp = dst + (size_t)row * 1024 + head * 128 + d0;
                    *(u32x4*)rowp = pack8(o1a, o1b); *(u32x4*)(rowp + 64) = pack8(o2a, o2b); }
        } else if (u.pn < 16) {
            const int col0 = (u.pn - 8) * BM + wc * 32 + 8 * fq;
#pragma unroll
            for (int ai = 0; ai < 2; ++ai)
#pragma unroll
                for (int m = 0; m < 4; ++m) { bf16_t* rowp = VR + (size_t)(row0 + ai * HALF + m * 16) * 2048 + col0;
#pragma unroll
                    for (int bj = 0; bj < 2; ++bj) *(u32x4*)(rowp + bj * HALF) = pack8(acc[ai][bj][m][0], acc[ai][bj][m][1]); }
        } else {
            const int col0 = (u.pn - 16) * BM + wc * 32 + 8 * fq;
#pragma unroll
            for (int ai = 0; ai < 2; ++ai)
#pragma unroll
                for (int m = 0; m < 4; ++m) { bf16_t* rowp = GR + (size_t)(row0 + ai * HALF + m * 16) * 2048 + col0;
#pragma unroll
                    for (int bj = 0; bj < 2; ++bj) *(u32x4*)(rowp + bj * HALF) = pack8(acc[ai][bj][m][0], acc[ai][bj][m][1]); }
        }
    }
};
struct EpiKV {
    static constexpr bool PERM = true, AFTER_DRAIN = false;
    bf16_t *KB, *VB; float *Kp, *Ks, *Vp, *Vs; const float* ropeB;
    __device__ __forceinline__ void operator()(const f32x4 (&acc)[2][2][4][2], const Unit& u, int wr, int wc, int fr, int fq) const {
        const int row0 = u.pm * BM + wr * 64 + fr; const bool samp = u.pm >= 64;
        if (u.pn < 4) {
            const int grp = 4 * u.pn + wc, d0 = 8 * fq; float* ob = samp ? Ks - (size_t)16384 * 1024 : Kp;
#pragma unroll
            for (int ai = 0; ai < 2; ++ai)
#pragma unroll
                for (int m = 0; m < 4; ++m) { const int row = row0 + ai * HALF + m * 16; const f32x4* rp = (const f32x4*)(ropeB + ((size_t)pidx_of(row) * 32 + d0) * 2);
                    f32x4 o1a, o1b, o2a, o2b; rot8(rp, acc[ai][0][m][0], acc[ai][0][m][1], acc[ai][1][m][0], acc[ai][1][m][1], 1.0f, o1a, o1b, o2a, o2b);
                    const size_t off = (size_t)row * 1024 + grp * 64 + d0;
                    stntf((f32x4*)(ob + off), o1a); stntf((f32x4*)(ob + off + 4), o1b); stntf((f32x4*)(ob + off + 32), o2a); stntf((f32x4*)(ob + off + 36), o2b);
                    *(u32x4*)(KB + off) = pack8(o1a, o1b); *(u32x4*)(KB + off + 32) = pack8(o2a, o2b); }
        } else {
            const int col0 = (u.pn - 4) * BM + wc * 32 + 8 * fq; float* ob = samp ? Vs - (size_t)16384 * 1024 : Vp;
#pragma unroll
            for (int ai = 0; ai < 2; ++ai)
#pragma unroll
                for (int m = 0; m < 4; ++m) { const size_t off = (size_t)(row0 + ai * HALF + m * 16) * 1024 + col0;
#pragma unroll
                    for (int bj = 0; bj < 2; ++bj) { stntf((f32x4*)(ob + off + bj * HALF), acc[ai][bj][m][0]); stntf((f32x4*)(ob + off + bj * HALF + 4), acc[ai][bj][m][1]);
                        *(u32x4*)(VB + off + bj * HALF) = pack8(acc[ai][bj][m][0], acc[ai][bj][m][1]); } }
        }
    }
};
struct EpiQ {
    static constexpr bool PERM = true, AFTER_DRAIN = false;
    bf16_t* QB; bf16_t* QB2; const float* ropeB; float qscale;
    __device__ __forceinline__ void operator()(const f32x4 (&acc)[2][2][4][2], const Unit& u, int wr, int wc, int fr, int fq) const {
        const int row0 = u.pm * BM + wr * 64 + fr; const int grp = 4 * u.pn + wc, d0 = 8 * fq; bf16_t* Qd = u.slot ? QB2 + (size_t)(u.slot - 1) * (1024 * 1024) : QB;
#pragma unroll
        for (int ai = 0; ai < 2; ++ai)
#pragma unroll
            for (int m = 0; m < 4; ++m) { const int row = row0 + ai * HALF + m * 16; const f32x4* rp = (const f32x4*)(ropeB + ((size_t)pidx_of(row) * 32 + d0) * 2);
                f32x4 o1a, o1b, o2a, o2b; rot8(rp, acc[ai][0][m][0], acc[ai][0][m][1], acc[ai][1][m][0], acc[ai][1][m][1], qscale, o1a, o1b, o2a, o2b);
                const size_t off = (size_t)row * 1024 + grp * 64 + d0;
                *(u32x4*)(Qd + off) = pack8(o1a, o1b); *(u32x4*)(Qd + off + 32) = pack8(o2a, o2b); }
    }
};
template <class Epi, class Sched, bool ALIGN_EPI = false, bool SP2 = false>
__device__ __forceinline__ void gemm_phase(PG8_LAS unsigned char* lds, const Gemm g, const Sched& S, const Epi& E) {
    const int tid = threadIdx.x, wid = __builtin_amdgcn_readfirstlane(tid >> 6), lane = tid & 63, wr = wid >> 2, wc = wid & 3, fr = lane & 15, fq = lane >> 4;
    const int K = g.K;
    unsigned voffA[2], voffB[2];
#pragma unroll
    for (int i = 0; i < 2; ++i) { int R, C; stage_rc(tid * 16 + i * 8192, R, C); const int Rb = Epi::PERM ? ((R & ~31) + perm32(R & 31)) : R;
        voffA[i] = (unsigned)(R * K + C) * 2u; voffB[i] = (unsigned)(Rb * K + C) * 2u; }
    const size_t kstep = (size_t)(BK * 2);
    const size_t hstep = (size_t)HALF * K * 2;
    const size_t tstep = 2 * hstep;
    const unsigned ldsw = (unsigned)wid * 1024u;
    const int aoff = lds_byte(wr * 64 + fr, fq * 8), boff = lds_byte(wc * 32 + fr, fq * 8);
#define PG8_SA(b, h) (((b) * 2 + (h)) * HTB)
#define PG8_SB(b, h) ((4 + (b) * 2 + (h)) * HTB)
#define PG8_STAGE(bufoff, gbase, voff) do { _Pragma("unroll") for (int _i = 0; _i < 2; ++_i) \
        __builtin_amdgcn_global_load_lds((const unsigned*)((const char*)(gbase) + (voff)[_i]), (PG8_LAS unsigned*)(lds + (bufoff) + ldsw + _i * 8192), 16, 0, 0); } while (0)
#define PG8_LDA(dst, b, h) do { _Pragma("unroll") for (int m = 0; m < 4; ++m) _Pragma("unroll") for (int k = 0; k < 2; ++k) dst[m][k] = *(const PG8_LAS bf16x8*)(lds + PG8_SA(b, h) + aoff + m * 2048 + k * 1024); } while (0)
#define PG8_LDB(dst, b, h) do { _Pragma("unroll") for (int n = 0; n < 2; ++n) _Pragma("unroll") for (int k = 0; k < 2; ++k) dst[n][k] = *(const PG8_LAS bf16x8*)(lds + PG8_SB(b, h) + boff + n * 2048 + k * 1024); } while (0)
#define PG8_MMA(ai, bj, At, Bt) do { __builtin_amdgcn_s_setprio(1); _Pragma("unroll") for (int m = 0; m < 4; ++m) _Pragma("unroll") for (int n = 0; n < 2; ++n) _Pragma("unroll") for (int k = 0; k < 2; ++k) \
        acc[ai][bj][m][n] = __builtin_amdgcn_mfma_f32_16x16x32_bf16(Bt[n][k], At[m][k], acc[ai][bj][m][n], 0, 0, 0); __builtin_amdgcn_s_setprio(0); } while (0)
#define PG8_WAIT_V(n) asm volatile("s_waitcnt vmcnt(" #n ")" ::: "memory")
#define PG8_WAIT_L(n) asm volatile("s_waitcnt lgkmcnt(" #n ")" ::: "memory")
#define PG8_BAR __builtin_amdgcn_s_barrier()
#define PG8_SCHED __builtin_amdgcn_sched_barrier(0)
    Unit cur, nxt; int ui = 0;
    if (!S.next(0, cur)) return;
    f32x4 acc[2][2][4][2];
#pragma unroll
    for (int a = 0; a < 2; ++a)
#pragma unroll
        for (int b = 0; b < 2; ++b)
#pragma unroll
            for (int m = 0; m < 4; ++m)
#pragma unroll
                for (int n = 0; n < 2; ++n) acc[a][b][m][n] = (f32x4){0.f, 0.f, 0.f, 0.f};
    bf16x8 At[4][2], B0[2][2], B1[2][2];
    const char* cA = (const char*)g.A + (size_t)cur.pm * tstep + (size_t)cur.k0 * kstep; const char* cB = (const char*)g.Bt + (size_t)cur.pn * tstep + (size_t)cur.k0 * kstep;
    S.a_ready(cur);
    if constexpr (SP2) {
        PG8_STAGE(PG8_SB(0, 0), cB, voffB); PG8_STAGE(PG8_SB(0, 1), cB + hstep, voffB); PG8_STAGE(PG8_SA(0, 0), cA, voffA); PG8_STAGE(PG8_SA(0, 1), cA + hstep, voffA);
        if (wr == 1) PG8_BAR;
        PG8_WAIT_V(2); PG8_BAR;
        PG8_STAGE(PG8_SB(1, 0), cB + kstep, voffB); PG8_STAGE(PG8_SA(1, 0), cA + kstep, voffA); PG8_STAGE(PG8_SB(1, 1), cB + hstep + kstep, voffB);
        PG8_WAIT_V(6); PG8_BAR;
    } else {
        PG8_STAGE(PG8_SB(0, 0), cB, voffB); PG8_STAGE(PG8_SA(0, 0), cA, voffA); PG8_STAGE(PG8_SB(0, 1), cB + hstep, voffB); PG8_STAGE(PG8_SA(0, 1), cA + hstep, voffA);
        if (wr == 1) PG8_BAR;
        PG8_WAIT_V(4); PG8_BAR;
        PG8_STAGE(PG8_SB(1, 0), cB + kstep, voffB); PG8_STAGE(PG8_SA(1, 0), cA + kstep, voffA); PG8_STAGE(PG8_SB(1, 1), cB + hstep + kstep, voffB);
        PG8_WAIT_V(6); PG8_BAR;
    }
    for (;;) {
        const bool has_next = S.next(ui + 1, nxt);
        const char* nA = has_next ? (const char*)g.A + (size_t)nxt.pm * tstep + (size_t)nxt.k0 * kstep : cA; const char* nB = has_next ? (const char*)g.Bt + (size_t)nxt.pn * tstep + (size_t)nxt.k0 * kstep : cB;
        const int nt = cur.nt;
        for (int t = 0; t < nt; t += 2) {
            const bool last = (t == nt - 2);
            const char* a1 = cA + (size_t)(t + 1) * kstep;
            const char* a2 = last ? nA : cA + (size_t)(t + 2) * kstep; const char* b2 = last ? nB : cB + (size_t)(t + 2) * kstep;
            const char* a3 = a2 + kstep; const char* b3 = b2 + kstep;
            if (last && has_next) S.a_ready(nxt);
            if constexpr (SP2) {
            PG8_LDB(B0, 0, 0); PG8_LDB(B1, 0, 1); PG8_SCHED; PG8_LDA(At, 0, 0); PG8_STAGE(PG8_SA(1, 1), a1 + hstep, voffA);
            PG8_WAIT_V(8); PG8_WAIT_L(0); PG8_BAR; PG8_MMA(0, 0, At, B0); PG8_MMA(0, 1, At, B1); PG8_BAR; PG8_SCHED;
            PG8_LDA(At, 0, 1); PG8_STAGE(PG8_SB(0, 0), b2, voffB); PG8_STAGE(PG8_SB(0, 1), b2 + hstep, voffB); PG8_STAGE(PG8_SA(0, 0), a2, voffA);
            PG8_WAIT_V(8); PG8_WAIT_L(0); PG8_BAR; PG8_MMA(1, 0, At, B0); PG8_MMA(1, 1, At, B1); PG8_BAR; PG8_SCHED;
            PG8_LDB(B0, 1, 0); PG8_LDB(B1, 1, 1); PG8_SCHED; PG8_LDA(At, 1, 0); PG8_STAGE(PG8_SA(0, 1), a2 + hstep, voffA);
            PG8_WAIT_V(8); PG8_WAIT_L(0); PG8_BAR; PG8_MMA(0, 0, At, B0); PG8_MMA(0, 1, At, B1); PG8_BAR; PG8_SCHED;
            PG8_LDA(At, 1, 1); PG8_STAGE(PG8_SB(1, 0), b3, voffB); PG8_STAGE(PG8_SB(1, 1), b3 + hstep, voffB); PG8_STAGE(PG8_SA(1, 0), a3, voffA);
            PG8_WAIT_V(8); PG8_WAIT_L(0); PG8_BAR; PG8_MMA(1, 0, At, B0); PG8_MMA(1, 1, At, B1); PG8_BAR; PG8_SCHED;
            } else {
            PG8_LDB(B0, 0, 0); PG8_SCHED; PG8_LDA(At, 0, 0); PG8_STAGE(PG8_SA(1, 1), a1 + hstep, voffA);
            PG8_WAIT_L(8); PG8_BAR; PG8_WAIT_L(0); PG8_MMA(0, 0, At, B0); PG8_BAR; PG8_SCHED;
            PG8_LDB(B1, 0, 1); PG8_STAGE(PG8_SB(0, 0), b2, voffB);
            PG8_BAR; PG8_WAIT_L(0); PG8_MMA(0, 1, At, B1); PG8_BAR;
            PG8_LDA(At, 0, 1); PG8_STAGE(PG8_SA(0, 0), a2, voffA);
            PG8_BAR; PG8_WAIT_L(0); PG8_MMA(1, 0, At, B0); PG8_BAR; PG8_SCHED;
            PG8_STAGE(PG8_SB(0, 1), b2 + hstep, voffB);
            PG8_WAIT_V(6); PG8_BAR; PG8_MMA(1, 1, At, B1); PG8_BAR;
            PG8_LDB(B0, 1, 0); PG8_SCHED; PG8_LDA(At, 1, 0); PG8_STAGE(PG8_SA(0, 1), a2 + hstep, voffA);
            PG8_WAIT_L(8); PG8_BAR; PG8_WAIT_L(0); PG8_MMA(0, 0, At, B0); PG8_BAR; PG8_SCHED;
            PG8_LDB(B1, 1, 1); PG8_STAGE(PG8_SB(1, 0), b3, voffB);
            PG8_BAR; PG8_WAIT_L(0); PG8_MMA(0, 1, At, B1); PG8_BAR;
            PG8_LDA(At, 1, 1); PG8_STAGE(PG8_SA(1, 0), a3, voffA);
            PG8_BAR; PG8_WAIT_L(0); PG8_MMA(1, 0, At, B0); PG8_BAR; PG8_SCHED;
            PG8_STAGE(PG8_SB(1, 1), b3 + hstep, voffB);
            PG8_WAIT_V(6); PG8_BAR; PG8_MMA(1, 1, At, B1); PG8_BAR;
            }
        }
        if constexpr (ALIGN_EPI) { if (wr == 0) PG8_BAR; }
        if constexpr (!Epi::AFTER_DRAIN) { E(acc, cur, wr, wc, fr, fq); S.done(cur); }
        if (!has_next) break;
#pragma unroll
        for (int a = 0; a < 2; ++a)
#pragma unroll
            for (int b = 0; b < 2; ++b)
#pragma unroll
                for (int m = 0; m < 4; ++m)
#pragma unroll
                    for (int n = 0; n < 2; ++n) acc[a][b][m][n] = (f32x4){0.f, 0.f, 0.f, 0.f};
        cur = nxt; cA = nA; cB = nB; ++ui;
        if constexpr (ALIGN_EPI) { if (wr == 1) PG8_BAR; }
    }
    PG8_WAIT_V(0);
    if constexpr (!ALIGN_EPI) { if (wr == 0) PG8_BAR; }
    PG8_BAR;
    if constexpr (Epi::AFTER_DRAIN) { E.fused(acc, cur, wr, wc, fr, fq, lds, wid, lane); S.done(cur); }
#undef PG8_SA
#undef PG8_SB
#undef PG8_STAGE
#undef PG8_LDA
#undef PG8_LDB
#undef PG8_MMA
#undef PG8_WAIT_V
#undef PG8_WAIT_L
#undef PG8_BAR
#undef PG8_SCHED
}
}
#include <hip/hip_bf16.h>
#include <cmath>
namespace attn_body {
using bf16=__hip_bfloat16;
using bf16x8=__attribute__((ext_vector_type(8)))short;
using s16x4=__attribute__((ext_vector_type(4)))short;
using f32x16=__attribute__((ext_vector_type(16)))float;
using u32x4=__attribute__((ext_vector_type(4)))unsigned;
constexpr int BATCH=8,NHEAD=16,SEQ=2048,D=64,DM=NHEAD*D;
constexpr int NW=8,QBLK=32,QB=QBLK*NW,KVBLK=64,NQB=SEQ/QB;
constexpr int ATTN_PITCH=DM, ATTN_UNIT_ROWS=QB;
__device__ __forceinline__ int crow(int r,int hi){return (r&3)+8*(r>>2)+4*hi;}
#define SBAR() __builtin_amdgcn_sched_barrier(0)
__device__ __forceinline__ void cmask(f32x16&p0,f32x16&p1,int jb,int wid){
  const float NEG=-INFINITY;
  if(jb>(wid>>1)){
    #pragma unroll
    for(int r=0;r<16;++r){p0[r]=NEG;p1[r]=NEG;}
  }
}

constexpr int NSLOT=3, SLOTB=8192;
constexpr int LDS_K=0, LDS_V=NSLOT*SLOTB, LDS_WS=2*NSLOT*SLOTB, LDS_OST=LDS_WS+NW*64*4, LDS_BYTES=LDS_OST+NW*4096;
constexpr float C2=0.125f*1.4426950408889634f;
__device__ __forceinline__ void glds16(const void*gsrc,unsigned lds_dst){unsigned keep;
  asm volatile("s_mov_b32 %0, m0\n\ts_mov_b32 m0, %2\n\ts_nop 0\n\tglobal_load_lds_dwordx4 %1, off\n\ts_mov_b32 m0, %0":"=&s"(keep):"v"(gsrc),"s"(lds_dst):"memory");}
__device__ __forceinline__ float max3f(float a,float b,float c){float r;asm("v_max3_f32 %0, %1, %2, %3":"=v"(r):"v"(a),"v"(b),"v"(c));return r;}
__device__ __forceinline__ float max2f(float a,float b){float r;asm("v_max_f32_e32 %0, %1, %2":"=v"(r):"v"(a),"v"(b));return r;}
__device__ __forceinline__ float fadd_s(float a,float b){float r;asm("v_add_f32_e32 %0, %1, %2":"=v"(r):"v"(a),"v"(b));return r;}
__device__ __forceinline__ float fsub_s(float a,float b){float r;asm("v_sub_f32_e32 %0, %1, %2":"=v"(r):"v"(a),"v"(b));return r;}
typedef float f32x2_t __attribute__((ext_vector_type(2))); typedef __bf16 bf16x2_t __attribute__((ext_vector_type(2)));
__device__ __forceinline__ unsigned cvtpk_s(float lo,float hi){f32x2_t v={lo,hi};bf16x2_t b=__builtin_convertvector(v,bf16x2_t);return __builtin_bit_cast(unsigned,b);}
#define WAIT_BAR(N) asm volatile("s_waitcnt vmcnt(" #N ") lgkmcnt(0)\n\ts_barrier":::"memory")

__device__ __forceinline__ void qkt(f32x16&p0,f32x16&p1,const char*Kslot,const bf16x8*qr,const f32x16&negm,int r32,int hi){
  const char*kb=Kslot+hi*1024+r32*16;
  #pragma unroll
  for(int d0=0;d0<4;++d0){
    const bf16x8 b0=*reinterpret_cast<const bf16x8*>(kb+d0*2048);
    const bf16x8 b1=*reinterpret_cast<const bf16x8*>(kb+d0*2048+512);
    if(d0==0){p0=__builtin_amdgcn_mfma_f32_32x32x16_bf16(b0,qr[0],negm,0,0,0);p1=__builtin_amdgcn_mfma_f32_32x32x16_bf16(b1,qr[0],negm,0,0,0);}
    else{p0=__builtin_amdgcn_mfma_f32_32x32x16_bf16(b0,qr[d0],p0,0,0,0);p1=__builtin_amdgcn_mfma_f32_32x32x16_bf16(b1,qr[d0],p1,0,0,0);}}
}
typedef __attribute__((address_space(3))) const char* lds_cptr;
typedef short v4i16_t __attribute__((ext_vector_type(4)));
__device__ __forceinline__ void kload8(bf16x8*kf,lds_cptr kp){
  kf[0]=*(const __attribute__((address_space(3))) bf16x8*)(kp);      kf[1]=*(const __attribute__((address_space(3))) bf16x8*)(kp+512);
  kf[2]=*(const __attribute__((address_space(3))) bf16x8*)(kp+2048); kf[3]=*(const __attribute__((address_space(3))) bf16x8*)(kp+2560);
  kf[4]=*(const __attribute__((address_space(3))) bf16x8*)(kp+4096); kf[5]=*(const __attribute__((address_space(3))) bf16x8*)(kp+4608);
  kf[6]=*(const __attribute__((address_space(3))) bf16x8*)(kp+6144); kf[7]=*(const __attribute__((address_space(3))) bf16x8*)(kp+6656);
}
__device__ __forceinline__ void kload2(bf16x8*kf,lds_cptr kp,int j){ kf[2*j]=*(const __attribute__((address_space(3))) bf16x8*)(kp+j*2048); kf[2*j+1]=*(const __attribute__((address_space(3))) bf16x8*)(kp+j*2048+512); }
__device__ __forceinline__ s16x4 vtr(lds_cptr p){ return __builtin_bit_cast(s16x4,__builtin_amdgcn_ds_read_tr16_b64_v4i16((__attribute__((address_space(3))) v4i16_t*)p)); }
__device__ __forceinline__ float rowmax(const f32x16&p0,const f32x16&p1){
  float a=max3f(p0[0],p0[1],p1[0]),b=max3f(p0[2],p0[3],p1[1]);a=max3f(a,p1[2],p1[3]);
  #pragma unroll
  for(int r=4;r<16;r+=4){a=max3f(a,p0[r],p0[r+1]);b=max3f(b,p0[r+2],p0[r+3]);a=max3f(a,p1[r],p1[r+1]);b=max3f(b,p1[r+2],p1[r+3]);}
  const float m=max2f(a,b);
  auto rr=__builtin_amdgcn_permlane32_swap(__float_as_uint(m),__float_as_uint(m),false,false);
  return max2f(__uint_as_float(rr[0]),__uint_as_float(rr[1]));
}
__device__ __forceinline__ void pv(f32x16*o,int vb,bf16x8 pa0,bf16x8 pa1,bf16x8 pa2,bf16x8 pa3){
  #pragma unroll
  for(int d0=0;d0<2;++d0){s16x4 lo[4],hi[4];
    #pragma unroll
    for(int ks=0;ks<4;++ks){
      asm volatile("ds_read_b64_tr_b16 %0,%1 offset:%c2":"=&v"(lo[ks]):"v"(vb),"i"(d0*4096+ks*1024):"memory");
      asm volatile("ds_read_b64_tr_b16 %0,%1 offset:%c2":"=&v"(hi[ks]):"v"(vb),"i"(d0*4096+ks*1024+512):"memory");}
    asm volatile("s_waitcnt lgkmcnt(0)":::"memory");SBAR();
    #define PK(k) (bf16x8){lo[k][0],lo[k][1],lo[k][2],lo[k][3],hi[k][0],hi[k][1],hi[k][2],hi[k][3]}
    o[d0]=__builtin_amdgcn_mfma_f32_32x32x16_bf16(pa0,PK(0),o[d0],0,0,0);
    o[d0]=__builtin_amdgcn_mfma_f32_32x32x16_bf16(pa1,PK(1),o[d0],0,0,0);
    o[d0]=__builtin_amdgcn_mfma_f32_32x32x16_bf16(pa2,PK(2),o[d0],0,0,0);
    o[d0]=__builtin_amdgcn_mfma_f32_32x32x16_bf16(pa3,PK(3),o[d0],0,0,0);
    #undef PK
  }
}

#ifndef ATTN_STORE16
#define ATTN_STORE16(p,v) (*(u32x4*)(p)=(v))
#endif
template<int THRL> __device__ __forceinline__ void attn_unit(int b,int h,int hv,int qb,const bf16*Q,const bf16*__restrict__ K,const bf16*__restrict__ V,bf16*O,char*shm){
  const int tid=threadIdx.x,lane=tid&63,r32=lane&31,hi=lane>>5; const int wid=__builtin_amdgcn_readfirstlane(tid>>6);
  const long rowbase=(long)b*SEQ; const int q0=qb*QB;
  const bf16*Qw=Q+(rowbase+q0+wid*QBLK)*DM+h*D;
  const bf16*Kh=K+rowbase*DM+h*D,*Vh=V+rowbase*DM+hv*D;
  const unsigned lds0=(unsigned)(uintptr_t)shm;
  float*wsf=(float*)(shm+LDS_WS)+wid*64;
  const bf16*ksrc=Kh+(long)lane*DM+wid*8;
  const bf16*vsrc=Vh+(long)(16*(wid&3)+(lane>>2))*DM+(wid>>2)*32+(lane&3)*8;
  const unsigned kdst=lds0+LDS_K+wid*1024, vdst=lds0+LDS_V+wid*1024;
  #define DMA_K(t,slot) glds16(ksrc+(long)(t)*KVBLK*DM,(unsigned)__builtin_amdgcn_readfirstlane(kdst+(slot)))
  #define DMA_V(t,slot) glds16(vsrc+(long)(t)*KVBLK*DM,(unsigned)__builtin_amdgcn_readfirstlane(vdst+(slot)))
  const int vb0=(int)(lds0+LDS_V)+((lane>>4)&1)*32+(lane&3)*8+(4*hi+((lane&15)>>2))*64;
  const char*Kbase=shm+LDS_K; bf16x8 kf[8];
  const lds_cptr shm3=(lds_cptr)shm; const lds_cptr kp0=shm3+LDS_K+hi*1024+r32*16; const lds_cptr vp0=shm3+LDS_V+((lane>>4)&1)*32+(lane&3)*8+(4*hi+((lane&15)>>2))*64;
  const int NT=(q0+QB)/KVBLK;
  DMA_K(0,0);DMA_V(0,0);DMA_K(1,SLOTB);
  bf16x8 qr[4];
  #pragma unroll
  for(int d0=0;d0<4;++d0)qr[d0]=*reinterpret_cast<const bf16x8*>(&Qw[(long)r32*DM+d0*16+hi*8]);
  float mhat=0.f,l_reg=0.f;f32x16 o[2];o[0]=f32x16{};o[1]=f32x16{};f32x16 negm=f32x16{};asm volatile("":"+v"(negm));

  #define CMASK(P0,P1,t) do{int jb_=(t)-(NT-4); if(jb_>=0)cmask(P0,P1,jb_,wid);}while(0)
  bool resc=false;
  #define START(P0,P1) do{ const float rm=rowmax(P0,P1); resc=false; \
    { const float dl=rm; mhat=fadd_s(mhat,dl); \
      _Pragma("unroll") for(int r=0;r<16;++r){P0[r]=fsub_s(P0[r],dl);P1[r]=fsub_s(P1[r],dl);} \
      _Pragma("unroll") for(int r=0;r<16;++r)negm[r]=-mhat; asm volatile("":"+v"(negm)); } \
    _Pragma("unroll") for(int r=0;r<16;++r)P0[r]=__builtin_amdgcn_exp2f(P0[r]); }while(0)
  #define RESC() do{ if(resc){ asm volatile("s_waitcnt lgkmcnt(0)":::"memory"); \
      _Pragma("unroll") for(int d_=0;d_<2;++d_) _Pragma("unroll") for(int r=0;r<16;++r)o[d_][r]*=wsf[crow(r,hi)]; } }while(0)
  f32x16 pA0,pA1,pB0,pB1;
  int sl_prev=0,sl_cur=0,sl_next=SLOTB;
  #define ROT() do{sl_prev=sl_cur;sl_cur=sl_next;sl_next=(sl_next==(NSLOT-1)*SLOTB)?0:sl_next+SLOTB;}while(0)
  DMA_K(2,2*SLOTB);
  WAIT_BAR(3);
  qkt(pA0,pA1,Kbase,qr,negm,r32,hi);asm volatile("s_nop 15\n\ts_nop 7":"+v"(pA0),"+v"(pA1));CMASK(pA0,pA1,0);
  START(pA0,pA1);
  _Pragma("unroll") for(int r=0;r<16;++r)pA1[r]=__builtin_amdgcn_exp2f(pA1[r]);
  WAIT_BAR(0);
  DMA_K(3,0);DMA_V(1,SLOTB);
  ROT();
  kload8(kf,kp0+sl_cur);
  WAIT_BAR(2);
  s16x4 vlo[8],vhi[8]; u32x4 pw0,pw1,pw2,pw3;
  #define PKW(P,B) cvtpk_s(P[B],P[B+1])
  #define PAF(k) __builtin_bit_cast(bf16x8,pw##k)
  #define VFR(i) (bf16x8){vlo[i][0],vlo[i][1],vlo[i][2],vlo[i][3],vhi[i][0],vhi[i][1],vhi[i][2],vhi[i][3]}
  #define PIN(x) asm volatile("":"+v"(x))
  #define MX3(a,b,c) __builtin_fmaxf(__builtin_fmaxf((a),(b)),(c))
  #define GAPA(MF,A0,A1,A2,A3,W0,W1,PW) do{ MF; sacc+=A0; sacc+=A1; sacc+=A2; sacc+=A3; PIN(sacc); W0; W1; PIN(PW); SBAR(); }while(0)
  #define EX(v) __builtin_amdgcn_exp2f(v)
  #define GAPB(MF,X,B) do{ MF; X[B]=EX(X[B]); X[B+1]=EX(X[B+1]); X[B+2]=EX(X[B+2]); X[B+3]=EX(X[B+3]); PIN(X); SBAR(); }while(0)
  #define VRD(i) do{ vlo[i]=vtr(vp_+(((i)>>2)*4096+((i)&3)*1024)); vhi[i]=vtr(vp_+(((i)>>2)*4096+((i)&3)*1024+512)); }while(0)
  #define KRD(G,j) do{ if(G){ kload2(kf,kp0+sl_next,j); SBAR(); } }while(0)
  #define STEP(C0,C1,P0,P1,t,GK,GV,GL) do{ SBAR(); \
    const lds_cptr vp_=vp0+sl_prev; \
    VRD(0); SBAR(); float sacc=(P0[0]+P0[1]); \
    GAPA(C0=__builtin_amdgcn_mfma_f32_32x32x16_bf16(kf[0],qr[0],negm,0,0,0), P0[2],P0[3],P0[4],P0[5],     pw0[0]=PKW(P0,0), pw0[1]=PKW(P0,2), pw0); \
    VRD(4); SBAR(); GAPA(C1=__builtin_amdgcn_mfma_f32_32x32x16_bf16(kf[1],qr[0],negm,0,0,0), P0[6],P0[7],P0[8],P0[9],     pw0[2]=PKW(P0,4), pw0[3]=PKW(P0,6), pw0); \
    VRD(1); SBAR(); GAPA(C0=__builtin_amdgcn_mfma_f32_32x32x16_bf16(kf[2],qr[1],C0,0,0,0),   P0[10],P0[11],P0[12],P0[13], pw1[0]=PKW(P0,8), pw1[1]=PKW(P0,10), pw1); \
    VRD(5); SBAR(); GAPA(C1=__builtin_amdgcn_mfma_f32_32x32x16_bf16(kf[3],qr[1],C1,0,0,0),   P0[14],P0[15],P1[0],P1[1],   pw1[2]=PKW(P0,12),pw1[3]=PKW(P0,14), pw1); \
    VRD(2); SBAR(); GAPA(C0=__builtin_amdgcn_mfma_f32_32x32x16_bf16(kf[4],qr[2],C0,0,0,0),   P1[2],P1[3],P1[4],P1[5],     pw2[0]=PKW(P1,0), pw2[1]=PKW(P1,2), pw2); \
    VRD(6); SBAR(); GAPA(C1=__builtin_amdgcn_mfma_f32_32x32x16_bf16(kf[5],qr[2],C1,0,0,0),   P1[6],P1[7],P1[8],P1[9],     pw2[2]=PKW(P1,4), pw2[3]=PKW(P1,6), pw2); \
    VRD(3); SBAR(); GAPA(C0=__builtin_amdgcn_mfma_f32_32x32x16_bf16(kf[6],qr[3],C0,0,0,0),   P1[10],P1[11],P1[12],P1[13], pw3[0]=PKW(P1,8), pw3[1]=PKW(P1,10), pw3); \
    VRD(7); SBAR(); GAPA(C1=__builtin_amdgcn_mfma_f32_32x32x16_bf16(kf[7],qr[3],C1,0,0,0),   P1[14],P1[15],0.f,0.f,       pw3[2]=PKW(P1,12),pw3[3]=PKW(P1,14), pw3); \
    l_reg+=sacc; \
    if(GK){DMA_K((t)+3,sl_cur);} if(GV){DMA_V((t)+1,sl_next);} \
    CMASK(C0,C1,t); \
    { float a=MX3(C0[0],C0[1],C1[0]),b=MX3(C0[2],C0[3],C1[1]); a=MX3(a,C1[2],C1[3]); \
      _Pragma("unroll") for(int r=4;r<16;r+=4){a=MX3(a,C0[r],C0[r+1]);b=MX3(b,C0[r+2],C0[r+3]);a=MX3(a,C1[r],C1[r+1]);b=MX3(b,C1[r+2],C1[r+3]);} \
      float rm=__builtin_fmaxf(a,b); { auto rr=__builtin_amdgcn_permlane32_swap(__float_as_uint(rm),__float_as_uint(rm),false,false); rm=__builtin_fmaxf(__uint_as_float(rr[0]),__uint_as_float(rr[1])); } \
      resc=false; \
      if(__builtin_expect(__any(rm>(float)THRL),0)){ const float dl=__builtin_fmaxf(rm,0.f); mhat+=dl; \
        _Pragma("unroll") for(int r=0;r<16;++r){C0[r]-=dl;C1[r]-=dl;} \
        _Pragma("unroll") for(int r=0;r<16;++r)negm[r]=-mhat; asm volatile("":"+v"(negm)); \
        const float f=__builtin_amdgcn_exp2f(-dl); l_reg*=f; if(hi==0)wsf[r32]=f; resc=true; } } \
    SBAR(); \
    GAPB(o[0]=__builtin_amdgcn_mfma_f32_32x32x16_bf16(PAF(0),VFR(0),o[0],0,0,0), C0,0); \
    GAPB(o[1]=__builtin_amdgcn_mfma_f32_32x32x16_bf16(PAF(0),VFR(4),o[1],0,0,0), C0,4); \
    KRD(GL,0); GAPB(o[0]=__builtin_amdgcn_mfma_f32_32x32x16_bf16(PAF(1),VFR(1),o[0],0,0,0), C0,8); \
    KRD(GL,1); GAPB(o[1]=__builtin_amdgcn_mfma_f32_32x32x16_bf16(PAF(1),VFR(5),o[1],0,0,0), C0,12); \
    KRD(GL,2); GAPB(o[0]=__builtin_amdgcn_mfma_f32_32x32x16_bf16(PAF(2),VFR(2),o[0],0,0,0), C1,0); \
    KRD(GL,3); GAPB(o[1]=__builtin_amdgcn_mfma_f32_32x32x16_bf16(PAF(2),VFR(6),o[1],0,0,0), C1,4); \
    GAPB(o[0]=__builtin_amdgcn_mfma_f32_32x32x16_bf16(PAF(3),VFR(3),o[0],0,0,0), C1,8); \
    GAPB(o[1]=__builtin_amdgcn_mfma_f32_32x32x16_bf16(PAF(3),VFR(7),o[1],0,0,0), C1,12); \
    }while(0)
  int t=1;
  #undef CMASK
  #define CMASK(P0,P1,t) do{}while(0)
  for(;t+5<NT;t+=2){
    STEP(pB0,pB1,pA0,pA1,t,true,true,true);     WAIT_BAR(2); RESC(); ROT();
    STEP(pA0,pA1,pB0,pB1,t+1,true,true,true);   WAIT_BAR(2); RESC(); ROT();
  }
  #undef CMASK
  #define CMASK(P0,P1,t) do{int jb_=(t)-(NT-4); if(jb_>=0)cmask(P0,P1,jb_,wid);}while(0)
  #define ENDW(tt) do{ if((tt)+3<NT){WAIT_BAR(2);} else if((tt)+2<NT){WAIT_BAR(1);} else {WAIT_BAR(0);} }while(0)
  for(;t+1<NT;t+=2){
    STEP(pB0,pB1,pA0,pA1,t,(t+3<NT),(t+1<NT),(t+1<NT));       ENDW(t);   RESC(); ROT();
    STEP(pA0,pA1,pB0,pB1,t+1,(t+4<NT),(t+2<NT),(t+2<NT));     ENDW(t+1); RESC(); ROT();
  }
  STEP(pB0,pB1,pA0,pA1,NT-1,false,false,false); RESC();
  { float sacc=pB0[0]+pB0[1]; _Pragma("unroll") for(int r=2;r<16;++r)sacc+=pB0[r]; _Pragma("unroll") for(int r=0;r<16;++r)sacc+=pB1[r]; l_reg+=sacc;
    pw0=(u32x4){PKW(pB0,0),PKW(pB0,2),PKW(pB0,4),PKW(pB0,6)};pw1=(u32x4){PKW(pB0,8),PKW(pB0,10),PKW(pB0,12),PKW(pB0,14)};pw2=(u32x4){PKW(pB1,0),PKW(pB1,2),PKW(pB1,4),PKW(pB1,6)};pw3=(u32x4){PKW(pB1,8),PKW(pB1,10),PKW(pB1,12),PKW(pB1,14)};
    SBAR(); pv(o,vb0+sl_cur,PAF(0),PAF(1),PAF(2),PAF(3)); }
  #undef PKW
  #undef PAF
  #undef VFR
  #undef PIN
  #undef MX3
  #undef GAPA
  #undef GAPB
  #undef EX
  #undef VRD
  #undef KRD
  #undef STEP
  #undef ENDW
  {auto rr=__builtin_amdgcn_permlane32_swap(__float_as_uint(l_reg),__float_as_uint(l_reg),false,false);l_reg=__uint_as_float(rr[0])+__uint_as_float(rr[1]);}
  if(hi==0)wsf[32+r32]=l_reg;asm volatile("s_waitcnt lgkmcnt(0)":::"memory");
  float rli[16];
  #pragma unroll
  for(int r=0;r<16;++r)rli[r]=__builtin_amdgcn_rcpf(wsf[32+crow(r,hi)]);
  bf16*Ow=O+(rowbase+q0+wid*QBLK)*DM+hv*D;
  { bf16*stg=(bf16*)(shm+LDS_OST)+wid*2048;
    #pragma unroll
    for(int r=0;r<16;++r){const int orow=crow(r,hi);
      #pragma unroll
      for(int d0=0;d0<2;++d0)stg[orow*64+d0*32+r32]=__float2bfloat16(o[d0][r]*rli[r]);}
    asm volatile("s_waitcnt lgkmcnt(0)":::"memory");
    #pragma unroll
    for(int i=0;i<4;++i){const int row=i*8+(lane>>3),ch=lane&7; const u32x4 v=*(const u32x4*)(stg+row*64+ch*8); ATTN_STORE16(Ow+(long)row*DM+ch*8,v);} }
  asm volatile("s_waitcnt lgkmcnt(0)\n\ts_barrier":::"memory");
  #undef DMA_K
  #undef DMA_V
  #undef CMASK
  #undef START
  #undef RESC
  #undef ROT
}
constexpr int ATTN_LDS_BYTES=LDS_BYTES;
struct AttnTensors { const bf16* Q; const bf16* K; const bf16* V; bf16* O0; bf16* O1; };
struct AttnUnit { int combo; int qb; };
struct StaticOrder {
  int vcu, G;
  __device__ __forceinline__ explicit StaticOrder(int grid,int vcu_):vcu(vcu_),G(grid){}
  __device__ __forceinline__ bool next(int i,AttnUnit&u)const{ const int c=vcu+(i>>3)*G; if(c>=BATCH*NHEAD*2)return false; u.combo=c; u.qb=7-(i&7); return true; }
  __device__ __forceinline__ void a_ready(const AttnUnit&)const{}
  __device__ __forceinline__ void done(const AttnUnit&)const{}
};
template<class Sched,int THRL=8> __device__ __forceinline__ void attn_phase(char*lds,const AttnTensors&T,const Sched&S){
  AttnUnit u;
  for(int i=0;S.next(i,u);++i){ S.a_ready(u); const int b=u.combo>>5, hq=(u.combo>>1)&15, vh=u.combo&1; attn_unit<THRL>(b,hq,(hq&~1)+vh,u.qb,T.Q,T.K,T.V,(hq&1)?T.O1:T.O0,lds); S.done(u); }
}
#undef SBAR
#undef WAIT_BAR
}
#define GAS __attribute__((address_space(1)))
#define LAS __attribute__((address_space(3)))
typedef unsigned short bf16;
typedef unsigned v4u __attribute__((ext_vector_type(4)));
typedef float f32x4 __attribute__((ext_vector_type(4)));
typedef short bf16x8 __attribute__((ext_vector_type(8)));
typedef GAS unsigned gu32;
typedef GAS unsigned long long gu64;
#define RLX_AGENT __ATOMIC_RELAXED, __HIP_MEMORY_SCOPE_AGENT
#define LDS_WAIT() asm volatile("s_waitcnt lgkmcnt(0)" ::: "memory")
#define VM_WAIT() asm volatile("s_waitcnt vmcnt(0)" ::: "memory")
__device__ __forceinline__ unsigned long long rt() { return __builtin_amdgcn_s_memrealtime(); }
__device__ __forceinline__ unsigned f2bf(float f) { unsigned u = __builtin_bit_cast(unsigned, f); return (u + 0x7fffu + ((u >> 16) & 1u)) >> 16; }
typedef float pk_f32x2 __attribute__((ext_vector_type(2))); typedef __bf16 pk_bf16x2 __attribute__((ext_vector_type(2)));
__device__ __forceinline__ unsigned pk2(float lo, float hi) { const pk_f32x2 v = {lo, hi}; return __builtin_bit_cast(unsigned, __builtin_convertvector(v, pk_bf16x2)); }

#define XB_TMO      128
#define XB_XCNT(j)  (256  + 64 * (j))
#define XB_XSUB(j)  (1280 + 64 * (j))
#define XB_XGEN(j)  (2304 + 64 * (j))
#define XB_TOP      3328
#define XB_TOPGEN   3392
#define XCD_BAR_WORDS 3456
#define XB_SPIN_CAP (1u << 18)

__device__ __forceinline__ unsigned xb_ld(unsigned* p)              { return __hip_atomic_load(p, __ATOMIC_RELAXED, __HIP_MEMORY_SCOPE_AGENT); }
__device__ __forceinline__ unsigned xb_add(unsigned* p, unsigned v) { return __hip_atomic_fetch_add(p, v, __ATOMIC_RELAXED, __HIP_MEMORY_SCOPE_AGENT); }
__device__ __forceinline__ unsigned xb_xcc_id() { return (unsigned)__builtin_amdgcn_s_getreg((3 << 11) | 20) & 0xFu; }
#define XB_SPIN(cond, bar) do { unsigned _sp = 0; while (cond) { __builtin_amdgcn_s_sleep(1); \
    if ((++_sp & 255u) == 0u) { if (xb_ld(&(bar)[XB_TMO])) break; if (_sp > XB_SPIN_CAP) { atomicAdd(&(bar)[XB_TMO], 1u); break; } } } } while (0)

struct XcdBarrier {
    unsigned* bar; unsigned x;
    volatile LAS unsigned* st;
};

__device__ __forceinline__ XcdBarrier xcd_barrier_post(unsigned* bar, volatile LAS unsigned* st) {
    XcdBarrier b; b.bar = bar; b.x = xb_xcc_id(); b.st = st;
    if (threadIdx.x == 0) (void)xb_add(&bar[XB_XCNT(b.x)], 1u);
    return b;
}
__device__ __forceinline__ void xcd_barrier_complete(unsigned* bar, unsigned x, unsigned& nloc, unsigned& nx) {
    const unsigned G = gridDim.x * gridDim.y * gridDim.z;
    unsigned sum, cnt, mine, sp = 0u;
    for (;;) {
        sum = 0u; cnt = 0u; mine = 0u;
#pragma unroll
        for (unsigned j = 0; j < 16; ++j) { const unsigned c = xb_ld(&bar[XB_XCNT(j)]); sum += c; cnt += (c > 0u) ? 1u : 0u; mine = (j == x) ? c : mine; }
        if (sum == G) break;
        __builtin_amdgcn_s_sleep(1);
        if ((++sp & 255u) == 0u) { if (xb_ld(&bar[XB_TMO])) break; if (sp > XB_SPIN_CAP) { atomicAdd(&bar[XB_TMO], 1u); break; } }
    }
    nloc = mine > 0u ? mine : 1u; nx = cnt > 0u ? cnt : 1u;
}

__device__ __forceinline__ unsigned xcd_barrier_arrive(const XcdBarrier& b) {
    asm volatile("s_waitcnt vmcnt(0)" ::: "memory");
    __syncthreads();
    unsigned target = 0u;
    if (threadIdx.x == 0) {
        unsigned* bar = b.bar;
        __builtin_amdgcn_s_waitcnt(0);
        unsigned nloc = b.st[0], nx = b.st[1];
        if (nloc == 0u) { xcd_barrier_complete(bar, b.x, nloc, nx); b.st[0] = nloc; b.st[1] = nx; }
        const unsigned old = xb_add(&bar[XB_XSUB(b.x)], 1u);
        const unsigned gen = old / nloc;
        if (old + 1u == (gen + 1u) * nloc) {
            __builtin_amdgcn_fence(__ATOMIC_RELEASE, "agent");
            asm volatile("s_waitcnt vmcnt(0)" ::: "memory");
            (void)xb_add(&bar[XB_TOP], 1u);
        }
        target = (gen + 1u) * nx;
    }
    return target;
}
__device__ __forceinline__ void xcd_barrier_wait(const XcdBarrier& b, unsigned target) {
    if (threadIdx.x == 0) {
        unsigned* bar = b.bar;
        XB_SPIN(xb_ld(&bar[XB_TOP]) < target, bar);
        __builtin_amdgcn_fence(__ATOMIC_ACQUIRE, "agent");
        asm volatile("s_waitcnt vmcnt(0)" ::: "memory");
    }
    __syncthreads();
}
__device__ __forceinline__ void xcd_barrier(const XcdBarrier& b) { const unsigned t = xcd_barrier_arrive(b); xcd_barrier_wait(b, t); }

constexpr int NWAVES = 8;
constexpr int D = 1024, MP = 16384, MS = 1024, M = MP + MS;
constexpr int NSEQ = 40;
constexpr int DFF = 2816, AIN = 6144, NMODC = 20480;
constexpr int NPOS = 2080;
constexpr float EPS = 1e-6f;
constexpr float LAM_INIT = 0.35550906759096934f;
constexpr float QSCALE = 0.125f * 1.4426950408889634f;

constexpr size_t MiB = 1u << 20;
constexpr size_t WS_CTL = 0;
constexpr size_t WS_MOD = 1 * MiB;
constexpr size_t ZERO_BYTES = 64 * 1024;
constexpr size_t WS_ROPEA = 5 * MiB, WS_ROPEB = 7 * MiB;
constexpr size_t WS_WFI = 8 * MiB;
constexpr size_t SZ_WFI = (size_t)5632 * 1024 * 2;
constexpr size_t WS_WFO = WS_WFI + 4 * SZ_WFI;
constexpr size_t SZ_WFO = (size_t)1024 * 2816 * 2;
constexpr size_t WS_WIA = WS_WFO + 4 * SZ_WFO;
constexpr size_t WS_WOA = WS_WIA + (size_t)6144 * 1024 * 2;
constexpr size_t WS_WKV = WS_WOA + (size_t)1024 * 2048 * 2;
constexpr size_t WS_WQB = WS_WKV + (size_t)2048 * 1024 * 2;
constexpr size_t WS_WOB = WS_WQB + (size_t)1024 * 1024 * 2;
constexpr size_t WS_ACT = 128 * MiB;
constexpr size_t SZ_A1 = (size_t)M * 1024 * 2, SZ_A2 = (size_t)M * 2048 * 2, SZ_U = (size_t)M * 2816 * 2;
constexpr size_t WS_H = WS_ACT, WS_HKV = WS_H + SZ_A1, WS_Y = WS_HKV + SZ_A1, WS_U = WS_Y + 2 * SZ_A1;
constexpr size_t WS_QR = WS_U + SZ_U, WS_KR = WS_QR + SZ_A1, WS_VR = WS_KR + SZ_A1, WS_GR = WS_VR + SZ_A2, WS_OR = WS_GR + SZ_A2, WS_AR = WS_OR + SZ_A2;
constexpr size_t WS_KB = WS_AR + SZ_A2, WS_VB = WS_KB + SZ_A1, WS_QB = WS_VB + SZ_A1, WS_O0 = WS_QB + SZ_A1, WS_O1 = WS_O0 + SZ_A1, WS_AB = WS_O1 + SZ_A1;
constexpr size_t WS_XB = WS_AB + SZ_A1;
constexpr size_t WS_END = WS_XB + SZ_A1;
static_assert(WS_WOB + (size_t)1024 * 1024 * 2 <= WS_ACT && ZERO_BYTES <= WS_MOD && WS_MOD + (size_t)NSEQ * NMODC * 4 <= WS_ROPEA && WS_ROPEA + (size_t)NPOS * 64 * 8 <= WS_ROPEB && WS_ROPEB + (size_t)NPOS * 32 * 8 <= WS_WFI, "d_ws map");
constexpr size_t OUT_Y = 0, OUT_SRP = (size_t)M * 1024, OUT_KP = OUT_SRP + (size_t)8 * 8 * 128 * 256, OUT_VP = OUT_KP + (size_t)MP * 1024, OUT_SRS = OUT_VP + (size_t)MP * 1024,
                 OUT_KS = OUT_SRS + (size_t)32 * 8 * 128 * 256, OUT_VS = OUT_KS + (size_t)MS * 1024, OUT_END = OUT_VS + (size_t)MS * 1024;
static_assert(OUT_END == 63963136, "d_out map");
constexpr int CW_BAR = 4096;
static_assert((CW_BAR + 3456) * 4 <= (int)ZERO_BYTES, "barrier words inside the zeroed region");

constexpr int RING_OFF = 0, RING_BYTES = 131072;
constexpr int LDSCTL_OFF = RING_BYTES, MISC_OFF = LDSCTL_OFF + 320;
constexpr int LDS_BYTES = 147456;
static_assert(MISC_OFF + 128 <= LDS_BYTES, "LDS map");

static __device__ const double INVF[64] = {
 1.0, 0.8659643233600653, 0.7498942093324559, 0.6493816315762113, 0.5623413251903491, 0.4869675251658631, 0.4216965034285822, 0.3651741272548377, 0.31622776601683794, 0.27384196342643613, 0.23713737056616552, 0.2053525026457146, 0.1778279410038923, 0.1539926526059492, 0.1333521432163324, 0.11547819846894582,
 0.1, 0.08659643233600653, 0.07498942093324558, 0.06493816315762113, 0.05623413251903491, 0.04869675251658631, 0.042169650342858224, 0.03651741272548377, 0.03162277660168379, 0.027384196342643614, 0.023713737056616554, 0.02053525026457146, 0.01778279410038923, 0.01539926526059492, 0.01333521432163324, 0.011547819846894581,
 0.01, 0.008659643233600654, 0.007498942093324558, 0.006493816315762113, 0.005623413251903491, 0.004869675251658631, 0.004216965034285823, 0.003651741272548377, 0.0031622776601683794, 0.0027384196342643613, 0.0023713737056616554, 0.002053525026457146, 0.0017782794100389228, 0.001539926526059492, 0.001333521432163324, 0.0011547819846894581,
 0.001, 0.0008659643233600654, 0.0007498942093324559, 0.0006493816315762113, 0.0005623413251903491, 0.0004869675251658631, 0.00042169650342858224, 0.0003651741272548377, 0.00031622776601683794, 0.0002738419634264361, 0.00023713737056616554, 0.0002053525026457146, 0.00017782794100389227, 0.0001539926526059492, 0.0001333521432163324, 0.00011547819846894582 };
__device__ __forceinline__ float lg2gamma(int h) {
    switch (h) { case 0: return -0.04580368961312479f; case 1: return -0.02272007650008353f; case 2: return -0.011315313227834146f; case 3: return -0.005646563141142063f;
                 case 4: return -0.0028205190623786626f; case 5: return -0.0014095702546713536f; case 6: return -0.0007046129765893727f; default: return -0.0003522634716290214f; }
}
__device__ __forceinline__ float bf2f(unsigned short b) { return __builtin_bit_cast(float, (unsigned)b << 16); }
__device__ __forceinline__ float wave_sum(float v) {
#pragma unroll
    for (int o = 1; o < 64; o <<= 1) v += __shfl_xor(v, o);
    return v;
}
__device__ __forceinline__ void unpack8(const v4u w, float (&f)[8]) {
    f[0] = __builtin_bit_cast(float, w.x << 16); f[1] = __builtin_bit_cast(float, w.x & 0xffff0000u); f[2] = __builtin_bit_cast(float, w.y << 16); f[3] = __builtin_bit_cast(float, w.y & 0xffff0000u);
    f[4] = __builtin_bit_cast(float, w.z << 16); f[5] = __builtin_bit_cast(float, w.z & 0xffff0000u); f[6] = __builtin_bit_cast(float, w.w << 16); f[7] = __builtin_bit_cast(float, w.w & 0xffff0000u);
}
__device__ __forceinline__ v4u pack8f(const float (&f)[8]) { v4u o; o.x = pk2(f[0], f[1]); o.y = pk2(f[2], f[3]); o.z = pk2(f[4], f[5]); o.w = pk2(f[6], f[7]); return o; }
__device__ __forceinline__ v4u ldnt16(const void* p) { return __builtin_nontemporal_load((const GAS v4u*)p); }
__device__ __forceinline__ void ld8nt(const float* p, float (&f)[8]) { const f32x4 a = __builtin_nontemporal_load((const GAS f32x4*)p), b = __builtin_nontemporal_load((const GAS f32x4*)(p + 4)); f[0] = a[0]; f[1] = a[1]; f[2] = a[2]; f[3] = a[3]; f[4] = b[0]; f[5] = b[1]; f[6] = b[2]; f[7] = b[3]; }
__device__ __forceinline__ void ld8(const float* p, float (&f)[8]) { const f32x4 a = *(const GAS f32x4*)p, b = *(const GAS f32x4*)(p + 4); f[0] = a[0]; f[1] = a[1]; f[2] = a[2]; f[3] = a[3]; f[4] = b[0]; f[5] = b[1]; f[6] = b[2]; f[7] = b[3]; }
__device__ __forceinline__ void st8(float* p, const float (&f)[8]) { *(GAS f32x4*)p = (f32x4){f[0], f[1], f[2], f[3]}; *(GAS f32x4*)(p + 4) = (f32x4){f[4], f[5], f[6], f[7]}; }

typedef float f32x16_t __attribute__((ext_vector_type(16)));
__device__ __forceinline__ bf16x8 cvt8(const f32x4 a, const f32x4 b) { const v4u w = {pg8::cvt_pk_bf16(a[0], a[1]), pg8::cvt_pk_bf16(a[2], a[3]), pg8::cvt_pk_bf16(b[0], b[1]), pg8::cvt_pk_bf16(b[2], b[3])}; return __builtin_bit_cast(bf16x8, w); }
struct P0Args { const float *c_p, *c_s, *w_ada, *b_ada, *w_ffn_in, *w_ffn_out, *w_in_a, *w_out_a, *w_ada_kv, *b_ada_kv, *w_kv, *w_q_b, *w_out_b; unsigned char* ws; };
struct TItem { const float* src; bf16* dst; int K, Nsrc, k0, sc0, dr0; float mul; };
constexpr int I_FI = 16 * 176, I_FO = 44 * 32, I_IA = 16 * 192, I_OA = 32 * 32, I_KV = 16 * 64, I_QB = 16 * 32, I_OB = 16 * 32;
constexpr int P0_SET0 = I_FI, P0_SET1 = I_OA + I_FI + I_FO, P0_SET2 = I_OB + I_FI + I_FO, P0_SET3 = 2 * I_FO + I_IA + I_FI + I_KV + I_QB;
constexpr int P0_NITEMS = P0_SET0 + P0_SET1 + P0_SET2 + P0_SET3;
static_assert(P0_NITEMS == 4 * I_FI + 4 * I_FO + I_IA + I_OA + I_KV + I_QB + I_OB, "item sets");
__device__ __forceinline__ TItem p0_item_fi(const P0Args& A, int mi, int r) { TItem t; const int kb = r / 176, nb = r % 176, n0 = 32 * nb;
    const int pn = n0 >> 8, bj = (n0 >> 7) & 1, i0 = n0 & 127;
    t.src = A.w_ffn_in + (size_t)mi * 1024 * 5632; t.dst = (bf16*)(A.ws + WS_WFI + mi * SZ_WFI); t.K = 1024; t.Nsrc = 5632; t.k0 = 64 * kb; t.sc0 = bj * 2816 + 128 * pn + i0; t.dr0 = n0; t.mul = bj ? 0.6931471805599453f : 1.4426950408889634f; return t; }
__device__ __forceinline__ TItem p0_item_fo(const P0Args& A, int mi, int r) { TItem t; const int kb = r / 32, nb = r % 32;
    t.src = A.w_ffn_out + (size_t)mi * 2816 * 1024; t.dst = (bf16*)(A.ws + WS_WFO + mi * SZ_WFO); t.K = 2816; t.Nsrc = 1024; t.k0 = 64 * kb; t.sc0 = 32 * nb; t.dr0 = 32 * nb; t.mul = 1.0f; return t; }
__device__ __forceinline__ TItem p0_item_sq(const float* src, bf16* dst, int K, int r) { TItem t; const int kb = r / 32, nb = r % 32;
    t.src = src; t.dst = dst; t.K = K; t.Nsrc = 1024; t.k0 = 64 * kb; t.sc0 = 32 * nb; t.dr0 = 32 * nb; t.mul = 1.0f; return t; }
template <int SET> __device__ __forceinline__ TItem p0_decode(const P0Args& A, int r  ) {
    TItem t;
    if (SET == 0) { return p0_item_fi(A, 0, r);
    } else if (SET == 3) {
    if (r < I_FO) return p0_item_fo(A, 0, r); r -= I_FO;
    if (r < I_IA) { const int kb = r / 192, nb = r % 192, n0 = 32 * nb; int sc0 = n0;
        if (n0 < 2048) { const int sec = n0 >> 10, pn4 = (n0 >> 8) & 3, bj = (n0 >> 7) & 1, hh = (n0 >> 6) & 1, d = n0 & 63;
            sc0 = sec * 1024 + (2 * pn4 + hh) * 128 + d + 64 * bj; }
        t.src = A.w_in_a; t.dst = (bf16*)(A.ws + WS_WIA); t.K = 1024; t.Nsrc = 6144; t.k0 = 64 * kb; t.sc0 = sc0; t.dr0 = n0; t.mul = 1.0f; return t; }
    r -= I_IA;
    if (r < I_FI) return p0_item_fi(A, 2, r); r -= I_FI;
    if (r < I_KV) { const int kb = r / 64, nb = r % 64, n0 = 32 * nb; int sc0 = n0;
        if (n0 < 1024) { const int pn = n0 >> 8, bj = (n0 >> 7) & 1, g = (n0 >> 5) & 3; sc0 = (4 * pn + g) * 64 + 32 * bj; }
        t.src = A.w_kv; t.dst = (bf16*)(A.ws + WS_WKV); t.K = 1024; t.Nsrc = 2048; t.k0 = 64 * kb; t.sc0 = sc0; t.dr0 = n0; t.mul = 1.0f; return t; }
    r -= I_KV;
    if (r < I_FO) return p0_item_fo(A, 2, r); r -= I_FO;
    { const int kb = r / 32, nb = r % 32, n0 = 32 * nb; const int pn = n0 >> 8, bj = (n0 >> 7) & 1, g = (n0 >> 5) & 3;
        t.src = A.w_q_b; t.dst = (bf16*)(A.ws + WS_WQB); t.K = 1024; t.Nsrc = 1024; t.k0 = 64 * kb; t.sc0 = (4 * pn + g) * 64 + 32 * bj; t.dr0 = n0; t.mul = 1.0f; return t; }
    } else if (SET == 1) {
    if (r < I_OA) return p0_item_sq(A.w_out_a, (bf16*)(A.ws + WS_WOA), 2048, r); r -= I_OA;
    if (r < I_FI) return p0_item_fi(A, 1, r); r -= I_FI;
    return p0_item_fo(A, 1, r);
    } else {
    if (r < I_OB) return p0_item_sq(A.w_out_b, (bf16*)(A.ws + WS_WOB), 1024, r); r -= I_OB;
    if (r < I_FI) return p0_item_fi(A, 3, r); r -= I_FI;
    return p0_item_fo(A, 3, r);
    }
}
__device__ __forceinline__ void p0_tload(const TItem& t, f32x4 (&v)[8], int lane) {
    const float* p = t.src + (size_t)(t.k0 + (lane >> 3)) * t.Nsrc + t.sc0 + 4 * (lane & 7);
#pragma unroll
    for (int i = 0; i < 8; ++i) v[i] = __builtin_nontemporal_load((const GAS f32x4*)(p + (size_t)(8 * i) * t.Nsrc));
}
__device__ __forceinline__ void p0_tstore(const TItem& t, const f32x4 (&v)[8], LAS float* scr, int lane) {
    { const int kr = lane >> 3, c4 = 4 * (lane & 7);
#pragma unroll
      for (int i = 0; i < 8; ++i) { LAS float* d = scr + (kr + 8 * i) * 33 + c4; d[0] = v[i][0]; d[1] = v[i][1]; d[2] = v[i][2]; d[3] = v[i][3]; } }
    LDS_WAIT(); asm volatile("" ::: "memory");
    const int c = lane & 7;
#pragma unroll
    for (int j = 0; j < 4; ++j) { const int n = (lane >> 3) + 8 * j; const LAS float* s = scr + (8 * c) * 33 + n;
        const float ml = t.mul; v4u o; o.x = pk2(s[0 * 33] * ml, s[1 * 33] * ml); o.y = pk2(s[2 * 33] * ml, s[3 * 33] * ml); o.z = pk2(s[4 * 33] * ml, s[5 * 33] * ml); o.w = pk2(s[6 * 33] * ml, s[7 * 33] * ml);
        *(GAS v4u*)(t.dst + (size_t)(t.dr0 + n) * t.K + t.k0 + 8 * c) = o; }
    LDS_WAIT(); asm volatile("" ::: "memory");
}
template <int SET> __device__ __forceinline__ void p0_convert(const P0Args& A, LAS unsigned char* lds, int gw, int NGW, int lane, int wave, int it0 = 0, int it1 = (SET == 0 ? P0_SET0 : SET == 1 ? P0_SET1 : SET == 2 ? P0_SET2 : P0_SET3)) {
    LAS float* scr = (LAS float*)(lds + RING_OFF + wave * 16384);
    int it = it0 + gw; f32x4 cur[8], nxt[8]; TItem tc, tn;
    if (it < it1) { tc = p0_decode<SET>(A, it); p0_tload(tc, cur, lane); }
    while (it < it1) {
        const int nit = it + NGW;
        if (nit < it1) { tn = p0_decode<SET>(A, nit); p0_tload(tn, nxt, lane); }
        p0_tstore(tc, cur, scr, lane);
#pragma unroll
        for (int i = 0; i < 8; ++i) cur[i] = nxt[i];
        tc = tn; it = nit;
    }
}
typedef float f32x2_t __attribute__((ext_vector_type(2)));
__device__ __forceinline__ void p0_mod(const P0Args& A, LAS unsigned char* lds, int vcu, int G, int tid, int lane, int wave) {
    {   LAS float* red = (LAS float*)(lds + RING_OFF);
        float* MODw = (float*)(A.ws + WS_MOD);
        const int r32 = lane & 31, hi = lane >> 5;
        for (int it = vcu; it < NMODC / 32; it += G) {
            const int col0 = 32 * it; const float* W; const float* bias; int N, col;
            if (col0 < 9216) { W = A.w_ada; bias = A.b_ada; N = 9216; col = col0; }
            else if (col0 < 18432) { W = A.w_ada + (size_t)1024 * 9216; bias = A.b_ada + 9216; N = 9216; col = col0 - 9216; }
            else { W = A.w_ada_kv; bias = A.b_ada_kv; N = 2048; col = col0 - 18432; }
            const int kw = 128 * wave; const int loff = hi * 8 * N + r32;
            const float* c0p = (r32 < 8 ? A.c_p + r32 * 1024 : A.c_s + (r32 - 8) * 1024) + kw + 8 * hi;
            const float* c1p = A.c_s + (24 + (r32 & 7)) * 1024 + kw + 8 * hi;
            f32x16_t acc0, acc1;
#pragma unroll
            for (int r = 0; r < 16; ++r) { acc0[r] = 0.f; acc1[r] = 0.f; }
#pragma nounroll
            for (int hf = 0; hf < 2; ++hf) {
                float wv[4][8];
#pragma unroll
                for (int st = 0; st < 4; ++st)
#pragma unroll
                    for (int j = 0; j < 8; ++j) { const float* rowb = W + (size_t)(kw + 64 * hf + 16 * st + j) * N + col; wv[st][j] = __builtin_nontemporal_load((const GAS float*)(rowb + loff)); }
#pragma unroll
                for (int st = 0; st < 4; ++st) {
                    float ca[8], cb[8]; ld8(c0p + 64 * hf + 16 * st, ca); ld8(c1p + 64 * hf + 16 * st, cb);
#pragma unroll
                    for (int j = 0; j < 8; ++j) { ca[j] = ca[j] / (1.0f + __expf(-ca[j])); cb[j] = (r32 < 8) ? cb[j] / (1.0f + __expf(-cb[j])) : 0.f; }
                    const bf16x8 bfr = cvt8((f32x4){wv[st][0], wv[st][1], wv[st][2], wv[st][3]}, (f32x4){wv[st][4], wv[st][5], wv[st][6], wv[st][7]});
                    acc0 = __builtin_amdgcn_mfma_f32_32x32x16_bf16(cvt8((f32x4){ca[0], ca[1], ca[2], ca[3]}, (f32x4){ca[4], ca[5], ca[6], ca[7]}), bfr, acc0, 0, 0, 0);
                    acc1 = __builtin_amdgcn_mfma_f32_32x32x16_bf16(cvt8((f32x4){cb[0], cb[1], cb[2], cb[3]}, (f32x4){cb[4], cb[5], cb[6], cb[7]}), bfr, acc1, 0, 0, 0);
                }
            }
#pragma unroll
            for (int r = 0; r < 16; ++r) { const int sq = (r & 3) + 8 * (r >> 2) + 4 * hi; red[(wave * 40 + sq) * 32 + r32] = acc0[r]; if (sq < 8) red[(wave * 40 + 32 + sq) * 32 + r32] = acc1[r]; }
            __syncthreads();
            for (int u = tid; u < NSEQ * 32; u += NWAVES * 64) { float v = bias[col + (u & 31)];
#pragma unroll
                for (int w8 = 0; w8 < 8; ++w8) v += red[w8 * 40 * 32 + u];
                MODw[(size_t)(u >> 5) * NMODC + col0 + (u & 31)] = v; }
            __syncthreads();
        }
    }
}
__device__ __forceinline__ void p0_rest(const P0Args& A, LAS unsigned char* lds, int vcu, int G, int tid, int lane, int wave) {
    const int gw = vcu * NWAVES + wave, NGW = G * NWAVES;
    p0_convert<0>(A, lds, gw, NGW, lane, wave);
    float* RA = (float*)(A.ws + WS_ROPEA); float* RB = (float*)(A.ws + WS_ROPEB);
    for (int e = gw * 64 + lane; e < NPOS * 64; e += NGW * 64) {
        const int pi = e >> 6, d = e & 63; const double pos = (double)(pi < 2048 ? pi : 4096 + (pi - 2048));
        const double t = pos * INVF[d] * 0.15915494309189535; const float fr = (float)(t - floor(t));
        const float cs = __builtin_amdgcn_cosf(fr), sn = __builtin_amdgcn_sinf(fr);
        RA[2 * e] = cs; RA[2 * e + 1] = sn;
        if ((d & 1) == 0) { const int eb = pi * 32 + (d >> 1); RB[2 * eb] = cs; RB[2 * eb + 1] = sn; }
    }
}

struct RowOut { const float* gn; int shift_off, scale_off; bf16* dst; };
struct RowPre { float A1[2][8], B0[2][8], S0[2][8], B1[2][8], S1[2][8]; };
template <bool HAS_Y, int NOUT>
__device__ __forceinline__ void rowpre(RowPre& P, const float* gw, int gate_off, float gs, const RowOut o0, const RowOut o1, const float* MOD, int r0, int lane) {
    const int c0 = 8 * lane; const int seq = r0 < MP ? (r0 >> 11) : 8 + ((r0 - MP) >> 5); const float* mrow = MOD + (size_t)seq * NMODC;
#pragma unroll
    for (int j = 0; j < 2; ++j) {
        if (HAS_Y) { float g[8], t[8]; ld8(gw + c0 + 512 * j, g); ld8(mrow + gate_off + c0 + 512 * j, t);
#pragma unroll
            for (int e = 0; e < 8; ++e) P.A1[j][e] = gs * t[e] * g[e]; }
        if (NOUT >= 1) { float g[8], t[8]; ld8(o0.gn + c0 + 512 * j, g); ld8(mrow + o0.scale_off + c0 + 512 * j, t); ld8(mrow + o0.shift_off + c0 + 512 * j, P.S0[j]);
#pragma unroll
            for (int e = 0; e < 8; ++e) P.B0[j][e] = g[e] * (1.0f + t[e]); }
        if (NOUT >= 2) { float g[8], t[8]; ld8(o1.gn + c0 + 512 * j, g); ld8(mrow + o1.scale_off + c0 + 512 * j, t); ld8(mrow + o1.shift_off + c0 + 512 * j, P.S1[j]);
#pragma unroll
            for (int e = 0; e < 8; ++e) P.B1[j][e] = g[e] * (1.0f + t[e]); }
    }
}
template <bool HAS_Y, int NOUT, bool XIN_BF, int XOUT  , bool HASPRE = false  >
__device__ __forceinline__ void rowpass(const float* xp, const float* xs  , bf16* xb  , const bf16* Y, const float* gw, int gate_off, float gs, float* xdst,
                                        const RowOut o0, const RowOut o1, const float* MOD, int gw_id, int NGW, int lane, int ykdim, int G, RowPre& Q  ) {
    const int c0 = 8 * lane;
    pg8::StreamK SK; if (HAS_Y) SK.init(M, 1024, ykdim, G, 0);
    for (int seg = 0; seg < 2; ++seg) {
        const int nblk = seg == 0 ? MP / 8 : MS;
        for (int bi = gw_id; bi < nblk; bi += NGW) {
            const int r0 = seg == 0 ? 8 * bi : MP + bi, nr = seg == 0 ? 8 : 1;
            const int seq = r0 < MP ? (r0 >> 11) : 8 + ((r0 - MP) >> 5);
            const float* mrow = MOD + (size_t)seq * NMODC;
            bool two[2] = {false, false};
            if (HAS_Y) { _Pragma("unroll") for (int j = 0; j < 2; ++j) two[j] = SK.pieces((r0 >> 8) * 4 + (lane >> 5) + 2 * j) > 1; }
            if (!(HASPRE && seg == 0 && bi == gw_id)) rowpre<HAS_Y, NOUT>(Q, gw, gate_off, gs, o0, o1, MOD, r0, lane);
            float (&A1)[2][8] = Q.A1; float (&B0)[2][8] = Q.B0; float (&S0)[2][8] = Q.S0; float (&B1)[2][8] = Q.B1; float (&S1)[2][8] = Q.S1;
            for (int rr = 0; rr < nr; ++rr) {
                const int r = r0 + rr;
                float x[2][8];
                if (XIN_BF) {
#pragma unroll
                    for (int j = 0; j < 2; ++j) unpack8(ldnt16(xb + (size_t)r * 1024 + c0 + 512 * j), x[j]);
                } else { const float* xrow = (r < MP) ? xp + (size_t)r * 1024 : xs + (size_t)(r - MP) * 1024;
#pragma unroll
                    for (int j = 0; j < 2; ++j) ld8nt(xrow + c0 + 512 * j, x[j]); }
                if (HAS_Y) {
                    float y[2][8]; float ss = 0.f;
#pragma unroll
                    for (int j = 0; j < 2; ++j) { unpack8(ldnt16(Y + (size_t)r * 1024 + c0 + 512 * j), y[j]);
                        if (two[j]) { float y2[8]; unpack8(ldnt16(Y + SZ_A1 / 2 + (size_t)r * 1024 + c0 + 512 * j), y2); _Pragma("unroll") for (int e = 0; e < 8; ++e) y[j][e] += y2[e]; }
#pragma unroll
                        for (int e = 0; e < 8; ++e) ss += y[j][e] * y[j][e]; }
                    const float rstd = rsqrtf(wave_sum(ss) * (1.0f / 1024.0f) + EPS);
#pragma unroll
                    for (int j = 0; j < 2; ++j)
#pragma unroll
                        for (int e = 0; e < 8; ++e) x[j][e] += A1[j][e] * (y[j][e] * rstd);
                }
                if (XOUT == 2) {
#pragma unroll
                    for (int j = 0; j < 2; ++j) st8(xdst + (size_t)r * 1024 + c0 + 512 * j, x[j]);
                }
                if (XOUT == 1) {
#pragma unroll
                    for (int j = 0; j < 2; ++j) __builtin_nontemporal_store(pack8f(x[j]), (GAS v4u*)(xb + (size_t)r * 1024 + c0 + 512 * j));
                }
                if (NOUT >= 1) {
                    float ss = 0.f;
#pragma unroll
                    for (int j = 0; j < 2; ++j)
#pragma unroll
                        for (int e = 0; e < 8; ++e) ss += x[j][e] * x[j][e];
                    const float rstd = rsqrtf(wave_sum(ss) * (1.0f / 1024.0f) + EPS);
#pragma unroll
                    for (int j = 0; j < 2; ++j) { float h[8];
#pragma unroll
                        for (int e = 0; e < 8; ++e) h[e] = (x[j][e] * rstd) * B0[j][e] + S0[j][e];
                        *(GAS v4u*)(o0.dst + (size_t)r * 1024 + c0 + 512 * j) = pack8f(h);
                        if (NOUT >= 2) {
#pragma unroll
                            for (int e = 0; e < 8; ++e) h[e] = (x[j][e] * rstd) * B1[j][e] + S1[j][e];
                            *(GAS v4u*)(o1.dst + (size_t)r * 1024 + c0 + 512 * j) = pack8f(h); } }
                }
            }
        }
    }
}
__device__ __forceinline__ void gatenorm_pass(const bf16* OR_, const bf16* GR, const float* ggn, bf16* AR, int gw_id, int NGW, int lane) {
    float gg[4][8];
#pragma unroll
    for (int j = 0; j < 4; ++j) ld8(ggn + 8 * lane + 512 * j, gg[j]);
    for (int r = gw_id; r < M; r += NGW) {
#pragma unroll
        for (int j = 0; j < 4; ++j) { const size_t off = (size_t)r * 2048 + 8 * lane + 512 * j;
            float o[8], g[8]; unpack8(ldnt16(OR_ + off), o); unpack8(ldnt16(GR + off), g);
            float ss = 0.f;
#pragma unroll
            for (int e = 0; e < 8; ++e) ss += o[e] * o[e];
#pragma unroll
            for (int k = 1; k < 32; k <<= 1) ss += __shfl_xor(ss, k);
            const float rstd = rsqrtf(ss * (1.0f / 256.0f) + EPS);
            float a[8];
#pragma unroll
            for (int e = 0; e < 8; ++e) a[e] = pg8::silu_f(g[e]) * ((o[e] * rstd) * gg[j][e]);
            *(GAS v4u*)(AR + off) = pack8f(a); }
    }
}
__device__ __forceinline__ void diffnorm_pass(const bf16* O0, const bf16* O1, const float* lamp  , const float* gsub  , bf16* AB, int gw_id, int NGW, int lane) {
    const float s01 = wave_sum(lamp[lane] * lamp[64 + lane]), s23 = wave_sum(lamp[128 + lane] * lamp[192 + lane]);
    const float lam = expf(s01) - expf(s23) + LAM_INIT;
    float gs[8]; ld8(gsub + 8 * (lane & 15), gs);
#pragma unroll
    for (int e = 0; e < 8; ++e) gs[e] *= (1.0f - LAM_INIT);
    for (int r = gw_id; r < M; r += NGW) {
#pragma unroll
        for (int j = 0; j < 2; ++j) { const size_t off = (size_t)r * 1024 + 8 * lane + 512 * j;
            float a[8], b[8]; unpack8(ldnt16(O0 + off), a); unpack8(ldnt16(O1 + off), b);
            float ss = 0.f;
#pragma unroll
            for (int e = 0; e < 8; ++e) { a[e] -= lam * b[e]; ss += a[e] * a[e]; }
#pragma unroll
            for (int k = 1; k < 16; k <<= 1) ss += __shfl_xor(ss, k);
            const float rstd = rsqrtf(ss * (1.0f / 128.0f) + EPS);
#pragma unroll
            for (int e = 0; e < 8; ++e) a[e] = (a[e] * rstd) * gs[e];
            *(GAS v4u*)(AB + off) = pack8f(a); }
    }
}

typedef float f32x4_t __attribute__((ext_vector_type(4)));
typedef short v4s_t __attribute__((ext_vector_type(4)));
__device__ __forceinline__ f32x4_t mfma16(const bf16x8 a, const bf16x8 b, const f32x4_t c) { return __builtin_amdgcn_mfma_f32_16x16x32_bf16(a, b, c, 0, 0, 0); }
__device__ __forceinline__ bf16x8 tr16(const LAS unsigned char* p, int skip_bytes) {
    const v4s_t lo = __builtin_amdgcn_ds_read_tr16_b64_v4i16((LAS v4s_t*)p), hi = __builtin_amdgcn_ds_read_tr16_b64_v4i16((LAS v4s_t*)(p + skip_bytes));
    return (bf16x8){lo[0], lo[1], lo[2], lo[3], hi[0], hi[1], hi[2], hi[3]};
}
#define WG_BAR_L() do { asm volatile("s_waitcnt lgkmcnt(0)" ::: "memory"); __builtin_amdgcn_s_barrier(); asm volatile("" ::: "memory"); } while (0)
template <int N, int NVT, bool DB>
__device__ __forceinline__ void ret_unit(LAS unsigned char* lds, const bf16* QR_, const bf16* KR_, const bf16* VR_, bf16* ORo, const float* S_in, float* S_out,
                                         int row0, int nchunks, int h, int vbase, int tid, int lane, int wave) {
    constexpr int QP = 136, VP = NVT * 16 + 8, NTI = N / 16, WPT = 8 / NTI, TVW = NVT / WPT, NKS = N / 32;
    constexpr int OFF_K = N * QP * 2, OFF_V = 2 * N * QP * 2, SETB = OFF_V + N * VP * 2, NSET = DB ? 2 : 1, STB = NVT * 16 * QP * 2, OFF_ST = NSET * SETB;
    static_assert(OFF_ST + NSET * STB <= RING_BYTES, "retention LDS");
    const float lg = lg2gamma(h);
    const int l15 = lane & 15, l4 = lane >> 4, trq = (lane & 15) >> 2, trp = lane & 3;
    const int ti = wave / WPT, tv0 = TVW * (wave % WPT);
    constexpr int NPQ = N * 16 / 512;
    constexpr int VPR = NVT * 2;
    constexpr int NPV = (N * VPR + 511) / 512;
    f32x4_t Sacc[NVT];
    if (DB) {
#pragma unroll
        for (int tv = 0; tv < NVT; ++tv) Sacc[tv] = (f32x4_t){0.f, 0.f, 0.f, 0.f};
    } else {
#pragma unroll
        for (int tv = 0; tv < NVT; ++tv)
#pragma unroll
            for (int rg = 0; rg < 4; ++rg) Sacc[tv][rg] = __builtin_nontemporal_load((const GAS float*)(S_in + (size_t)(16 * wave + 4 * l4 + rg) * 256 + vbase + 16 * tv + l15));
    }
#pragma unroll
    for (int tv = 0; tv < NVT; ++tv) {
        unsigned long long w = (unsigned long long)pk2(Sacc[tv][0], Sacc[tv][1]) | ((unsigned long long)pk2(Sacc[tv][2], Sacc[tv][3]) << 32);
        *(LAS unsigned long long*)(lds + OFF_ST + ((16 * tv + l15) * QP + 16 * wave + 4 * l4) * 2) = w;
    }
    const float qdec = __builtin_amdgcn_exp2f(lg * (float)(16 * ti + l15)), cdec = __builtin_amdgcn_exp2f(lg * (float)N);
    float kdec[NKS][8];
#pragma unroll
    for (int ks = 0; ks < NKS; ++ks)
#pragma unroll
        for (int e = 0; e < 8; ++e) kdec[ks][e] = __builtin_amdgcn_exp2f(lg * (float)(N - (32 * ks + 8 * l4 + e)));
    v4u qreg[NPQ], kreg[NPQ], vreg[NPV];
#define RET_FETCH(c) do { _Pragma("unroll") for (int i_ = 0; i_ < NPQ; ++i_) { const int p_ = tid + 512 * i_, row_ = p_ >> 4, c8_ = p_ & 15; const size_t g_ = (size_t)(row0 + (c) * N + row_) * 1024 + h * 128 + 8 * c8_; \
            qreg[i_] = *(const GAS v4u*)(QR_ + g_); kreg[i_] = *(const GAS v4u*)(KR_ + g_); } \
        _Pragma("unroll") for (int i_ = 0; i_ < NPV; ++i_) { const int p_ = tid + 512 * i_; if (p_ < N * VPR) { const int row_ = p_ / VPR, c8_ = p_ % VPR; vreg[i_] = __builtin_nontemporal_load((const GAS v4u*)(VR_ + (size_t)(row0 + (c) * N + row_) * 2048 + h * 256 + vbase + 8 * c8_)); } } } while (0)
#define RET_STAGE(set) do { LAS unsigned char* sb_ = lds + (set) * SETB; \
        _Pragma("unroll") for (int i_ = 0; i_ < NPQ; ++i_) { const int p_ = tid + 512 * i_, row_ = p_ >> 4, c8_ = p_ & 15; *(LAS v4u*)(sb_ + (row_ * QP + 8 * c8_) * 2) = qreg[i_]; *(LAS v4u*)(sb_ + OFF_K + (row_ * QP + 8 * c8_) * 2) = kreg[i_]; } \
        _Pragma("unroll") for (int i_ = 0; i_ < NPV; ++i_) { const int p_ = tid + 512 * i_; if (p_ < N * VPR) { const int row_ = p_ / VPR, c8_ = p_ % VPR; *(LAS v4u*)(sb_ + OFF_V + (row_ * VP + 8 * c8_) * 2) = vreg[i_]; } } } while (0)
    RET_FETCH(0); RET_STAGE(0);
    if (nchunks > 1) RET_FETCH(1);
    WG_BAR_L();
    for (int c = 0; c < nchunks; ++c) {
        const int set = DB ? (c & 1) : 0;
        const LAS unsigned char* Qs = lds + set * SETB; const LAS unsigned char* Ks = Qs + OFF_K; const LAS unsigned char* Vs = Qs + OFF_V;
        const LAS unsigned char* STr = lds + OFF_ST + set * STB; LAS unsigned char* STw = lds + OFF_ST + (DB ? (set ^ 1) : 0) * STB;
        bf16x8 qf[4];
#pragma unroll
        for (int ks = 0; ks < 4; ++ks) qf[ks] = *(const LAS bf16x8*)(Qs + ((16 * ti + l15) * QP + 32 * ks + 8 * l4) * 2);
        bf16x8 pfr[NKS];
        { f32x4_t sT[NTI];
#pragma unroll
          for (int tj = 0; tj < NTI; ++tj) { f32x4_t acc = (f32x4_t){0.f, 0.f, 0.f, 0.f};
#pragma unroll
              for (int ks = 0; ks < 4; ++ks) acc = mfma16(*(const LAS bf16x8*)(Ks + ((16 * tj + l15) * QP + 32 * ks + 8 * l4) * 2), qf[ks], acc);
#pragma unroll
              for (int rg = 0; rg < 4; ++rg) { const int i = 16 * ti + l15, j = 16 * tj + 4 * l4 + rg; const int dd = i > j ? i - j : j - i; acc[rg] *= __builtin_amdgcn_exp2f(lg * (float)dd); }
              sT[tj] = acc; }
#pragma unroll
          for (int s2 = 0; s2 < NKS; ++s2) pfr[s2] = cvt8(sT[2 * s2], sT[2 * s2 + 1]); }
#pragma unroll
        for (int n = 0; n < TVW; ++n) { const int tv = tv0 + n; f32x4_t acc = (f32x4_t){0.f, 0.f, 0.f, 0.f};
#pragma unroll
            for (int ks = 0; ks < 4; ++ks) acc = mfma16(*(const LAS bf16x8*)(STr + ((16 * tv + l15) * QP + 32 * ks + 8 * l4) * 2), qf[ks], acc);
            acc = acc * qdec;
#pragma unroll
            for (int s2 = 0; s2 < NKS; ++s2) acc = mfma16(tr16(Vs + ((32 * s2 + 4 * l4 + trq) * VP + 16 * tv + 4 * trp) * 2, 16 * VP * 2), pfr[s2], acc);
            const unsigned long long w = (unsigned long long)pk2(acc[0], acc[1]) | ((unsigned long long)pk2(acc[2], acc[3]) << 32);
            *(GAS unsigned long long*)(ORo + (size_t)(row0 + c * N + 16 * ti + l15) * 2048 + h * 256 + vbase + 16 * tv + 4 * l4) = w; }
        { bf16x8 ka[NKS];
#pragma unroll
          for (int ks = 0; ks < NKS; ++ks) { const bf16x8 kr = tr16(Ks + ((32 * ks + 8 * l4 + trq) * QP + 16 * wave + 4 * trp) * 2, 4 * QP * 2);
              float kf[8]; unpack8(__builtin_bit_cast(v4u, kr), kf);
#pragma unroll
              for (int e = 0; e < 8; ++e) kf[e] *= kdec[ks][e];
              ka[ks] = cvt8((f32x4){kf[0], kf[1], kf[2], kf[3]}, (f32x4){kf[4], kf[5], kf[6], kf[7]}); }
#pragma unroll
          for (int tv = 0; tv < NVT; ++tv) { Sacc[tv] = Sacc[tv] * cdec;
#pragma unroll
            for (int ks = 0; ks < NKS; ++ks) Sacc[tv] = mfma16(ka[ks], tr16(Vs + ((32 * ks + 8 * l4 + trq) * VP + 16 * tv + 4 * trp) * 2, 4 * VP * 2), Sacc[tv]);
            if (DB) { const unsigned long long w = (unsigned long long)pk2(Sacc[tv][0], Sacc[tv][1]) | ((unsigned long long)pk2(Sacc[tv][2], Sacc[tv][3]) << 32);
                *(LAS unsigned long long*)(STw + ((16 * tv + l15) * QP + 16 * wave + 4 * l4) * 2) = w; } } }
        if (DB && c + 1 < nchunks) { RET_STAGE(set ^ 1); if (c + 2 < nchunks) RET_FETCH(c + 2); }
        WG_BAR_L();
    }
#undef RET_FETCH
#undef RET_STAGE
#pragma unroll
    for (int tv = 0; tv < NVT; ++tv)
#pragma unroll
        for (int rg = 0; rg < 4; ++rg) __builtin_nontemporal_store(Sacc[tv][rg], (GAS float*)(S_out + (size_t)(16 * wave + 4 * l4 + rg) * 256 + vbase + 16 * tv + l15));
}

__device__ __forceinline__ void sattn_unit(LAS unsigned char* lds, int b, int h, const bf16* QB_, const bf16* Q2_  , const float* ck, const float* cv, const float* knew, const float* vnew, bf16* O0_, bf16* O1_, int tid, int lane, int wave) {
    constexpr int NSL = 3, KPITCH = 272, VPITCH = 320, VOFF = 64 * KPITCH, SLOT = VOFF + 64 * VPITCH, NST = 65, PD = 3;
    static_assert(NSL * SLOT <= RING_BYTES && PD == 3 && SLOT % 16 == 0, "sample attention LDS / the counted wait is (PD - 1) * 8 = 16");
    const int t = wave >> 2, kh = (wave >> 1) & 1, vh2 = wave & 1, r32 = lane & 31, hi = lane >> 5;
    bf16x8 qf[4];
    { const bf16* qp = QB_ + (size_t)(MP + 32 * b + r32) * 1024 + (2 * h + t) * 64 + 8 * hi;
      const bf16* qp2 = Q2_ + (size_t)(32 * b + r32) * 1024 + (2 * h + t) * 64 + 8 * hi;
#pragma unroll
      for (int ks = 0; ks < 4; ++ks) { float qa[8]; unpack8(*(const GAS v4u*)(qp + 16 * ks), qa);
#pragma unroll
          for (int pc = 0; pc < 3; ++pc) { float qb2[8]; unpack8(*(const GAS v4u*)(qp2 + (size_t)pc * (1024 * 1024) + 16 * ks), qb2);
#pragma unroll
              for (int e = 0; e < 8; ++e) qa[e] += qb2[e]; }
          qf[ks] = __builtin_bit_cast(bf16x8, pack8f(qa)); }
      asm volatile("s_waitcnt vmcnt(0)" ::: "memory");
#pragma unroll
      for (int ks = 0; ks < 4; ++ks) asm volatile("" : "+v"(qf[ks])); }
    size_t gko[4], gkn[4]; int lko[4], lvo[4];
#pragma unroll
    for (int i = 0; i < 4; ++i) { const int key = (tid >> 5) + 16 * i, pp = tid & 31;
        gko[i] = (size_t)key * 1024 + h * 128 + pp * 4; gkn[i] = (size_t)(key & 31) * 1024 + h * 128 + pp * 4;
        lko[i] = key * KPITCH + pp * 8; lvo[i] = VOFF + key * VPITCH + pp * 8; }
    const float* kbase = ck + (size_t)b * 4096 * 1024; const float* vbase = cv + (size_t)b * 4096 * 1024;
    const float* knb = knew + (size_t)(32 * b) * 1024; const float* vnb = vnew + (size_t)(32 * b) * 1024;
    f32x4 st[PD][8];
#define SA_LOAD(stile, sg) do { const int s_i = (stile) < NST ? (stile) : NST - 1; const bool lastt = s_i == NST - 1; \
        const float* kb_ = lastt ? knb : kbase + (size_t)s_i * 64 * 1024; const float* vb_ = lastt ? vnb : vbase + (size_t)s_i * 64 * 1024; \
        _Pragma("unroll") for (int i_ = 0; i_ < 4; ++i_) { \
            asm volatile("global_load_dwordx4 %0, %1, off nt" : "=&v"(st[sg][i_]) : "v"(kb_ + (lastt ? gkn[i_] : gko[i_])) : "memory"); \
            asm volatile("global_load_dwordx4 %0, %1, off nt" : "=&v"(st[sg][4 + i_]) : "v"(vb_ + (lastt ? gkn[i_] : gko[i_])) : "memory"); } } while (0)
#define SA_WRITE(stile, sg) do { LAS unsigned char* sl_ = lds + ((stile) % NSL) * SLOT; \
        asm volatile("s_waitcnt vmcnt(16)" : "+v"(st[sg][0]), "+v"(st[sg][1]), "+v"(st[sg][2]), "+v"(st[sg][3]), "+v"(st[sg][4]), "+v"(st[sg][5]), "+v"(st[sg][6]), "+v"(st[sg][7]) :: "memory"); \
        _Pragma("unroll") for (int i_ = 0; i_ < 4; ++i_) { \
            *(LAS unsigned long long*)(sl_ + lko[i_]) = (unsigned long long)pg8::cvt_pk_bf16(st[sg][i_][0], st[sg][i_][1]) | ((unsigned long long)pg8::cvt_pk_bf16(st[sg][i_][2], st[sg][i_][3]) << 32); \
            *(LAS unsigned long long*)(sl_ + lvo[i_]) = (unsigned long long)pg8::cvt_pk_bf16(st[sg][4 + i_][0], st[sg][4 + i_][1]) | ((unsigned long long)pg8::cvt_pk_bf16(st[sg][4 + i_][2], st[sg][4 + i_][3]) << 32); } } while (0)
#pragma unroll
    for (int k = 0; k < PD; ++k) SA_LOAD(k, k);
    SA_WRITE(0, 0); SA_LOAD(PD, 0);
    asm volatile("s_waitcnt lgkmcnt(0)" ::: "memory"); __builtin_amdgcn_s_barrier(); asm volatile("" ::: "memory");
    float mrun = -1e30f, lrun = 0.f; f32x16_t o0, o1;
#pragma unroll
    for (int r = 0; r < 16; ++r) { o0[r] = 0.f; o1[r] = 0.f; }
    const int koffs = (32 * kh + r32) * KPITCH + (64 * t + 8 * hi) * 2;
    const int voffs = VOFF + (32 * kh + 4 * hi + ((lane & 15) >> 2)) * VPITCH + (64 * vh2 + 16 * ((lane >> 4) & 1) + 4 * (lane & 3)) * 2;
    for (int t0 = 0; t0 < (NST + PD - 1) / PD * PD; t0 += PD) {
#pragma unroll
      for (int u = 0; u < PD; ++u) { const int stile = t0 + u;
        SA_WRITE(stile + 1, (u + 1) % PD); SA_LOAD(stile + 1 + PD, (u + 1) % PD);
        if (stile < NST - kh) {
        const LAS unsigned char* slot = lds + (stile % NSL) * SLOT;
        f32x16_t s_;
#pragma unroll
        for (int r = 0; r < 16; ++r) s_[r] = 0.f;
#pragma unroll
        for (int ks = 0; ks < 4; ++ks) s_ = __builtin_amdgcn_mfma_f32_32x32x16_bf16(*(const LAS bf16x8*)(slot + koffs + 32 * ks), qf[ks], s_, 0, 0, 0);
        bf16x8 vf[2][2];
#pragma unroll
        for (int s2 = 0; s2 < 2; ++s2)
#pragma unroll
            for (int bk = 0; bk < 2; ++bk) vf[s2][bk] = tr16(slot + voffs + (16 * s2) * VPITCH + (32 * bk) * 2, 8 * VPITCH);
        float mx = s_[0];
#pragma unroll
        for (int r = 1; r < 16; ++r) mx = fmaxf(mx, s_[r]);
        mx = fmaxf(mx, __shfl_xor(mx, 32));
        const float mnew = fmaxf(mrun, mx), alpha = __builtin_amdgcn_exp2f(mrun - mnew); mrun = mnew;
        float rs = 0.f;
#pragma unroll
        for (int r = 0; r < 16; ++r) { s_[r] = __builtin_amdgcn_exp2f(s_[r] - mnew); rs += s_[r]; }
        lrun = lrun * alpha + rs;
#pragma unroll
        for (int r = 0; r < 16; ++r) { o0[r] *= alpha; o1[r] *= alpha; }
#pragma unroll
        for (int s2 = 0; s2 < 2; ++s2) {
            const bf16x8 pf = cvt8((f32x4){s_[8 * s2 + 0], s_[8 * s2 + 1], s_[8 * s2 + 2], s_[8 * s2 + 3]}, (f32x4){s_[8 * s2 + 4], s_[8 * s2 + 5], s_[8 * s2 + 6], s_[8 * s2 + 7]});
            o0 = __builtin_amdgcn_mfma_f32_32x32x16_bf16(vf[s2][0], pf, o0, 0, 0, 0);
            o1 = __builtin_amdgcn_mfma_f32_32x32x16_bf16(vf[s2][1], pf, o1, 0, 0, 0); }
        }
        asm volatile("s_waitcnt lgkmcnt(0)" ::: "memory"); __builtin_amdgcn_s_barrier(); asm volatile("" ::: "memory");
      }
    }
#undef SA_LOAD
#undef SA_WRITE
    asm volatile("s_waitcnt vmcnt(0)" ::: "memory");
    lrun += __shfl_xor(lrun, 32);
    LAS float* mg = (LAS float*)(lds + (wave & ~2) * 8704);
    if (kh == 1) {
#pragma unroll
        for (int r = 0; r < 16; ++r) { mg[r * 64 + lane] = o0[r]; mg[(16 + r) * 64 + lane] = o1[r]; }
        mg[32 * 64 + lane] = mrun; mg[33 * 64 + lane] = lrun; }
    asm volatile("s_waitcnt lgkmcnt(0)" ::: "memory"); __builtin_amdgcn_s_barrier(); asm volatile("" ::: "memory");
    if (kh == 0) {
        const float m1 = mg[32 * 64 + lane], l1 = mg[33 * 64 + lane];
        const float mm = fmaxf(mrun, m1), a0 = __builtin_amdgcn_exp2f(mrun - mm), a1 = __builtin_amdgcn_exp2f(m1 - mm);
        const float inv = 1.0f / (lrun * a0 + l1 * a1);
#pragma unroll
        for (int r = 0; r < 16; ++r) { o0[r] = (o0[r] * a0 + mg[r * 64 + lane] * a1) * inv; o1[r] = (o1[r] * a0 + mg[(16 + r) * 64 + lane] * a1) * inv; }
        bf16* Ot = (t ? O1_ : O0_) + (size_t)(MP + 32 * b + r32) * 1024 + h * 128 + 64 * vh2 + 4 * hi;
#pragma unroll
        for (int g = 0; g < 4; ++g) {
            *(GAS unsigned long long*)(Ot + 8 * g) = (unsigned long long)pk2(o0[4 * g], o0[4 * g + 1]) | ((unsigned long long)pk2(o0[4 * g + 2], o0[4 * g + 3]) << 32);
            *(GAS unsigned long long*)(Ot + 32 + 8 * g) = (unsigned long long)pk2(o1[4 * g], o1[4 * g + 1]) | ((unsigned long long)pk2(o1[4 * g + 2], o1[4 * g + 3]) << 32); } }
    asm volatile("s_waitcnt lgkmcnt(0)" ::: "memory"); __builtin_amdgcn_s_barrier(); asm volatile("" ::: "memory");
}

#ifndef PROBE_MASK
#define PROBE_MASK 0u
#endif
#ifndef PROBE_REPS
#define PROBE_REPS 2
#endif
#ifndef MK_N_LAUNCHES
#define MK_N_LAUNCHES 1
#endif
constexpr int NPHASE = 25;
constexpr int N_LAUNCHES = MK_N_LAUNCHES;
static_assert(N_LAUNCHES == 1 || N_LAUNCHES == NPHASE, "MK_N_LAUNCHES is 1 or 25");
struct Args { const float* in[23]; float* out; unsigned char* ws; int ph_lo, ph_hi; };
static_assert(sizeof(Args) == 25 * 8 + 8, "Args has no holes");

template <class Epi>
__device__ __forceinline__ void run_gemm(LAS unsigned char* lds, const bf16* A, const bf16* Bt, int N, int K, int G, int c, const Epi& E) {
    pg8::Gemm g{A, Bt, M, N, K}; pg8::StaticOrder S; S.init(M, N, K, G, c);
    pg8::gemm_phase<Epi, pg8::StaticOrder, true, true>(lds + RING_OFF, g, S, E);
}
template <class Epi>
__device__ __forceinline__ void run_gemm_q(LAS unsigned char* lds, const bf16* A, const bf16* Bt, int G, int c, const Epi& E) {
    pg8::Gemm g{A, Bt, M, 1024, 1024}; pg8::QSplit S; S.init(G, c);
    pg8::gemm_phase<Epi, pg8::QSplit, true, true>(lds + RING_OFF, g, S, E);
}
template <class Epi>
__device__ __forceinline__ void run_gemm_sk(LAS unsigned char* lds, const bf16* A, const bf16* Bt, int N, int K, int G, int v, const Epi& E) {
    pg8::Gemm g{A, Bt, M, N, K}; pg8::StreamK S; S.init(M, N, K, G, v);
    pg8::gemm_phase<Epi, pg8::StreamK, true, true>(lds + RING_OFF, g, S, E);
}

__global__ void __launch_bounds__(NWAVES * 64, 2) yoco_fwd(Args args) {
    extern __shared__ __attribute__((aligned(16))) unsigned char lds_raw[];
    LAS unsigned char* lds = (LAS unsigned char*)lds_raw;
    volatile LAS unsigned* MISC = (volatile LAS unsigned*)(lds + MISC_OFF);
    const int tid = threadIdx.x, lane = tid & 63, wave = __builtin_amdgcn_readfirstlane(tid >> 6);
    const int G = gridDim.x; const int bx = blockIdx.x; const int vcu = (G % 8 == 0) ? (bx % 8) * (G / 8) + bx / 8 : bx;
    const int gw = vcu * NWAVES + wave, NGW = G * NWAVES;
    unsigned char* ws = args.ws; float* out = args.out;
    gu32* ctl = (gu32*)(ws + WS_CTL);
    for (int u = tid; u < (LDS_BYTES - LDSCTL_OFF) / 4; u += NWAVES * 64) ((LAS unsigned*)(lds + LDSCTL_OFF))[u] = 0u;
    __syncthreads();
    XcdBarrier bar; bar.bar = (unsigned*)(ctl + CW_BAR); bar.x = 0; bar.st = nullptr;
    if (N_LAUNCHES == 1) bar = xcd_barrier_post((unsigned*)(ctl + CW_BAR), MISC + 8);
#define GRID_BAR() do { if (N_LAUNCHES == 1) xcd_barrier(bar); } while (0)
    const int lo = args.ph_lo, hi = args.ph_hi;
#define IN(k) (lo <= (k) && (k) < hi)
#define SEAM(k) do { if (IN((k) + 1)) GRID_BAR(); } while (0)
#define SEAMP(k, a, b, ...) do { const bool inl_ = (N_LAUNCHES == 1) && IN((k) + 1); unsigned t_ = 0u; if (inl_) t_ = xcd_barrier_arrive(bar); if (N_LAUNCHES == 1) { __VA_ARGS__; } \
        { const P0Args A_ = P0ARGS; p0_convert<3>(A_, lds, gw, NGW, lane, wave, (a), (b)); } if (inl_) xcd_barrier_wait(bar, t_); } while (0)
#define SEAMQ(k, ...) do { const bool inl_ = (N_LAUNCHES == 1) && IN((k) + 1); unsigned t_ = 0u; if (inl_) t_ = xcd_barrier_arrive(bar); if (N_LAUNCHES == 1) { __VA_ARGS__; } if (inl_) xcd_barrier_wait(bar, t_); } while (0)
#define SEAMF(k, a, b) do { const bool inl_ = (N_LAUNCHES == 1) && IN((k) + 1); unsigned t_ = 0u; if (inl_) t_ = xcd_barrier_arrive(bar); \
        { const P0Args A_ = P0ARGS; p0_convert<3>(A_, lds, gw, NGW, lane, wave, (a), (b)); } if (inl_) xcd_barrier_wait(bar, t_); } while (0)

#define x_p (args.in[0])
#define x_s (args.in[1])
#define state_ret (args.in[2])
#define cache_k (args.in[3])
#define cache_v (args.in[4])
#define g_norm (args.in[9])
#define g_gn_a (args.in[13])
#define g_kv (args.in[17])
#define lam_b (args.in[20])
#define g_sub (args.in[21])
#define MOD ((const float*)(ws + WS_MOD))
#define ropeA ((const float*)(ws + WS_ROPEA))
#define ropeB ((const float*)(ws + WS_ROPEB))
#define H ((bf16*)(ws + WS_H))
#define HKV ((bf16*)(ws + WS_HKV))
#define Y ((bf16*)(ws + WS_Y))
#define U ((bf16*)(ws + WS_U))
#define QR ((bf16*)(ws + WS_QR))
#define KR ((bf16*)(ws + WS_KR))
#define VR ((bf16*)(ws + WS_VR))
#define GR ((bf16*)(ws + WS_GR))
#define OR_ ((bf16*)(ws + WS_OR))
#define AR ((bf16*)(ws + WS_AR))
#define KB ((bf16*)(ws + WS_KB))
#define VB ((bf16*)(ws + WS_VB))
#define QB ((bf16*)(ws + WS_QB))
#define O0 ((bf16*)(ws + WS_O0))
#define O1 ((bf16*)(ws + WS_O1))
#define AB ((bf16*)(ws + WS_AB))
#define XB ((bf16*)(ws + WS_XB))
#define X (out + OUT_Y)
    const RowOut none{nullptr, 0, 0, nullptr};
#define WFI(l, i) ((const bf16*)(ws + WS_WFI + (size_t)((l) * 2 + (i)) * SZ_WFI))
#define WFO(l, i) ((const bf16*)(ws + WS_WFO + (size_t)((l) * 2 + (i)) * SZ_WFO))
#define GN(l, j) (g_norm + ((l) * 6 + (j)) * 1024)
#define MC(l, j) (((l) * 9 + (j)) * 1024)

#define P0ARGS P0Args{args.in[5], args.in[6], args.in[7], args.in[8], args.in[10], args.in[11], args.in[12], args.in[14], args.in[15], args.in[16], args.in[18], args.in[19], args.in[22], ws}
    if (IN(0)) { const P0Args A = P0ARGS; p0_mod(A, lds, vcu, G, tid, lane, wave);
        const bool split = (N_LAUNCHES == 1) && IN(1); unsigned tgt = 0u;
        if (split) tgt = xcd_barrier_arrive(bar);
        p0_rest(A, lds, vcu, G, tid, lane, wave);
        if (split) xcd_barrier_wait(bar, tgt); }
    const int pre_r0 = 8 * (gw < MP / 8 ? gw : 0);
    if (IN(1)) { RowPre pre; rowpass<false, 1, false, 0>(x_p, x_s, nullptr, nullptr, nullptr, 0, 0.f, nullptr, RowOut{GN(0, 0), MC(0, 0), MC(0, 1), H}, none, MOD, gw, NGW, lane, 0, G, pre); SEAMF(1, 0, 1408); }
    if (IN(2)) { run_gemm(lds, H, WFI(0, 0), 2 * DFF, 1024, G, bx, pg8::EpiSwiglu{U, DFF}); SEAMF(2, 1408, 2944); }
    { RowPre pre;
    if (IN(3)) { run_gemm_sk(lds, U, WFO(0, 0), 1024, DFF, G, vcu, pg8::EpiBf16{Y, 1024, SZ_A1 / 2}); SEAMP(3, 2944, 4480, rowpre<true, 1>(pre, GN(0, 1), MC(0, 2), 0.5f, RowOut{GN(0, 2), MC(0, 3), MC(0, 4), H}, none, MOD, pre_r0, lane)); }
    if (IN(4)) { rowpass<true, 1, false, 1, (N_LAUNCHES == 1)>(x_p, x_s, XB, Y, GN(0, 1), MC(0, 2), 0.5f, nullptr, RowOut{GN(0, 2), MC(0, 3), MC(0, 4), H}, none, MOD, gw, NGW, lane, DFF, G, pre); SEAMF(4, 4480, 5064); } }
    if (IN(5)) { run_gemm(lds, H, (const bf16*)(ws + WS_WIA), AIN, 1024, G, bx, pg8::EpiRetIn{QR, KR, VR, GR, ropeA});
        { const int nu = 68 * 24, full = nu / G, rem = nu - full * G;
          const int f0 = rem ? rem : 0, nf = G - f0; if (bx >= f0) { const P0Args A = P0ARGS; p0_convert<1>(A, lds, (bx - f0) * NWAVES + wave, nf * NWAVES, lane, wave); } }
        SEAMF(5, 5064, 5648); }
    if (IN(6)) {
        for (int id = vcu; id < 256; id += G) { const int b = id >> 5, h = (id >> 2) & 7, vs = id & 3;
            ret_unit<64, 4, true>(lds, QR, KR, VR, OR_, nullptr, out + OUT_SRP + (size_t)(b * 8 + h) * 128 * 256, 2048 * b, 32, h, 64 * vs, tid, lane, wave); }
        for (int id = vcu; id < 256; id += G) { const int b = id >> 3, h = id & 7;
            ret_unit<32, 16, false>(lds, QR, KR, VR, OR_, state_ret + (size_t)(b * 8 + h) * 128 * 256, out + OUT_SRS + (size_t)(b * 8 + h) * 128 * 256, MP + 32 * b, 1, h, 0, tid, lane, wave); }
        SEAMF(6, 5648, 6232); }
    if (IN(7)) { gatenorm_pass(OR_, GR, g_gn_a, AR, gw, NGW, lane); SEAMF(7, 6232, 6816); }
    { RowPre pre;
    if (IN(8)) { run_gemm_sk(lds, AR, (const bf16*)(ws + WS_WOA), 1024, 2048, G, vcu, pg8::EpiBf16{Y, 1024, SZ_A1 / 2}); SEAMP(8, 6816, 7400, rowpre<true, 1>(pre, GN(0, 3), MC(0, 5), 1.0f, RowOut{GN(0, 4), MC(0, 6), MC(0, 7), H}, none, MOD, pre_r0, lane)); }
    if (IN(9)) { rowpass<true, 1, true, 1, (N_LAUNCHES == 1)>(nullptr, nullptr, XB, Y, GN(0, 3), MC(0, 5), 1.0f, nullptr, RowOut{GN(0, 4), MC(0, 6), MC(0, 7), H}, none, MOD, gw, NGW, lane, 2048, G, pre); SEAMF(9, 7400, 7984); } }
    if (IN(10)) { run_gemm(lds, H, WFI(0, 1), 2 * DFF, 1024, G, bx, pg8::EpiSwiglu{U, DFF}); SEAMF(10, 7984, 8568); }
    { RowPre pre;
    if (IN(11)) { run_gemm_sk(lds, U, WFO(0, 1), 1024, DFF, G, vcu, pg8::EpiBf16{Y, 1024, SZ_A1 / 2}); SEAMP(11, 8568, 9152, rowpre<true, 2>(pre, GN(0, 5), MC(0, 8), 0.5f, RowOut{GN(1, 0), MC(1, 0), MC(1, 1), H}, RowOut{g_kv, 18432, 18432 + 1024, HKV}, MOD, pre_r0, lane)); }
    if (IN(12)) { rowpass<true, 2, true, 1, (N_LAUNCHES == 1)>(nullptr, nullptr, XB, Y, GN(0, 5), MC(0, 8), 0.5f, nullptr, RowOut{GN(1, 0), MC(1, 0), MC(1, 1), H}, RowOut{g_kv, 18432, 18432 + 1024, HKV}, MOD, gw, NGW, lane, DFF, G, pre); SEAMF(12, 9152, 9728); } }
    if (IN(13)) { run_gemm(lds, H, WFI(1, 0), 2 * DFF, 1024, G, bx, pg8::EpiSwiglu{U, DFF});
        const bool inl_ = (N_LAUNCHES == 1) && IN(14); unsigned t_ = 0u; if (inl_) t_ = xcd_barrier_arrive(bar);
        run_gemm(lds, HKV, (const bf16*)(ws + WS_WKV), 2048, 1024, G, (bx + G - (1496 % G)) % G, pg8::EpiKV{KB, VB, out + OUT_KP, out + OUT_KS, out + OUT_VP, out + OUT_VS, ropeB});
        { const P0Args A_ = P0ARGS; p0_convert<3>(A_, lds, gw, NGW, lane, wave, 9728, 9984); }
        if (inl_) xcd_barrier_wait(bar, t_); }
    { RowPre pre;
    if (IN(14)) { run_gemm_sk(lds, U, WFO(1, 0), 1024, DFF, G, vcu, pg8::EpiBf16{Y, 1024, SZ_A1 / 2}); SEAMP(14, 9984, 10240, rowpre<true, 1>(pre, GN(1, 1), MC(1, 2), 0.5f, RowOut{GN(1, 2), MC(1, 3), MC(1, 4), H}, none, MOD, pre_r0, lane)); }
    if (IN(15)) { rowpass<true, 1, true, 1, (N_LAUNCHES == 1)>(nullptr, nullptr, XB, Y, GN(1, 1), MC(1, 2), 0.5f, nullptr, RowOut{GN(1, 2), MC(1, 3), MC(1, 4), H}, none, MOD, gw, NGW, lane, DFF, G, pre); SEAM(15); } }
    if (IN(16)) { run_gemm_q(lds, H, (const bf16*)(ws + WS_WQB), G, bx, pg8::EpiQ{QB, Y - (size_t)MP * 1024, ropeB, QSCALE});
        { const int f0 = G > 64 ? 64 : 0, nf = G - f0;
          if (bx >= f0) { const P0Args A = P0ARGS; p0_convert<2>(A, lds, (bx - f0) * NWAVES + wave, nf * NWAVES, lane, wave); } }
        SEAM(16); }
    const bool sfirst = IN(17) && IN(18) && ((vcu >> 3) & 1);
    if (IN(18) && sfirst) { for (int id = vcu; id < 256; id += G) sattn_unit(lds, id >> 3, id & 7, QB, Y, cache_k, cache_v, out + OUT_KS, out + OUT_VS, O0, O1, tid, lane, wave); }
    if (IN(17)) {
        const attn_body::AttnTensors AT{(const attn_body::bf16*)QB, (const attn_body::bf16*)KB, (const attn_body::bf16*)VB, (attn_body::bf16*)O0, (attn_body::bf16*)O1};
        const attn_body::StaticOrder S(G, vcu);
        attn_body::attn_phase<attn_body::StaticOrder>((char*)lds_raw + RING_OFF, AT, S); }
    if (IN(18)) {
        if (!sfirst) { for (int id = vcu; id < 256; id += G) sattn_unit(lds, id >> 3, id & 7, QB, Y, cache_k, cache_v, out + OUT_KS, out + OUT_VS, O0, O1, tid, lane, wave); }
        SEAM(18); }
    if (IN(19)) { diffnorm_pass(O0, O1, lam_b, g_sub, AB, gw, NGW, lane); SEAM(19); }
    { RowPre pre;
    if (IN(20)) { run_gemm_sk(lds, AB, (const bf16*)(ws + WS_WOB), 1024, 1024, G, vcu, pg8::EpiBf16{Y, 1024, SZ_A1 / 2}); SEAMQ(20, rowpre<true, 1>(pre, GN(1, 3), MC(1, 5), 1.0f, RowOut{GN(1, 4), MC(1, 6), MC(1, 7), H}, none, MOD, pre_r0, lane)); }
    if (IN(21)) { rowpass<true, 1, true, 1, (N_LAUNCHES == 1)>(nullptr, nullptr, XB, Y, GN(1, 3), MC(1, 5), 1.0f, nullptr, RowOut{GN(1, 4), MC(1, 6), MC(1, 7), H}, none, MOD, gw, NGW, lane, 1024, G, pre); SEAM(21); } }
    if (IN(22)) { run_gemm(lds, H, WFI(1, 1), 2 * DFF, 1024, G, bx, pg8::EpiSwiglu{U, DFF}); SEAM(22); }
    { RowPre pre;
    if (IN(23)) { run_gemm_sk(lds, U, WFO(1, 1), 1024, DFF, G, vcu, pg8::EpiBf16{Y, 1024, SZ_A1 / 2}); SEAMQ(23, rowpre<true, 0>(pre, GN(1, 5), MC(1, 8), 0.5f, none, none, MOD, pre_r0, lane)); }
    if (IN(24)) { rowpass<true, 0, true, 2, (N_LAUNCHES == 1)>(nullptr, nullptr, XB, Y, GN(1, 5), MC(1, 8), 0.5f, out + OUT_Y, none, none, MOD, gw, NGW, lane, DFF, G, pre); } }
#undef IN
#undef SEAM
#undef SEAMF
#undef SEAMP
#undef SEAMQ
#undef GRID_BAR
}

extern "C" void kernel_launch(void* const* d_in, const int* in_sizes, int n_in, void* d_out, int out_size, void* d_ws, size_t ws_size, hipStream_t stream) {
    static int grid = 0;
    if (grid == 0) {
        if (n_in != 23 || in_sizes[0] != MP * D || (size_t)out_size != OUT_END || ws_size < WS_END) { fprintf(stderr, "kernel_launch: unexpected shapes (n_in %d, in0 %d, out %d, ws %zu); nothing launched\n", n_in, n_in > 0 ? in_sizes[0] : -1, out_size, ws_size); grid = -1; return; }
        int dev = 0, cus = 0, per_cu = 0;
        if (hipGetDevice(&dev) != hipSuccess || hipDeviceGetAttribute(&cus, hipDeviceAttributeMultiprocessorCount, dev) != hipSuccess) { fprintf(stderr, "kernel_launch: device query failed\n"); grid = -1; return; }
        if (hipFuncSetAttribute((const void*)yoco_fwd, hipFuncAttributeMaxDynamicSharedMemorySize, LDS_BYTES) != hipSuccess) { fprintf(stderr, "kernel_launch: hipFuncSetAttribute failed\n"); grid = -1; return; }
        if (hipOccupancyMaxActiveBlocksPerMultiprocessor(&per_cu, (const void*)yoco_fwd, NWAVES * 64, LDS_BYTES) != hipSuccess || per_cu < 1)
            fprintf(stderr, "kernel_launch: note: occupancy query reports %d workgroups per CU\n", per_cu);
        (void)hipGetLastError();
        grid = cus;
    }
    if (grid < 0) return;
    if (hipMemsetAsync((char*)d_ws + WS_CTL, 0, ZERO_BYTES, stream) != hipSuccess) { fprintf(stderr, "kernel_launch: hipMemsetAsync failed\n"); return; }
    Args a{};
    for (int i = 0; i < 23; ++i) a.in[i] = (const float*)d_in[i];
    a.out = (float*)d_out; a.ws = (unsigned char*)d_ws;
    for (int li = 0; li < N_LAUNCHES; ++li) {
        a.ph_lo = (N_LAUNCHES == 1) ? 0 : li; a.ph_hi = (N_LAUNCHES == 1) ? NPHASE : li + 1;
        for (int rp = 0; rp < 1 + ((N_LAUNCHES != 1 && ((PROBE_MASK >> li) & 1u)) ? PROBE_REPS : 0); ++rp)
        hipLaunchKernelGGL(yoco_fwd, dim3(grid), dim3(NWAVES * 64), LDS_BYTES, stream, a);
        const hipError_t le = hipPeekAtLastError();
        if (le != hipSuccess) { fprintf(stderr, "kernel_launch: launch %d failed: %s\n", li, hipGetErrorName(le)); break; }
    }
}
```

```cpp
#include <hip/hip_runtime.h>
#include <cstdio>
#include <cstdint>
namespace pg8 {
#define PG8_LAS __attribute__((address_space(3)))
typedef unsigned short bf16_t;
typedef short bf16x8 __attribute__((ext_vector_type(8)));
typedef float f32x4 __attribute__((ext_vector_type(4)));
typedef unsigned u32x4 __attribute__((ext_vector_type(4)));
constexpr int BM = 256, BK = 64, HALF = 128, HTB = HALF * BK * 2  , STAGE_BYTES = 8 * HTB, NXCD = 8, WGM = 8;

__host__ __device__ __forceinline__ int lds_byte(int r, int c) { const int st = (r >> 4) * 2 + (c >> 5), rr = r & 15, cc = c & 31, ob = rr * 64 + cc * 2; return st * 1024 + (ob ^ (((ob >> 9) & 1) << 5)); }
__host__ __device__ __forceinline__ void stage_rc(int b, int& R, int& C) { const int st = b / 1024, sb = b % 1024, swz = sb ^ (((sb >> 9) & 1) << 5); R = (st >> 1) * 16 + swz / 64; C = (st & 1) * 32 + (swz % 64) / 2; }
__host__ __device__ __forceinline__ int perm32(int rho) { const int n = rho >> 4, i = rho & 15; return 8 * (i >> 2) + 4 * n + (i & 3); }

struct Unit { int pm, pn, k0, nt, slot; };
struct Gemm { const bf16_t* A; const bf16_t* Bt; int M, N, K; };

struct StaticOrder {
    int nM, nN, nwg, G, c, ntK;
    __host__ __device__ void init(int M, int N, int K, int G_, int c_) { nM = M / BM; nN = N / BM; nwg = nM * nN; G = G_; c = c_; ntK = K / BK; }
    __host__ __device__ bool next(int i, Unit& u) const {
        const long L = (long)i * G + c; if (L >= nwg) return false;
        int wgid = (int)L; { const int q = nwg / NXCD, r = nwg % NXCD, xcd = wgid % NXCD, off = wgid / NXCD; wgid = (xcd < r ? xcd * (q + 1) : r * (q + 1) + (xcd - r) * q) + off; }
        const int nig = WGM * nN, gid = wgid / nig, fm = gid * WGM, gsz = (nM - fm) < WGM ? (nM - fm) : WGM;
        u.pm = fm + ((wgid % nig) % gsz); u.pn = (wgid % nig) / gsz; u.k0 = 0; u.nt = ntK; u.slot = 0; return true;
    }
    __device__ __forceinline__ void a_ready(const Unit&) const {}
    __device__ __forceinline__ void done(const Unit&) const {}
};


struct StreamK {
    int nN, nkp, W, G, v, b0, b1;
    __host__ __device__ void init(int M, int N, int K, int G_, int v_) { nN = N / BM; nkp = K / 128; const int nu = (M / BM) * nN; W = nu * nkp; G = G_ < nu ? G_ : nu; v = v_;
        b0 = v < G ? (int)(((long)v * W) / G) : W; b1 = v < G ? (int)(((long)(v + 1) * W) / G) : W; }
    __host__ __device__ int cu_of(int x) const { return (int)((((long)x + 1) * G - 1) / W); }
    __host__ __device__ int pieces(int un) const { return cu_of(un * nkp + nkp - 1) - cu_of(un * nkp) + 1; }
    __host__ __device__ bool next(int i, Unit& u) const {
        const int un = b0 / nkp + i, ks = un * nkp; const int a = b0 > ks ? b0 : ks, e = b1 < ks + nkp ? b1 : ks + nkp;
        if (a >= e) return false;
        u.pm = un / nN; u.pn = un % nN; u.k0 = 2 * (a - ks); u.nt = 2 * (e - a); u.slot = v - cu_of(ks); return true;
    }
    __device__ __forceinline__ void a_ready(const Unit&) const {}
    __device__ __forceinline__ void done(const Unit&) const {}
};

struct QSplit {
    StaticOrder P; int G, c, R;
    __host__ __device__ void init(int G_, int c_) { P.init(16384, 1024, 1024, G_, c_); G = G_; c = c_; R = (P.nwg + G_ - 1) / G_; }
    __host__ __device__ bool next(int i, Unit& u) const {
        if (i < R) { if (P.next(i, u)) return true; i = R; }
        const long j = (long)(i - R) * G + c; if (j >= 64) return false;
        const int s = (int)j >> 2; u.pm = 64 + (s >> 2); u.pn = s & 3; u.k0 = 4 * ((int)j & 3); u.nt = 4; u.slot = (int)j & 3; return true;
    }
    __device__ __forceinline__ void a_ready(const Unit&) const {}
    __device__ __forceinline__ void done(const Unit&) const {}
};

__device__ __forceinline__ unsigned cvt_pk_bf16(float lo, float hi) { unsigned r; asm volatile("v_cvt_pk_bf16_f32 %0, %1, %2" : "=v"(r) : "v"(lo), "v"(hi)); return r; }
__device__ __forceinline__ void stntf(f32x4* p, const f32x4 v) { __builtin_nontemporal_store(v, p); }
__device__ __forceinline__ u32x4 pack8(const f32x4 a, const f32x4 b) { u32x4 w; w.x = cvt_pk_bf16(a[0], a[1]); w.y = cvt_pk_bf16(a[2], a[3]); w.z = cvt_pk_bf16(b[0], b[1]); w.w = cvt_pk_bf16(b[2], b[3]); return w; }
__device__ __forceinline__ float silu_f(float a) { return a * __builtin_amdgcn_rcpf(1.0f + __builtin_amdgcn_exp2f(-1.4426950408889634f * a)); }
__device__ __forceinline__ float swi_f(float a, float b) { return (a * b) * __builtin_amdgcn_rcpf(1.0f + __builtin_amdgcn_exp2f(-a)); }
__device__ __forceinline__ f32x4 swi4(const f32x4 a, const f32x4 b) { f32x4 r; r[0] = swi_f(a[0], b[0]); r[1] = swi_f(a[1], b[1]); r[2] = swi_f(a[2], b[2]); r[3] = swi_f(a[3], b[3]); return r; }
__device__ __forceinline__ f32x4 silu4(const f32x4 a) { f32x4 r; r[0] = silu_f(a[0]); r[1] = silu_f(a[1]); r[2] = silu_f(a[2]); r[3] = silu_f(a[3]); return r; }
__device__ __forceinline__ int pidx_of(int r) { return r < 16384 ? (r & 2047) : 2048 + ((r - 16384) & 31); }

struct EpiBf16 {
    static constexpr bool PERM = true, AFTER_DRAIN = false;
    bf16_t* O; int ldc; size_t slot_stride;
    __device__ __forceinline__ void operator()(const f32x4 (&acc)[2][2][4][2], const Unit& u, int wr, int wc, int fr, int fq) const {
        const int row0 = u.pm * BM + wr * 64 + fr, col0 = u.pn * BM + wc * 32 + 8 * fq; bf16_t* Ob = O + (size_t)u.slot * slot_stride;
#pragma unroll
        for (int ai = 0; ai < 2; ++ai)
#pragma unroll
            for (int m = 0; m < 4; ++m) { bf16_t* rowp = Ob + (size_t)(row0 + ai * HALF + m * 16) * ldc + col0;
#pragma unroll
                for (int bj = 0; bj < 2; ++bj) *(u32x4*)(rowp + bj * HALF) = pack8(acc[ai][bj][m][0], acc[ai][bj][m][1]); }
    }
};
struct EpiSwiglu {
    static constexpr bool PERM = true, AFTER_DRAIN = false;
    bf16_t* U; int ldu;
    __device__ __forceinline__ void operator()(const f32x4 (&acc)[2][2][4][2], const Unit& u, int wr, int wc, int fr, int fq) const {
        const int row0 = u.pm * BM + wr * 64 + fr, col0 = u.pn * HALF + wc * 32 + 8 * fq;
#pragma unroll
        for (int ai = 0; ai < 2; ++ai)
#pragma unroll
            for (int m = 0; m < 4; ++m) { bf16_t* rowp = U + (size_t)(row0 + ai * HALF + m * 16) * ldu + col0;
                const f32x4 v0 = swi4(acc[ai][0][m][0], acc[ai][1][m][0]), v1 = swi4(acc[ai][0][m][1], acc[ai][1][m][1]);
                *(u32x4*)rowp = pack8(v0, v1); }
    }
};
__device__ __forceinline__ void rot8(const f32x4* rp, const f32x4 x1a, const f32x4 x1b, const f32x4 x2a, const f32x4 x2b, float sc, f32x4& o1a, f32x4& o1b, f32x4& o2a, f32x4& o2b) {
    const f32x4 c0 = rp[0], c1 = rp[1], c2 = rp[2], c3 = rp[3];
    o1a[0] = (x1a[0] * c0[0] - x2a[0] * c0[1]) * sc; o2a[0] = (x2a[0] * c0[0] + x1a[0] * c0[1]) * sc;
    o1a[1] = (x1a[1] * c0[2] - x2a[1] * c0[3]) * sc; o2a[1] = (x2a[1] * c0[2] + x1a[1] * c0[3]) * sc;
    o1a[2] = (x1a[2] * c1[0] - x2a[2] * c1[1]) * sc; o2a[2] = (x2a[2] * c1[0] + x1a[2] * c1[1]) * sc;
    o1a[3] = (x1a[3] * c1[2] - x2a[3] * c1[3]) * sc; o2a[3] = (x2a[3] * c1[2] + x1a[3] * c1[3]) * sc;
    o1b[0] = (x1b[0] * c2[0] - x2b[0] * c2[1]) * sc; o2b[0] = (x2b[0] * c2[0] + x1b[0] * c2[1]) * sc;
    o1b[1] = (x1b[1] * c2[2] - x2b[1] * c2[3]) * sc; o2b[1] = (x2b[1] * c2[2] + x1b[1] * c2[3]) * sc;
    o1b[2] = (x1b[2] * c3[0] - x2b[2] * c3[1]) * sc; o2b[2] = (x2b[2] * c3[0] + x1b[2] * c3[1]) * sc;
    o1b[3] = (x1b[3] * c3[2] - x2b[3] * c3[3]) * sc; o2b[3] = (x2b[3] * c3[2] + x1b[3] * c3[3]) * sc;
}
struct EpiRetIn {
    static constexpr bool PERM = true, AFTER_DRAIN = false;
    bf16_t *QR, *KR, *VR, *GR; const float* ropeA;
    __device__ __forceinline__ void operator()(const f32x4 (&acc)[2][2][4][2], const Unit& u, int wr, int wc, int fr, int fq) const {
        const int row0 = u.pm * BM + wr * 64 + fr;
        if (u.pn < 8) {
            bf16_t* dst = (u.pn < 4) ? QR : KR; const float sc = (u.pn < 4) ? 1.0f : 0.08838834764831845f;
            const int head = 2 * (u.pn & 3) + (wc >> 1), d0 = 32 * (wc & 1) + 8 * fq;
#pragma unroll
            for (int ai = 0; ai < 2; ++ai)
#pragma unroll
                for (int m = 0; m < 4; ++m) { const int row = row0 + ai * HALF + m * 16; const f32x4* rp = (const f32x4*)(ropeA + ((size_t)pidx_of(row) * 64 + d0) * 2);
                    f32x4 o1a, o1b, o2a, o2b; rot8(rp, acc[ai][0][m][0], acc[ai][0][m][1], acc[ai][1][m][0], acc[ai][1][m][1], sc, o1a, o1b, o2a, o2b);
                    bf16_t* rowp = dst + (size_t)row * 1024 + head * 128 + d0;
                    *(u32x4*)rowp = pack8(o1a, o1b); *(u32x4*)(rowp + 64) = pack8(o2a, o2b); }
        } else if (u.pn < 16) {
            const int col0 = (u.pn - 8) * BM + wc * 32 + 8 * fq;
#pragma unroll
            for (int ai = 0; ai < 2; ++ai)
#pragma unroll
                for (int m = 0; m < 4; ++m) { bf16_t* rowp = VR + (size_t)(row0 + ai * HALF + m * 16) * 2048 + col0;
#pragma unroll
                    for (int bj = 0; bj < 2; ++bj) *(u32x4*)(rowp + bj * HALF) = pack8(acc[ai][bj][m][0], acc[ai][bj][m][1]); }
        } else {
            const int col0 = (u.pn - 16) * BM + wc * 32 + 8 * fq;
#pragma unroll
            for (int ai = 0; ai < 2; ++ai)
#pragma unroll
                for (int m = 0; m < 4; ++m) { bf16_t* rowp = GR + (size_t)(row0 + ai * HALF + m * 16) * 2048 + col0;
#pragma unroll
                    for (int bj = 0; bj < 2; ++bj) *(u32x4*)(rowp + bj * HALF) = pack8(acc[ai][bj][m][0], acc[ai][bj][m][1]); }
        }
    }
};
struct EpiKV {
    static constexpr bool PERM = true, AFTER_DRAIN = false;
    bf16_t *KB, *VB; float *Kp, *Ks, *Vp, *Vs; const float* ropeB;
    __device__ __forceinline__ void operator()(const f32x4 (&acc)[2][2][4][2], const Unit& u, int wr, int wc, int fr, int fq) const {
        const int row0 = u.pm * BM + wr * 64 + fr; const bool samp = u.pm >= 64;
        if (u.pn < 4) {
            const int grp = 4 * u.pn + wc, d0 = 8 * fq; float* ob = samp ? Ks - (size_t)16384 * 1024 : Kp;
#pragma unroll
            for (int ai = 0; ai < 2; ++ai)
#pragma unroll
                for (int m = 0; m < 4; ++m) { const int row = row0 + ai * HALF + m * 16; const f32x4* rp = (const f32x4*)(ropeB + ((size_t)pidx_of(row) * 32 + d0) * 2);
                    f32x4 o1a, o1b, o2a, o2b; rot8(rp, acc[ai][0][m][0], acc[ai][0][m][1], acc[ai][1][m][0], acc[ai][1][m][1], 1.0f, o1a, o1b, o2a, o2b);
                    const size_t off = (size_t)row * 1024 + grp * 64 + d0;
                    stntf((f32x4*)(ob + off), o1a); stntf((f32x4*)(ob + off + 4), o1b); stntf((f32x4*)(ob + off + 32), o2a); stntf((f32x4*)(ob + off + 36), o2b);
                    *(u32x4*)(KB + off) = pack8(o1a, o1b); *(u32x4*)(KB + off + 32) = pack8(o2a, o2b); }
        } else {
            const int col0 = (u.pn - 4) * BM + wc * 32 + 8 * fq; float* ob = samp ? Vs - (size_t)16384 * 1024 : Vp;
#pragma unroll
            for (int ai = 0; ai < 2; ++ai)
#pragma unroll
                for (int m = 0; m < 4; ++m) { const size_t off = (size_t)(row0 + ai * HALF + m * 16) * 1024 + col0;
#pragma unroll
                    for (int bj = 0; bj < 2; ++bj) { stntf((f32x4*)(ob + off + bj * HALF), acc[ai][bj][m][0]); stntf((f32x4*)(ob + off + bj * HALF + 4), acc[ai][bj][m][1]);
                        *(u32x4*)(VB + off + bj * HALF) = pack8(acc[ai][bj][m][0], acc[ai][bj][m][1]); } }
        }
    }
};
struct EpiQ {
    static constexpr bool PERM = true, AFTER_DRAIN = false;
    bf16_t* QB; bf16_t* QB2; const float* ropeB; float qscale;
    __device__ __forceinline__ void operator()(const f32x4 (&acc)[2][2][4][2], const Unit& u, int wr, int wc, int fr, int fq) const {
        const int row0 = u.pm * BM + wr * 64 + fr; const int grp = 4 * u.pn + wc, d0 = 8 * fq; bf16_t* Qd = u.slot ? QB2 + (size_t)(u.slot - 1) * (1024 * 1024) : QB;
#pragma unroll
        for (int ai = 0; ai < 2; ++ai)
#pragma unroll
            for (int m = 0; m < 4; ++m) { const int row = row0 + ai * HALF + m * 16; const f32x4* rp = (const f32x4*)(ropeB + ((size_t)pidx_of(row) * 32 + d0) * 2);
                f32x4 o1a, o1b, o2a, o2b; rot8(rp, acc[ai][0][m][0], acc[ai][0][m][1], acc[ai][1][m][0], acc[ai][1][m][1], qscale, o1a, o1b, o2a, o2b);
                const size_t off = (size_t)row * 1024 + grp * 64 + d0;
                *(u32x4*)(Qd + off) = pack8(o1a, o1b); *(u32x4*)(Qd + off + 32) = pack8(o2a, o2b); }
    }
};
template <class Epi, class Sched, bool ALIGN_EPI = false, bool SP2 = false>
__device__ __forceinline__ void gemm_phase(PG8_LAS unsigned char* lds, const Gemm g, const Sched& S, const Epi& E) {
    const int tid = threadIdx.x, wid = __builtin_amdgcn_readfirstlane(tid >> 6), lane = tid & 63, wr = wid >> 2, wc = wid & 3, fr = lane & 15, fq = lane >> 4;
    const int K = g.K;
    unsigned voffA[2], voffB[2];
#pragma unroll
    for (int i = 0; i < 2; ++i) { int R, C; stage_rc(tid * 16 + i * 8192, R, C); const int Rb = Epi::PERM ? ((R & ~31) + perm32(R & 31)) : R;
        voffA[i] = (unsigned)(R * K + C) * 2u; voffB[i] = (unsigned)(Rb * K + C) * 2u; }
    const size_t kstep = (size_t)(BK * 2);
    const size_t hstep = (size_t)HALF * K * 2;
    const size_t tstep = 2 * hstep;
    const unsigned ldsw = (unsigned)wid * 1024u;
    const int aoff = lds_byte(wr * 64 + fr, fq * 8), boff = lds_byte(wc * 32 + fr, fq * 8);
#define PG8_SA(b, h) (((b) * 2 + (h)) * HTB)
#define PG8_SB(b, h) ((4 + (b) * 2 + (h)) * HTB)
#define PG8_STAGE(bufoff, gbase, voff) do { _Pragma("unroll") for (int _i = 0; _i < 2; ++_i) \
        __builtin_amdgcn_global_load_lds((const unsigned*)((const char*)(gbase) + (voff)[_i]), (PG8_LAS unsigned*)(lds + (bufoff) + ldsw + _i * 8192), 16, 0, 0); } while (0)
#define PG8_LDA(dst, b, h) do { _Pragma("unroll") for (int m = 0; m < 4; ++m) _Pragma("unroll") for (int k = 0; k < 2; ++k) dst[m][k] = *(const PG8_LAS bf16x8*)(lds + PG8_SA(b, h) + aoff + m * 2048 + k * 1024); } while (0)
#define PG8_LDB(dst, b, h) do { _Pragma("unroll") for (int n = 0; n < 2; ++n) _Pragma("unroll") for (int k = 0; k < 2; ++k) dst[n][k] = *(const PG8_LAS bf16x8*)(lds + PG8_SB(b, h) + boff + n * 2048 + k * 1024); } while (0)
#define PG8_MMA(ai, bj, At, Bt) do { __builtin_amdgcn_s_setprio(1); _Pragma("unroll") for (int m = 0; m < 4; ++m) _Pragma("unroll") for (int n = 0; n < 2; ++n) _Pragma("unroll") for (int k = 0; k < 2; ++k) \
        acc[ai][bj][m][n] = __builtin_amdgcn_mfma_f32_16x16x32_bf16(Bt[n][k], At[m][k], acc[ai][bj][m][n], 0, 0, 0); __builtin_amdgcn_s_setprio(0); } while (0)
#define PG8_WAIT_V(n) asm volatile("s_waitcnt vmcnt(" #n ")" ::: "memory")
#define PG8_WAIT_L(n) asm volatile("s_waitcnt lgkmcnt(" #n ")" ::: "memory")
#define PG8_BAR __builtin_amdgcn_s_barrier()
#define PG8_SCHED __builtin_amdgcn_sched_barrier(0)
    Unit cur, nxt; int ui = 0;
    if (!S.next(0, cur)) return;
    f32x4 acc[2][2][4][2];
#pragma unroll
    for (int a = 0; a < 2; ++a)
#pragma unroll
        for (int b = 0; b < 2; ++b)
#pragma unroll
            for (int m = 0; m < 4; ++m)
#pragma unroll
                for (int n = 0; n < 2; ++n) acc[a][b][m][n] = (f32x4){0.f, 0.f, 0.f, 0.f};
    bf16x8 At[4][2], B0[2][2], B1[2][2];
    const char* cA = (const char*)g.A + (size_t)cur.pm * tstep + (size_t)cur.k0 * kstep; const char* cB = (const char*)g.Bt + (size_t)cur.pn * tstep + (size_t)cur.k0 * kstep;
    S.a_ready(cur);
    if constexpr (SP2) {
        PG8_STAGE(PG8_SB(0, 0), cB, voffB); PG8_STAGE(PG8_SB(0, 1), cB + hstep, voffB); PG8_STAGE(PG8_SA(0, 0), cA, voffA); PG8_STAGE(PG8_SA(0, 1), cA + hstep, voffA);
        if (wr == 1) PG8_BAR;
        PG8_WAIT_V(2); PG8_BAR;
        PG8_STAGE(PG8_SB(1, 0), cB + kstep, voffB); PG8_STAGE(PG8_SA(1, 0), cA + kstep, voffA); PG8_STAGE(PG8_SB(1, 1), cB + hstep + kstep, voffB);
        PG8_WAIT_V(6); PG8_BAR;
    } else {
        PG8_STAGE(PG8_SB(0, 0), cB, voffB); PG8_STAGE(PG8_SA(0, 0), cA, voffA); PG8_STAGE(PG8_SB(0, 1), cB + hstep, voffB); PG8_STAGE(PG8_SA(0, 1), cA + hstep, voffA);
        if (wr == 1) PG8_BAR;
        PG8_WAIT_V(4); PG8_BAR;
        PG8_STAGE(PG8_SB(1, 0), cB + kstep, voffB); PG8_STAGE(PG8_SA(1, 0), cA + kstep, voffA); PG8_STAGE(PG8_SB(1, 1), cB + hstep + kstep, voffB);
        PG8_WAIT_V(6); PG8_BAR;
    }
    for (;;) {
        const bool has_next = S.next(ui + 1, nxt);
        const char* nA = has_next ? (const char*)g.A + (size_t)nxt.pm * tstep + (size_t)nxt.k0 * kstep : cA; const char* nB = has_next ? (const char*)g.Bt + (size_t)nxt.pn * tstep + (size_t)nxt.k0 * kstep : cB;
        const int nt = cur.nt;
        for (int t = 0; t < nt; t += 2) {
            const bool last = (t == nt - 2);
            const char* a1 = cA + (size_t)(t + 1) * kstep;
            const char* a2 = last ? nA : cA + (size_t)(t + 2) * kstep; const char* b2 = last ? nB : cB + (size_t)(t + 2) * kstep;
            const char* a3 = a2 + kstep; const char* b3 = b2 + kstep;
            if (last && has_next) S.a_ready(nxt);
            if constexpr (SP2) {
            PG8_LDB(B0, 0, 0); PG8_LDB(B1, 0, 1); PG8_SCHED; PG8_LDA(At, 0, 0); PG8_STAGE(PG8_SA(1, 1), a1 + hstep, voffA);
            PG8_WAIT_V(8); PG8_WAIT_L(0); PG8_BAR; PG8_MMA(0, 0, At, B0); PG8_MMA(0, 1, At, B1); PG8_BAR; PG8_SCHED;
            PG8_LDA(At, 0, 1); PG8_STAGE(PG8_SB(0, 0), b2, voffB); PG8_STAGE(PG8_SB(0, 1), b2 + hstep, voffB); PG8_STAGE(PG8_SA(0, 0), a2, voffA);
            PG8_WAIT_V(8); PG8_WAIT_L(0); PG8_BAR; PG8_MMA(1, 0, At, B0); PG8_MMA(1, 1, At, B1); PG8_BAR; PG8_SCHED;
            PG8_LDB(B0, 1, 0); PG8_LDB(B1, 1, 1); PG8_SCHED; PG8_LDA(At, 1, 0); PG8_STAGE(PG8_SA(0, 1), a2 + hstep, voffA);
            PG8_WAIT_V(8); PG8_WAIT_L(0); PG8_BAR; PG8_MMA(0, 0, At, B0); PG8_MMA(0, 1, At, B1); PG8_BAR; PG8_SCHED;
            PG8_LDA(At, 1, 1); PG8_STAGE(PG8_SB(1, 0), b3, voffB); PG8_STAGE(PG8_SB(1, 1), b3 + hstep, voffB); PG8_STAGE(PG8_SA(1, 0), a3, voffA);
            PG8_WAIT_V(8); PG8_WAIT_L(0); PG8_BAR; PG8_MMA(1, 0, At, B0); PG8_MMA(1, 1, At, B1); PG8_BAR; PG8_SCHED;
            } else {
            PG8_LDB(B0, 0, 0); PG8_SCHED; PG8_LDA(At, 0, 0); PG8_STAGE(PG8_SA(1, 1), a1 + hstep, voffA);
            PG8_WAIT_L(8); PG8_BAR; PG8_WAIT_L(0); PG8_MMA(0, 0, At, B0); PG8_BAR; PG8_SCHED;
            PG8_LDB(B1, 0, 1); PG8_STAGE(PG8_SB(0, 0), b2, voffB);
            PG8_BAR; PG8_WAIT_L(0); PG8_MMA(0, 1, At, B1); PG8_BAR;
            PG8_LDA(At, 0, 1); PG8_STAGE(PG8_SA(0, 0), a2, voffA);
            PG8_BAR; PG8_WAIT_L(0); PG8_MMA(1, 0, At, B0); PG8_BAR; PG8_SCHED;
            PG8_STAGE(PG8_SB(0, 1), b2 + hstep, voffB);
            PG8_WAIT_V(6); PG8_BAR; PG8_MMA(1, 1, At, B1); PG8_BAR;
            PG8_LDB(B0, 1, 0); PG8_SCHED; PG8_LDA(At, 1, 0); PG8_STAGE(PG8_SA(0, 1), a2 + hstep, voffA);
            PG8_WAIT_L(8); PG8_BAR; PG8_WAIT_L(0); PG8_MMA(0, 0, At, B0); PG8_BAR; PG8_SCHED;
            PG8_LDB(B1, 1, 1); PG8_STAGE(PG8_SB(1, 0), b3, voffB);
            PG8_BAR; PG8_WAIT_L(0); PG8_MMA(0, 1, At, B1); PG8_BAR;
            PG8_LDA(At, 1, 1); PG8_STAGE(PG8_SA(1, 0), a3, voffA);
            PG8_BAR; PG8_WAIT_L(0); PG8_MMA(1, 0, At, B0); PG8_BAR; PG8_SCHED;
            PG8_STAGE(PG8_SB(1, 1), b3 + hstep, voffB);
            PG8_WAIT_V(6); PG8_BAR; PG8_MMA(1, 1, At, B1); PG8_BAR;
            }
        }
        if constexpr (ALIGN_EPI) { if (wr == 0) PG8_BAR; }
        if constexpr (!Epi::AFTER_DRAIN) { E(acc, cur, wr, wc, fr, fq); S.done(cur); }
        if (!has_next) break;
#pragma unroll
        for (int a = 0; a < 2; ++a)
#pragma unroll
            for (int b = 0; b < 2; ++b)
#pragma unroll
                for (int m = 0; m < 4; ++m)
#pragma unroll
                    for (int n = 0; n < 2; ++n) acc[a][b][m][n] = (f32x4){0.f, 0.f, 0.f, 0.f};
        cur = nxt; cA = nA; cB = nB; ++ui;
        if constexpr (ALIGN_EPI) { if (wr == 1) PG8_BAR; }
    }
    PG8_WAIT_V(0);
    if constexpr (!ALIGN_EPI) { if (wr == 0) PG8_BAR; }
    PG8_BAR;
    if constexpr (Epi::AFTER_DRAIN) { E.fused(acc, cur, wr, wc, fr, fq, lds, wid, lane); S.done(cur); }
#undef PG8_SA
#undef PG8_SB
#undef PG8_STAGE
#undef PG8_LDA
#undef PG8_LDB
#undef PG8_MMA
#undef PG8_WAIT_V
#undef PG8_WAIT_L
#undef PG8_BAR
#undef PG8_SCHED
}
}
#include <hip/hip_bf16.h>
#include <cmath>
namespace attn_body {
using bf16=__hip_bfloat16;
using bf16x8=__attribute__((ext_vector_type(8)))short;
using s16x4=__attribute__((ext_vector_type(4)))short;
using f32x16=__attribute__((ext_vector_type(16)))float;
using u32x4=__attribute__((ext_vector_type(4)))unsigned;
constexpr int BATCH=8,NHEAD=16,SEQ=2048,D=64,DM=NHEAD*D;
constexpr int NW=8,QBLK=32,QB=QBLK*NW,KVBLK=64,NQB=SEQ/QB;
constexpr int ATTN_PITCH=DM, ATTN_UNIT_ROWS=QB;
__device__ __forceinline__ int crow(int r,int hi){return (r&3)+8*(r>>2)+4*hi;}
#define SBAR() __builtin_amdgcn_sched_barrier(0)
__device__ __forceinline__ void cmask(f32x16&p0,f32x16&p1,int jb,int wid){
  const float NEG=-INFINITY;
  if(jb>(wid>>1)){
    #pragma unroll
    for(int r=0;r<16;++r){p0[r]=NEG;p1[r]=NEG;}
  }
}

constexpr int NSLOT=3, SLOTB=8192;
constexpr int LDS_K=0, LDS_V=NSLOT*SLOTB, LDS_WS=2*NSLOT*SLOTB, LDS_OST=LDS_WS+NW*64*4, LDS_BYTES=LDS_OST+NW*4096;
constexpr float C2=0.125f*1.4426950408889634f;
__device__ __forceinline__ void glds16(const void*gsrc,unsigned lds_dst){unsigned keep;
  asm volatile("s_mov_b32 %0, m0\n\ts_mov_b32 m0, %2\n\ts_nop 0\n\tglobal_load_lds_dwordx4 %1, off\n\ts_mov_b32 m0, %0":"=&s"(keep):"v"(gsrc),"s"(lds_dst):"memory");}
__device__ __forceinline__ float max3f(float a,float b,float c){float r;asm("v_max3_f32 %0, %1, %2, %3":"=v"(r):"v"(a),"v"(b),"v"(c));return r;}
__device__ __forceinline__ float max2f(float a,float b){float r;asm("v_max_f32_e32 %0, %1, %2":"=v"(r):"v"(a),"v"(b));return r;}
__device__ __forceinline__ float fadd_s(float a,float b){float r;asm("v_add_f32_e32 %0, %1, %2":"=v"(r):"v"(a),"v"(b));return r;}
__device__ __forceinline__ float fsub_s(float a,float b){float r;asm("v_sub_f32_e32 %0, %1, %2":"=v"(r):"v"(a),"v"(b));return r;}
typedef float f32x2_t __attribute__((ext_vector_type(2))); typedef __bf16 bf16x2_t __attribute__((ext_vector_type(2)));
__device__ __forceinline__ unsigned cvtpk_s(float lo,float hi){f32x2_t v={lo,hi};bf16x2_t b=__builtin_convertvector(v,bf16x2_t);return __builtin_bit_cast(unsigned,b);}
#define WAIT_BAR(N) asm volatile("s_waitcnt vmcnt(" #N ") lgkmcnt(0)\n\ts_barrier":::"memory")

__device__ __forceinline__ void qkt(f32x16&p0,f32x16&p1,const char*Kslot,const bf16x8*qr,const f32x16&negm,int r32,int hi){
  const char*kb=Kslot+hi*1024+r32*16;
  #pragma unroll
  for(int d0=0;d0<4;++d0){
    const bf16x8 b0=*reinterpret_cast<const bf16x8*>(kb+d0*2048);
    const bf16x8 b1=*reinterpret_cast<const bf16x8*>(kb+d0*2048+512);
    if(d0==0){p0=__builtin_amdgcn_mfma_f32_32x32x16_bf16(b0,qr[0],negm,0,0,0);p1=__builtin_amdgcn_mfma_f32_32x32x16_bf16(b1,qr[0],negm,0,0,0);}
    else{p0=__builtin_amdgcn_mfma_f32_32x32x16_bf16(b0,qr[d0],p0,0,0,0);p1=__builtin_amdgcn_mfma_f32_32x32x16_bf16(b1,qr[d0],p1,0,0,0);}}
}
typedef __attribute__((address_space(3))) const char* lds_cptr;
typedef short v4i16_t __attribute__((ext_vector_type(4)));
__device__ __forceinline__ void kload8(bf16x8*kf,lds_cptr kp){
  kf[0]=*(const __attribute__((address_space(3))) bf16x8*)(kp);      kf[1]=*(const __attribute__((address_space(3))) bf16x8*)(kp+512);
  kf[2]=*(const __attribute__((address_space(3))) bf16x8*)(kp+2048); kf[3]=*(const __attribute__((address_space(3))) bf16x8*)(kp+2560);
  kf[4]=*(const __attribute__((address_space(3))) bf16x8*)(kp+4096); kf[5]=*(const __attribute__((address_space(3))) bf16x8*)(kp+4608);
  kf[6]=*(const __attribute__((address_space(3))) bf16x8*)(kp+6144); kf[7]=*(const __attribute__((address_space(3))) bf16x8*)(kp+6656);
}
__device__ __forceinline__ void kload2(bf16x8*kf,lds_cptr kp,int j){ kf[2*j]=*(const __attribute__((address_space(3))) bf16x8*)(kp+j*2048); kf[2*j+1]=*(const __attribute__((address_space(3))) bf16x8*)(kp+j*2048+512); }
__device__ __forceinline__ s16x4 vtr(lds_cptr p){ return __builtin_bit_cast(s16x4,__builtin_amdgcn_ds_read_tr16_b64_v4i16((__attribute__((address_space(3))) v4i16_t*)p)); }
__device__ __forceinline__ float rowmax(const f32x16&p0,const f32x16&p1){
  float a=max3f(p0[0],p0[1],p1[0]),b=max3f(p0[2],p0[3],p1[1]);a=max3f(a,p1[2],p1[3]);
  #pragma unroll
  for(int r=4;r<16;r+=4){a=max3f(a,p0[r],p0[r+1]);b=max3f(b,p0[r+2],p0[r+3]);a=max3f(a,p1[r],p1[r+1]);b=max3f(b,p1[r+2],p1[r+3]);}
  const float m=max2f(a,b);
  auto rr=__builtin_amdgcn_permlane32_swap(__float_as_uint(m),__float_as_uint(m),false,false);
  return max2f(__uint_as_float(rr[0]),__uint_as_float(rr[1]));
}
__device__ __forceinline__ void pv(f32x16*o,int vb,bf16x8 pa0,bf16x8 pa1,bf16x8 pa2,bf16x8 pa3){
  #pragma unroll
  for(int d0=0;d0<2;++d0){s16x4 lo[4],hi[4];
    #pragma unroll
    for(int ks=0;ks<4;++ks){
      asm volatile("ds_read_b64_tr_b16 %0,%1 offset:%c2":"=&v"(lo[ks]):"v"(vb),"i"(d0*4096+ks*1024):"memory");
      asm volatile("ds_read_b64_tr_b16 %0,%1 offset:%c2":"=&v"(hi[ks]):"v"(vb),"i"(d0*4096+ks*1024+512):"memory");}
    asm volatile("s_waitcnt lgkmcnt(0)":::"memory");SBAR();
    #define PK(k) (bf16x8){lo[k][0],lo[k][1],lo[k][2],lo[k][3],hi[k][0],hi[k][1],hi[k][2],hi[k][3]}
    o[d0]=__builtin_amdgcn_mfma_f32_32x32x16_bf16(pa0,PK(0),o[d0],0,0,0);
    o[d0]=__builtin_amdgcn_mfma_f32_32x32x16_bf16(pa1,PK(1),o[d0],0,0,0);
    o[d0]=__builtin_amdgcn_mfma_f32_32x32x16_bf16(pa2,PK(2),o[d0],0,0,0);
    o[d0]=__builtin_amdgcn_mfma_f32_32x32x16_bf16(pa3,PK(3),o[d0],0,0,0);
    #undef PK
  }
}

#ifndef ATTN_STORE16
#define ATTN_STORE16(p,v) (*(u32x4*)(p)=(v))
#endif
template<int THRL> __device__ __forceinline__ void attn_unit(int b,int h,int hv,int qb,const bf16*Q,const bf16*__restrict__ K,const bf16*__restrict__ V,bf16*O,char*shm){
  const int tid=threadIdx.x,lane=tid&63,r32=lane&31,hi=lane>>5; const int wid=__builtin_amdgcn_readfirstlane(tid>>6);
  const long rowbase=(long)b*SEQ; const int q0=qb*QB;
  const bf16*Qw=Q+(rowbase+q0+wid*QBLK)*DM+h*D;
  const bf16*Kh=K+rowbase*DM+h*D,*Vh=V+rowbase*DM+hv*D;
  const unsigned lds0=(unsigned)(uintptr_t)shm;
  float*wsf=(float*)(shm+LDS_WS)+wid*64;
  const bf16*ksrc=Kh+(long)lane*DM+wid*8;
  const bf16*vsrc=Vh+(long)(16*(wid&3)+(lane>>2))*DM+(wid>>2)*32+(lane&3)*8;
  const unsigned kdst=lds0+LDS_K+wid*1024, vdst=lds0+LDS_V+wid*1024;
  #define DMA_K(t,slot) glds16(ksrc+(long)(t)*KVBLK*DM,(unsigned)__builtin_amdgcn_readfirstlane(kdst+(slot)))
  #define DMA_V(t,slot) glds16(vsrc+(long)(t)*KVBLK*DM,(unsigned)__builtin_amdgcn_readfirstlane(vdst+(slot)))
  const int vb0=(int)(lds0+LDS_V)+((lane>>4)&1)*32+(lane&3)*8+(4*hi+((lane&15)>>2))*64;
  const char*Kbase=shm+LDS_K; bf16x8 kf[8];
  const lds_cptr shm3=(lds_cptr)shm; const lds_cptr kp0=shm3+LDS_K+hi*1024+r32*16; const lds_cptr vp0=shm3+LDS_V+((lane>>4)&1)*32+(lane&3)*8+(4*hi+((lane&15)>>2))*64;
  const int NT=(q0+QB)/KVBLK;
  DMA_K(0,0);DMA_V(0,0);DMA_K(1,SLOTB);
  bf16x8 qr[4];
  #pragma unroll
  for(int d0=0;d0<4;++d0)qr[d0]=*reinterpret_cast<const bf16x8*>(&Qw[(long)r32*DM+d0*16+hi*8]);
  float mhat=0.f,l_reg=0.f;f32x16 o[2];o[0]=f32x16{};o[1]=f32x16{};f32x16 negm=f32x16{};asm volatile("":"+v"(negm));

  #define CMASK(P0,P1,t) do{int jb_=(t)-(NT-4); if(jb_>=0)cmask(P0,P1,jb_,wid);}while(0)
  bool resc=false;
  #define START(P0,P1) do{ const float rm=rowmax(P0,P1); resc=false; \
    { const float dl=rm; mhat=fadd_s(mhat,dl); \
      _Pragma("unroll") for(int r=0;r<16;++r){P0[r]=fsub_s(P0[r],dl);P1[r]=fsub_s(P1[r],dl);} \
      _Pragma("unroll") for(int r=0;r<16;++r)negm[r]=-mhat; asm volatile("":"+v"(negm)); } \
    _Pragma("unroll") for(int r=0;r<16;++r)P0[r]=__builtin_amdgcn_exp2f(P0[r]); }while(0)
  #define RESC() do{ if(resc){ asm volatile("s_waitcnt lgkmcnt(0)":::"memory"); \
      _Pragma("unroll") for(int d_=0;d_<2;++d_) _Pragma("unroll") for(int r=0;r<16;++r)o[d_][r]*=wsf[crow(r,hi)]; } }while(0)
  f32x16 pA0,pA1,pB0,pB1;
  int sl_prev=0,sl_cur=0,sl_next=SLOTB;
  #define ROT() do{sl_prev=sl_cur;sl_cur=sl_next;sl_next=(sl_next==(NSLOT-1)*SLOTB)?0:sl_next+SLOTB;}while(0)
  DMA_K(2,2*SLOTB);
  WAIT_BAR(3);
  qkt(pA0,pA1,Kbase,qr,negm,r32,hi);asm volatile("s_nop 15\n\ts_nop 7":"+v"(pA0),"+v"(pA1));CMASK(pA0,pA1,0);
  START(pA0,pA1);
  _Pragma("unroll") for(int r=0;r<16;++r)pA1[r]=__builtin_amdgcn_exp2f(pA1[r]);
  WAIT_BAR(0);
  DMA_K(3,0);DMA_V(1,SLOTB);
  ROT();
  kload8(kf,kp0+sl_cur);
  WAIT_BAR(2);
  s16x4 vlo[8],vhi[8]; u32x4 pw0,pw1,pw2,pw3;
  #define PKW(P,B) cvtpk_s(P[B],P[B+1])
  #define PAF(k) __builtin_bit_cast(bf16x8,pw##k)
  #define VFR(i) (bf16x8){vlo[i][0],vlo[i][1],vlo[i][2],vlo[i][3],vhi[i][0],vhi[i][1],vhi[i][2],vhi[i][3]}
  #define PIN(x) asm volatile("":"+v"(x))
  #define MX3(a,b,c) __builtin_fmaxf(__builtin_fmaxf((a),(b)),(c))
  #define GAPA(MF,A0,A1,A2,A3,W0,W1,PW) do{ MF; sacc+=A0; sacc+=A1; sacc+=A2; sacc+=A3; PIN(sacc); W0; W1; PIN(PW); SBAR(); }while(0)
  #define EX(v) __builtin_amdgcn_exp2f(v)
  #define GAPB(MF,X,B) do{ MF; X[B]=EX(X[B]); X[B+1]=EX(X[B+1]); X[B+2]=EX(X[B+2]); X[B+3]=EX(X[B+3]); PIN(X); SBAR(); }while(0)
  #define VRD(i) do{ vlo[i]=vtr(vp_+(((i)>>2)*4096+((i)&3)*1024)); vhi[i]=vtr(vp_+(((i)>>2)*4096+((i)&3)*1024+512)); }while(0)
  #define KRD(G,j) do{ if(G){ kload2(kf,kp0+sl_next,j); SBAR(); } }while(0)
  #define STEP(C0,C1,P0,P1,t,GK,GV,GL) do{ SBAR(); \
    const lds_cptr vp_=vp0+sl_prev; \
    VRD(0); SBAR(); float sacc=(P0[0]+P0[1]); \
    GAPA(C0=__builtin_amdgcn_mfma_f32_32x32x16_bf16(kf[0],qr[0],negm,0,0,0), P0[2],P0[3],P0[4],P0[5],     pw0[0]=PKW(P0,0), pw0[1]=PKW(P0,2), pw0); \
    VRD(4); SBAR(); GAPA(C1=__builtin_amdgcn_mfma_f32_32x32x16_bf16(kf[1],qr[0],negm,0,0,0), P0[6],P0[7],P0[8],P0[9],     pw0[2]=PKW(P0,4), pw0[3]=PKW(P0,6), pw0); \
    VRD(1); SBAR(); GAPA(C0=__builtin_amdgcn_mfma_f32_32x32x16_bf16(kf[2],qr[1],C0,0,0,0),   P0[10],P0[11],P0[12],P0[13], pw1[0]=PKW(P0,8), pw1[1]=PKW(P0,10), pw1); \
    VRD(5); SBAR(); GAPA(C1=__builtin_amdgcn_mfma_f32_32x32x16_bf16(kf[3],qr[1],C1,0,0,0),   P0[14],P0[15],P1[0],P1[1],   pw1[2]=PKW(P0,12),pw1[3]=PKW(P0,14), pw1); \
    VRD(2); SBAR(); GAPA(C0=__builtin_amdgcn_mfma_f32_32x32x16_bf16(kf[4],qr[2],C0,0,0,0),   P1[2],P1[3],P1[4],P1[5],     pw2[0]=PKW(P1,0), pw2[1]=PKW(P1,2), pw2); \
    VRD(6); SBAR(); GAPA(C1=__builtin_amdgcn_mfma_f32_32x32x16_bf16(kf[5],qr[2],C1,0,0,0),   P1[6],P1[7],P1[8],P1[9],     pw2[2]=PKW(P1,4), pw2[3]=PKW(P1,6), pw2); \
    VRD(3); SBAR(); GAPA(C0=__builtin_amdgcn_mfma_f32_32x32x16_bf16(kf[6],qr[3],C0,0,0,0),   P1[10],P1[11],P1[12],P1[13], pw3[0]=PKW(P1,8), pw3[1]=PKW(P1,10), pw3); \
    VRD(7); SBAR(); GAPA(C1=__builtin_amdgcn_mfma_f32_32x32x16_bf16(kf[7],qr[3],C1,0,0,0),   P1[14],P1[15],0.f,0.f,       pw3[2]=PKW(P1,12),pw3[3]=PKW(P1,14), pw3); \
    l_reg+=sacc; \
    if(GK){DMA_K((t)+3,sl_cur);} if(GV){DMA_V((t)+1,sl_next);} \
    CMASK(C0,C1,t); \
    { float a=MX3(C0[0],C0[1],C1[0]),b=MX3(C0[2],C0[3],C1[1]); a=MX3(a,C1[2],C1[3]); \
      _Pragma("unroll") for(int r=4;r<16;r+=4){a=MX3(a,C0[r],C0[r+1]);b=MX3(b,C0[r+2],C0[r+3]);a=MX3(a,C1[r],C1[r+1]);b=MX3(b,C1[r+2],C1[r+3]);} \
      float rm=__builtin_fmaxf(a,b); { auto rr=__builtin_amdgcn_permlane32_swap(__float_as_uint(rm),__float_as_uint(rm),false,false); rm=__builtin_fmaxf(__uint_as_float(rr[0]),__uint_as_float(rr[1])); } \
      resc=false; \
      if(__builtin_expect(__any(rm>(float)THRL),0)){ const float dl=__builtin_fmaxf(rm,0.f); mhat+=dl; \
        _Pragma("unroll") for(int r=0;r<16;++r){C0[r]-=dl;C1[r]-=dl;} \
        _Pragma("unroll") for(int r=0;r<16;++r)negm[r]=-mhat; asm volatile("":"+v"(negm)); \
        const float f=__builtin_amdgcn_exp2f(-dl); l_reg*=f; if(hi==0)wsf[r32]=f; resc=true; } } \
    SBAR(); \
    GAPB(o[0]=__builtin_amdgcn_mfma_f32_32x32x16_bf16(PAF(0),VFR(0),o[0],0,0,0), C0,0); \
    GAPB(o[1]=__builtin_amdgcn_mfma_f32_32x32x16_bf16(PAF(0),VFR(4),o[1],0,0,0), C0,4); \
    KRD(GL,0); GAPB(o[0]=__builtin_amdgcn_mfma_f32_32x32x16_bf16(PAF(1),VFR(1),o[0],0,0,0), C0,8); \
    KRD(GL,1); GAPB(o[1]=__builtin_amdgcn_mfma_f32_32x32x16_bf16(PAF(1),VFR(5),o[1],0,0,0), C0,12); \
    KRD(GL,2); GAPB(o[0]=__builtin_amdgcn_mfma_f32_32x32x16_bf16(PAF(2),VFR(2),o[0],0,0,0), C1,0); \
    KRD(GL,3); GAPB(o[1]=__builtin_amdgcn_mfma_f32_32x32x16_bf16(PAF(2),VFR(6),o[1],0,0,0), C1,4); \
    GAPB(o[0]=__builtin_amdgcn_mfma_f32_32x32x16_bf16(PAF(3),VFR(3),o[0],0,0,0), C1,8); \
    GAPB(o[1]=__builtin_amdgcn_mfma_f32_32x32x16_bf16(PAF(3),VFR(7),o[1],0,0,0), C1,12); \
    }while(0)
  int t=1;
  #undef CMASK
  #define CMASK(P0,P1,t) do{}while(0)
  for(;t+5<NT;t+=2){
    STEP(pB0,pB1,pA0,pA1,t,true,true,true);     WAIT_BAR(2); RESC(); ROT();
    STEP(pA0,pA1,pB0,pB1,t+1,true,true,true);   WAIT_BAR(2); RESC(); ROT();
  }
  #undef CMASK
  #define CMASK(P0,P1,t) do{int jb_=(t)-(NT-4); if(jb_>=0)cmask(P0,P1,jb_,wid);}while(0)
  #define ENDW(tt) do{ if((tt)+3<NT){WAIT_BAR(2);} else if((tt)+2<NT){WAIT_BAR(1);} else {WAIT_BAR(0);} }while(0)
  for(;t+1<NT;t+=2){
    STEP(pB0,pB1,pA0,pA1,t,(t+3<NT),(t+1<NT),(t+1<NT));       ENDW(t);   RESC(); ROT();
    STEP(pA0,pA1,pB0,pB1,t+1,(t+4<NT),(t+2<NT),(t+2<NT));     ENDW(t+1); RESC(); ROT();
  }
  STEP(pB0,pB1,pA0,pA1,NT-1,false,false,false); RESC();
  { float sacc=pB0[0]+pB0[1]; _Pragma("unroll") for(int r=2;r<16;++r)sacc+=pB0[r]; _Pragma("unroll") for(int r=0;r<16;++r)sacc+=pB1[r]; l_reg+=sacc;
    pw0=(u32x4){PKW(pB0,0),PKW(pB0,2),PKW(pB0,4),PKW(pB0,6)};pw1=(u32x4){PKW(pB0,8),PKW(pB0,10),PKW(pB0,12),PKW(pB0,14)};pw2=(u32x4){PKW(pB1,0),PKW(pB1,2),PKW(pB1,4),PKW(pB1,6)};pw3=(u32x4){PKW(pB1,8),PKW(pB1,10),PKW(pB1,12),PKW(pB1,14)};
    SBAR(); pv(o,vb0+sl_cur,PAF(0),PAF(1),PAF(2),PAF(3)); }
  #undef PKW
  #undef PAF
  #undef VFR
  #undef PIN
  #undef MX3
  #undef GAPA
  #undef GAPB
  #undef EX
  #undef VRD
  #undef KRD
  #undef STEP
  #undef ENDW
  {auto rr=__builtin_amdgcn_permlane32_swap(__float_as_uint(l_reg),__float_as_uint(l_reg),false,false);l_reg=__uint_as_float(rr[0])+__uint_as_float(rr[1]);}
  if(hi==0)wsf[32+r32]=l_reg;asm volatile("s_waitcnt lgkmcnt(0)":::"memory");
  float rli[16];
  #pragma unroll
  for(int r=0;r<16;++r)rli[r]=__builtin_amdgcn_rcpf(wsf[32+crow(r,hi)]);
  bf16*Ow=O+(rowbase+q0+wid*QBLK)*DM+hv*D;
  { bf16*stg=(bf16*)(shm+LDS_OST)+wid*2048;
    #pragma unroll
    for(int r=0;r<16;++r){const int orow=crow(r,hi);
      #pragma unroll
      for(int d0=0;d0<2;++d0)stg[orow*64+d0*32+r32]=__float2bfloat16(o[d0][r]*rli[r]);}
    asm volatile("s_waitcnt lgkmcnt(0)":::"memory");
    #pragma unroll
    for(int i=0;i<4;++i){const int row=i*8+(lane>>3),ch=lane&7; const u32x4 v=*(const u32x4*)(stg+row*64+ch*8); ATTN_STORE16(Ow+(long)row*DM+ch*8,v);} }
  asm volatile("s_waitcnt lgkmcnt(0)\n\ts_barrier":::"memory");
  #undef DMA_K
  #undef DMA_V
  #undef CMASK
  #undef START
  #undef RESC
  #undef ROT
}
constexpr int ATTN_LDS_BYTES=LDS_BYTES;
struct AttnTensors { const bf16* Q; const bf16* K; const bf16* V; bf16* O0; bf16* O1; };
struct AttnUnit { int combo; int qb; };
struct StaticOrder {
  int vcu, G;
  __device__ __forceinline__ explicit StaticOrder(int grid,int vcu_):vcu(vcu_),G(grid){}
  __device__ __forceinline__ bool next(int i,AttnUnit&u)const{ const int c=vcu+(i>>3)*G; if(c>=BATCH*NHEAD*2)return false; u.combo=c; u.qb=7-(i&7); return true; }
  __device__ __forceinline__ void a_ready(const AttnUnit&)const{}
  __device__ __forceinline__ void done(const AttnUnit&)const{}
};
template<class Sched,int THRL=8> __device__ __forceinline__ void attn_phase(char*lds,const AttnTensors&T,const Sched&S){
  AttnUnit u;
  for(int i=0;S.next(i,u);++i){ S.a_ready(u); const int b=u.combo>>5, hq=(u.combo>>1)&15, vh=u.combo&1; attn_unit<THRL>(b,hq,(hq&~1)+vh,u.qb,T.Q,T.K,T.V,(hq&1)?T.O1:T.O0,lds); S.done(u); }
}
#undef SBAR
#undef WAIT_BAR
}
#define GAS __attribute__((address_space(1)))
#define LAS __attribute__((address_space(3)))
typedef unsigned short bf16;
typedef unsigned v4u __attribute__((ext_vector_type(4)));
typedef float f32x4 __attribute__((ext_vector_type(4)));
typedef short bf16x8 __attribute__((ext_vector_type(8)));
typedef GAS unsigned gu32;
typedef GAS unsigned long long gu64;
#define RLX_AGENT __ATOMIC_RELAXED, __HIP_MEMORY_SCOPE_AGENT
#define LDS_WAIT() asm volatile("s_waitcnt lgkmcnt(0)" ::: "memory")
#define VM_WAIT() asm volatile("s_waitcnt vmcnt(0)" ::: "memory")
__device__ __forceinline__ unsigned long long rt() { return __builtin_amdgcn_s_memrealtime(); }
__device__ __forceinline__ unsigned f2bf(float f) { unsigned u = __builtin_bit_cast(unsigned, f); return (u + 0x7fffu + ((u >> 16) & 1u)) >> 16; }
typedef float pk_f32x2 __attribute__((ext_vector_type(2))); typedef __bf16 pk_bf16x2 __attribute__((ext_vector_type(2)));
__device__ __forceinline__ unsigned pk2(float lo, float hi) { const pk_f32x2 v = {lo, hi}; return __builtin_bit_cast(unsigned, __builtin_convertvector(v, pk_bf16x2)); }

#define XB_TMO      128
#define XB_XCNT(j)  (256  + 64 * (j))
#define XB_XSUB(j)  (1280 + 64 * (j))
#define XB_XGEN(j)  (2304 + 64 * (j))
#define XB_TOP      3328
#define XB_TOPGEN   3392
#define XCD_BAR_WORDS 3456
#define XB_SPIN_CAP (1u << 18)

__device__ __forceinline__ unsigned xb_ld(unsigned* p)              { return __hip_atomic_load(p, __ATOMIC_RELAXED, __HIP_MEMORY_SCOPE_AGENT); }
__device__ __forceinline__ unsigned xb_add(unsigned* p, unsigned v) { return __hip_atomic_fetch_add(p, v, __ATOMIC_RELAXED, __HIP_MEMORY_SCOPE_AGENT); }
__device__ __forceinline__ unsigned xb_xcc_id() { return (unsigned)__builtin_amdgcn_s_getreg((3 << 11) | 20) & 0xFu; }
#define XB_SPIN(cond, bar) do { unsigned _sp = 0; while (cond) { __builtin_amdgcn_s_sleep(1); \
    if ((++_sp & 255u) == 0u) { if (xb_ld(&(bar)[XB_TMO])) break; if (_sp > XB_SPIN_CAP) { atomicAdd(&(bar)[XB_TMO], 1u); break; } } } } while (0)

struct XcdBarrier {
    unsigned* bar; unsigned x;
    volatile LAS unsigned* st;
};

__device__ __forceinline__ XcdBarrier xcd_barrier_post(unsigned* bar, volatile LAS unsigned* st) {
    XcdBarrier b; b.bar = bar; b.x = xb_xcc_id(); b.st = st;
    if (threadIdx.x == 0) (void)xb_add(&bar[XB_XCNT(b.x)], 1u);
    return b;
}
__device__ __forceinline__ void xcd_barrier_complete(unsigned* bar, unsigned x, unsigned& nloc, unsigned& nx) {
    const unsigned G = gridDim.x * gridDim.y * gridDim.z;
    unsigned sum, cnt, mine, sp = 0u;
    for (;;) {
        sum = 0u; cnt = 0u; mine = 0u;
#pragma unroll
        for (unsigned j = 0; j < 16; ++j) { const unsigned c = xb_ld(&bar[XB_XCNT(j)]); sum += c; cnt += (c > 0u) ? 1u : 0u; mine = (j == x) ? c : mine; }
        if (sum == G) break;
        __builtin_amdgcn_s_sleep(1);
        if ((++sp & 255u) == 0u) { if (xb_ld(&bar[XB_TMO])) break; if (sp > XB_SPIN_CAP) { atomicAdd(&bar[XB_TMO], 1u); break; } }
    }
    nloc = mine > 0u ? mine : 1u; nx = cnt > 0u ? cnt : 1u;
}

__device__ __forceinline__ unsigned xcd_barrier_arrive(const XcdBarrier& b) {
    asm volatile("s_waitcnt vmcnt(0)" ::: "memory");
    __syncthreads();
    unsigned target = 0u;
    if (threadIdx.x == 0) {
        unsigned* bar = b.bar;
        __builtin_amdgcn_s_waitcnt(0);
        unsigned nloc = b.st[0], nx = b.st[1];
        if (nloc == 0u) { xcd_barrier_complete(bar, b.x, nloc, nx); b.st[0] = nloc; b.st[1] = nx; }
        const unsigned old = xb_add(&bar[XB_XSUB(b.x)], 1u);
        const unsigned gen = old / nloc;
        if (old + 1u == (gen + 1u) * nloc) {
            __builtin_amdgcn_fence(__ATOMIC_RELEASE, "agent");
            asm volatile("s_waitcnt vmcnt(0)" ::: "memory");
            (void)xb_add(&bar[XB_TOP], 1u);
        }
        target = (gen + 1u) * nx;
    }
    return target;
}
__device__ __forceinline__ void xcd_barrier_wait(const XcdBarrier& b, unsigned target) {
    if (threadIdx.x == 0) {
        unsigned* bar = b.bar;
        XB_SPIN(xb_ld(&bar[XB_TOP]) < target, bar);
        __builtin_amdgcn_fence(__ATOMIC_ACQUIRE, "agent");
        asm volatile("s_waitcnt vmcnt(0)" ::: "memory");
    }
    __syncthreads();
}
__device__ __forceinline__ void xcd_barrier(const XcdBarrier& b) { const unsigned t = xcd_barrier_arrive(b); xcd_barrier_wait(b, t); }

constexpr int NWAVES = 8;
constexpr int D = 1024, MP = 16384, MS = 1024, M = MP + MS;
constexpr int NSEQ = 40;
constexpr int DFF = 2816, AIN = 6144, NMODC = 20480;
constexpr int NPOS = 2080;
constexpr float EPS = 1e-6f;
constexpr float LAM_INIT = 0.35550906759096934f;
constexpr float QSCALE = 0.125f * 1.4426950408889634f;

constexpr size_t MiB = 1u << 20;
constexpr size_t WS_CTL = 0;
constexpr size_t WS_MOD = 1 * MiB;
constexpr size_t ZERO_BYTES = 64 * 1024;
constexpr size_t WS_ROPEA = 5 * MiB, WS_ROPEB = 7 * MiB;
constexpr size_t WS_WFI = 8 * MiB;
constexpr size_t SZ_WFI = (size_t)5632 * 1024 * 2;
constexpr size_t WS_WFO = WS_WFI + 4 * SZ_WFI;
constexpr size_t SZ_WFO = (size_t)1024 * 2816 * 2;
constexpr size_t WS_WIA = WS_WFO + 4 * SZ_WFO;
constexpr size_t WS_WOA = WS_WIA + (size_t)6144 * 1024 * 2;
constexpr size_t WS_WKV = WS_WOA + (size_t)1024 * 2048 * 2;
constexpr size_t WS_WQB = WS_WKV + (size_t)2048 * 1024 * 2;
constexpr size_t WS_WOB = WS_WQB + (size_t)1024 * 1024 * 2;
constexpr size_t WS_ACT = 128 * MiB;
constexpr size_t SZ_A1 = (size_t)M * 1024 * 2, SZ_A2 = (size_t)M * 2048 * 2, SZ_U = (size_t)M * 2816 * 2;
constexpr size_t WS_H = WS_ACT, WS_HKV = WS_H + SZ_A1, WS_Y = WS_HKV + SZ_A1, WS_U = WS_Y + 2 * SZ_A1;
constexpr size_t WS_QR = WS_U + SZ_U, WS_KR = WS_QR + SZ_A1, WS_VR = WS_KR + SZ_A1, WS_GR = WS_VR + SZ_A2, WS_OR = WS_GR + SZ_A2, WS_AR = WS_OR + SZ_A2;
constexpr size_t WS_KB = WS_AR + SZ_A2, WS_VB = WS_KB + SZ_A1, WS_QB = WS_VB + SZ_A1, WS_O0 = WS_QB + SZ_A1, WS_O1 = WS_O0 + SZ_A1, WS_AB = WS_O1 + SZ_A1;
constexpr size_t WS_XB = WS_AB + SZ_A1;
constexpr size_t WS_END = WS_XB + SZ_A1;
static_assert(WS_WOB + (size_t)1024 * 1024 * 2 <= WS_ACT && ZERO_BYTES <= WS_MOD && WS_MOD + (size_t)NSEQ * NMODC * 4 <= WS_ROPEA && WS_ROPEA + (size_t)NPOS * 64 * 8 <= WS_ROPEB && WS_ROPEB + (size_t)NPOS * 32 * 8 <= WS_WFI, "d_ws map");
constexpr size_t OUT_Y = 0, OUT_SRP = (size_t)M * 1024, OUT_KP = OUT_SRP + (size_t)8 * 8 * 128 * 256, OUT_VP = OUT_KP + (size_t)MP * 1024, OUT_SRS = OUT_VP + (size_t)MP * 1024,
                 OUT_KS = OUT_SRS + (size_t)32 * 8 * 128 * 256, OUT_VS = OUT_KS + (size_t)MS * 1024, OUT_END = OUT_VS + (size_t)MS * 1024;
static_assert(OUT_END == 63963136, "d_out map");
constexpr int CW_BAR = 4096;
static_assert((CW_BAR + 3456) * 4 <= (int)ZERO_BYTES, "barrier words inside the zeroed region");

constexpr int RING_OFF = 0, RING_BYTES = 131072;
constexpr int LDSCTL_OFF = RING_BYTES, MISC_OFF = LDSCTL_OFF + 320;
constexpr int LDS_BYTES = 147456;
static_assert(MISC_OFF + 128 <= LDS_BYTES, "LDS map");

static __device__ const double INVF[64] = {
 1.0, 0.8659643233600653, 0.7498942093324559, 0.6493816315762113, 0.5623413251903491, 0.4869675251658631, 0.4216965034285822, 0.3651741272548377, 0.31622776601683794, 0.27384196342643613, 0.23713737056616552, 0.2053525026457146, 0.1778279410038923, 0.1539926526059492, 0.1333521432163324, 0.11547819846894582,
 0.1, 0.08659643233600653, 0.07498942093324558, 0.06493816315762113, 0.05623413251903491, 0.04869675251658631, 0.042169650342858224, 0.03651741272548377, 0.03162277660168379, 0.027384196342643614, 0.023713737056616554, 0.02053525026457146, 0.01778279410038923, 0.01539926526059492, 0.01333521432163324, 0.011547819846894581,
 0.01, 0.008659643233600654, 0.007498942093324558, 0.006493816315762113, 0.005623413251903491, 0.004869675251658631, 0.004216965034285823, 0.003651741272548377, 0.0031622776601683794, 0.0027384196342643613, 0.0023713737056616554, 0.002053525026457146, 0.0017782794100389228, 0.001539926526059492, 0.001333521432163324, 0.0011547819846894581,
 0.001, 0.0008659643233600654, 0.0007498942093324559, 0.0006493816315762113, 0.0005623413251903491, 0.0004869675251658631, 0.00042169650342858224, 0.0003651741272548377, 0.00031622776601683794, 0.0002738419634264361, 0.00023713737056616554, 0.0002053525026457146, 0.00017782794100389227, 0.0001539926526059492, 0.0001333521432163324, 0.00011547819846894582 };
__device__ __forceinline__ float lg2gamma(int h) {
    switch (h) { case 0: return -0.04580368961312479f; case 1: return -0.02272007650008353f; case 2: return -0.011315313227834146f; case 3: return -0.005646563141142063f;
                 case 4: return -0.0028205190623786626f; case 5: return -0.0014095702546713536f; case 6: return -0.0007046129765893727f; default: return -0.0003522634716290214f; }
}
__device__ __forceinline__ float bf2f(unsigned short b) { return __builtin_bit_cast(float, (unsigned)b << 16); }
__device__ __forceinline__ float wave_sum(float v) {
#pragma unroll
    for (int o = 1; o < 64; o <<= 1) v += __shfl_xor(v, o);
    return v;
}
__device__ __forceinline__ void unpack8(const v4u w, float (&f)[8]) {
    f[0] = __builtin_bit_cast(float, w.x << 16); f[1] = __builtin_bit_cast(float, w.x & 0xffff0000u); f[2] = __builtin_bit_cast(float, w.y << 16); f[3] = __builtin_bit_cast(float, w.y & 0xffff0000u);
    f[4] = __builtin_bit_cast(float, w.z << 16); f[5] = __builtin_bit_cast(float, w.z & 0xffff0000u); f[6] = __builtin_bit_cast(float, w.w << 16); f[7] = __builtin_bit_cast(float, w.w & 0xffff0000u);
}
__device__ __forceinline__ v4u pack8f(const float (&f)[8]) { v4u o; o.x = pk2(f[0], f[1]); o.y = pk2(f[2], f[3]); o.z = pk2(f[4], f[5]); o.w = pk2(f[6], f[7]); return o; }
__device__ __forceinline__ v4u ldnt16(const void* p) { return __builtin_nontemporal_load((const GAS v4u*)p); }
__device__ __forceinline__ void ld8nt(const float* p, float (&f)[8]) { const f32x4 a = __builtin_nontemporal_load((const GAS f32x4*)p), b = __builtin_nontemporal_load((const GAS f32x4*)(p + 4)); f[0] = a[0]; f[1] = a[1]; f[2] = a[2]; f[3] = a[3]; f[4] = b[0]; f[5] = b[1]; f[6] = b[2]; f[7] = b[3]; }
__device__ __forceinline__ void ld8(const float* p, float (&f)[8]) { const f32x4 a = *(const GAS f32x4*)p, b = *(const GAS f32x4*)(p + 4); f[0] = a[0]; f[1] = a[1]; f[2] = a[2]; f[3] = a[3]; f[4] = b[0]; f[5] = b[1]; f[6] = b[2]; f[7] = b[3]; }
__device__ __forceinline__ void st8(float* p, const float (&f)[8]) { *(GAS f32x4*)p = (f32x4){f[0], f[1], f[2], f[3]}; *(GAS f32x4*)(p + 4) = (f32x4){f[4], f[5], f[6], f[7]}; }

typedef float f32x16_t __attribute__((ext_vector_type(16)));
__device__ __forceinline__ bf16x8 cvt8(const f32x4 a, const f32x4 b) { const v4u w = {pg8::cvt_pk_bf16(a[0], a[1]), pg8::cvt_pk_bf16(a[2], a[3]), pg8::cvt_pk_bf16(b[0], b[1]), pg8::cvt_pk_bf16(b[2], b[3])}; return __builtin_bit_cast(bf16x8, w); }
struct P0Args { const float *c_p, *c_s, *w_ada, *b_ada, *w_ffn_in, *w_ffn_out, *w_in_a, *w_out_a, *w_ada_kv, *b_ada_kv, *w_kv, *w_q_b, *w_out_b; unsigned char* ws; };
struct TItem { const float* src; bf16* dst; int K, Nsrc, k0, sc0, dr0; float mul; };
constexpr int I_FI = 16 * 176, I_FO = 44 * 32, I_IA = 16 * 192, I_OA = 32 * 32, I_KV = 16 * 64, I_QB = 16 * 32, I_OB = 16 * 32;
constexpr int P0_SET0 = I_FI, P0_SET1 = I_OA + I_FI + I_FO, P0_SET2 = I_OB + I_FI + I_FO, P0_SET3 = 2 * I_FO + I_IA + I_FI + I_KV + I_QB;
constexpr int P0_NITEMS = P0_SET0 + P0_SET1 + P0_SET2 + P0_SET3;
static_assert(P0_NITEMS == 4 * I_FI + 4 * I_FO + I_IA + I_OA + I_KV + I_QB + I_OB, "item sets");
__device__ __forceinline__ TItem p0_item_fi(const P0Args& A, int mi, int r) { TItem t; const int kb = r / 176, nb = r % 176, n0 = 32 * nb;
    const int pn = n0 >> 8, bj = (n0 >> 7) & 1, i0 = n0 & 127;
    t.src = A.w_ffn_in + (size_t)mi * 1024 * 5632; t.dst = (bf16*)(A.ws + WS_WFI + mi * SZ_WFI); t.K = 1024; t.Nsrc = 5632; t.k0 = 64 * kb; t.sc0 = bj * 2816 + 128 * pn + i0; t.dr0 = n0; t.mul = bj ? 0.6931471805599453f : 1.4426950408889634f; return t; }
__device__ __forceinline__ TItem p0_item_fo(const P0Args& A, int mi, int r) { TItem t; const int kb = r / 32, nb = r % 32;
    t.src = A.w_ffn_out + (size_t)mi * 2816 * 1024; t.dst = (bf16*)(A.ws + WS_WFO + mi * SZ_WFO); t.K = 2816; t.Nsrc = 1024; t.k0 = 64 * kb; t.sc0 = 32 * nb; t.dr0 = 32 * nb; t.mul = 1.0f; return t; }
__device__ __forceinline__ TItem p0_item_sq(const float* src, bf16* dst, int K, int r) { TItem t; const int kb = r / 32, nb = r % 32;
    t.src = src; t.dst = dst; t.K = K; t.Nsrc = 1024; t.k0 = 64 * kb; t.sc0 = 32 * nb; t.dr0 = 32 * nb; t.mul = 1.0f; return t; }
template <int SET> __device__ __forceinline__ TItem p0_decode(const P0Args& A, int r  ) {
    TItem t;
    if (SET == 0) { return p0_item_fi(A, 0, r);
    } else if (SET == 3) {
    if (r < I_FO) return p0_item_fo(A, 0, r); r -= I_FO;
    if (r < I_IA) { const int kb = r / 192, nb = r % 192, n0 = 32 * nb; int sc0 = n0;
        if (n0 < 2048) { const int sec = n0 >> 10, pn4 = (n0 >> 8) & 3, bj = (n0 >> 7) & 1, hh = (n0 >> 6) & 1, d = n0 & 63;
            sc0 = sec * 1024 + (2 * pn4 + hh) * 128 + d + 64 * bj; }
        t.src = A.w_in_a; t.dst = (bf16*)(A.ws + WS_WIA); t.K = 1024; t.Nsrc = 6144; t.k0 = 64 * kb; t.sc0 = sc0; t.dr0 = n0; t.mul = 1.0f; return t; }
    r -= I_IA;
    if (r < I_FI) return p0_item_fi(A, 2, r); r -= I_FI;
    if (r < I_KV) { const int kb = r / 64, nb = r % 64, n0 = 32 * nb; int sc0 = n0;
        if (n0 < 1024) { const int pn = n0 >> 8, bj = (n0 >> 7) & 1, g = (n0 >> 5) & 3; sc0 = (4 * pn + g) * 64 + 32 * bj; }
        t.src = A.w_kv; t.dst = (bf16*)(A.ws + WS_WKV); t.K = 1024; t.Nsrc = 2048; t.k0 = 64 * kb; t.sc0 = sc0; t.dr0 = n0; t.mul = 1.0f; return t; }
    r -= I_KV;
    if (r < I_FO) return p0_item_fo(A, 2, r); r -= I_FO;
    { const int kb = r / 32, nb = r % 32, n0 = 32 * nb; const int pn = n0 >> 8, bj = (n0 >> 7) & 1, g = (n0 >> 5) & 3;
        t.src = A.w_q_b; t.dst = (bf16*)(A.ws + WS_WQB); t.K = 1024; t.Nsrc = 1024; t.k0 = 64 * kb; t.sc0 = (4 * pn + g) * 64 + 32 * bj; t.dr0 = n0; t.mul = 1.0f; return t; }
    } else if (SET == 1) {
    if (r < I_OA) return p0_item_sq(A.w_out_a, (bf16*)(A.ws + WS_WOA), 2048, r); r -= I_OA;
    if (r < I_FI) return p0_item_fi(A, 1, r); r -= I_FI;
    return p0_item_fo(A, 1, r);
    } else {
    if (r < I_OB) return p0_item_sq(A.w_out_b, (bf16*)(A.ws + WS_WOB), 1024, r); r -= I_OB;
    if (r < I_FI) return p0_item_fi(A, 3, r); r -= I_FI;
    return p0_item_fo(A, 3, r);
    }
}
__device__ __forceinline__ void p0_tload(const TItem& t, f32x4 (&v)[8], int lane) {
    const float* p = t.src + (size_t)(t.k0 + (lane >> 3)) * t.Nsrc + t.sc0 + 4 * (lane & 7);
#pragma unroll
    for (int i = 0; i < 8; ++i) v[i] = __builtin_nontemporal_load((const GAS f32x4*)(p + (size_t)(8 * i) * t.Nsrc));
}
__device__ __forceinline__ void p0_tstore(const TItem& t, const f32x4 (&v)[8], LAS float* scr, int lane) {
    { const int kr = lane >> 3, c4 = 4 * (lane & 7);
#pragma unroll
      for (int i = 0; i < 8; ++i) { LAS float* d = scr + (kr + 8 * i) * 33 + c4; d[0] = v[i][0]; d[1] = v[i][1]; d[2] = v[i][2]; d[3] = v[i][3]; } }
    LDS_WAIT(); asm volatile("" ::: "memory");
    const int c = lane & 7;
#pragma unroll
    for (int j = 0; j < 4; ++j) { const int n = (lane >> 3) + 8 * j; const LAS float* s = scr + (8 * c) * 33 + n;
        const float ml = t.mul; v4u o; o.x = pk2(s[0 * 33] * ml, s[1 * 33] * ml); o.y = pk2(s[2 * 33] * ml, s[3 * 33] * ml); o.z = pk2(s[4 * 33] * ml, s[5 * 33] * ml); o.w = pk2(s[6 * 33] * ml, s[7 * 33] * ml);
        *(GAS v4u*)(t.dst + (size_t)(t.dr0 + n) * t.K + t.k0 + 8 * c) = o; }
    LDS_WAIT(); asm volatile("" ::: "memory");
}
template <int SET> __device__ __forceinline__ void p0_convert(const P0Args& A, LAS unsigned char* lds, int gw, int NGW, int lane, int wave, int it0 = 0, int it1 = (SET == 0 ? P0_SET0 : SET == 1 ? P0_SET1 : SET == 2 ? P0_SET2 : P0_SET3)) {
    LAS float* scr = (LAS float*)(lds + RING_OFF + wave * 16384);
    int it = it0 + gw; f32x4 cur[8], nxt[8]; TItem tc, tn;
    if (it < it1) { tc = p0_decode<SET>(A, it); p0_tload(tc, cur, lane); }
    while (it < it1) {
        const int nit = it + NGW;
        if (nit < it1) { tn = p0_decode<SET>(A, nit); p0_tload(tn, nxt, lane); }
        p0_tstore(tc, cur, scr, lane);
#pragma unroll
        for (int i = 0; i < 8; ++i) cur[i] = nxt[i];
        tc = tn; it = nit;
    }
}
typedef float f32x2_t __attribute__((ext_vector_type(2)));
__device__ __forceinline__ void p0_mod(const P0Args& A, LAS unsigned char* lds, int vcu, int G, int tid, int lane, int wave) {
    {   LAS float* red = (LAS float*)(lds + RING_OFF);
        float* MODw = (float*)(A.ws + WS_MOD);
        const int r32 = lane & 31, hi = lane >> 5;
        for (int it = vcu; it < NMODC / 32; it += G) {
            const int col0 = 32 * it; const float* W; const float* bias; int N, col;
            if (col0 < 9216) { W = A.w_ada; bias = A.b_ada; N = 9216; col = col0; }
            else if (col0 < 18432) { W = A.w_ada + (size_t)1024 * 9216; bias = A.b_ada + 9216; N = 9216; col = col0 - 9216; }
            else { W = A.w_ada_kv; bias = A.b_ada_kv; N = 2048; col = col0 - 18432; }
            const int kw = 128 * wave; const int loff = hi * 8 * N + r32;
            const float* c0p = (r32 < 8 ? A.c_p + r32 * 1024 : A.c_s + (r32 - 8) * 1024) + kw + 8 * hi;
            const float* c1p = A.c_s + (24 + (r32 & 7)) * 1024 + kw + 8 * hi;
            f32x16_t acc0, acc1;
#pragma unroll
            for (int r = 0; r < 16; ++r) { acc0[r] = 0.f; acc1[r] = 0.f; }
#pragma nounroll
            for (int hf = 0; hf < 2; ++hf) {
                float wv[4][8];
#pragma unroll
                for (int st = 0; st < 4; ++st)
#pragma unroll
                    for (int j = 0; j < 8; ++j) { const float* rowb = W + (size_t)(kw + 64 * hf + 16 * st + j) * N + col; wv[st][j] = __builtin_nontemporal_load((const GAS float*)(rowb + loff)); }
#pragma unroll
                for (int st = 0; st < 4; ++st) {
                    float ca[8], cb[8]; ld8(c0p + 64 * hf + 16 * st, ca); ld8(c1p + 64 * hf + 16 * st, cb);
#pragma unroll
                    for (int j = 0; j < 8; ++j) { ca[j] = ca[j] / (1.0f + __expf(-ca[j])); cb[j] = (r32 < 8) ? cb[j] / (1.0f + __expf(-cb[j])) : 0.f; }
                    const bf16x8 bfr = cvt8((f32x4){wv[st][0], wv[st][1], wv[st][2], wv[st][3]}, (f32x4){wv[st][4], wv[st][5], wv[st][6], wv[st][7]});
                    acc0 = __builtin_amdgcn_mfma_f32_32x32x16_bf16(cvt8((f32x4){ca[0], ca[1], ca[2], ca[3]}, (f32x4){ca[4], ca[5], ca[6], ca[7]}), bfr, acc0, 0, 0, 0);
                    acc1 = __builtin_amdgcn_mfma_f32_32x32x16_bf16(cvt8((f32x4){cb[0], cb[1], cb[2], cb[3]}, (f32x4){cb[4], cb[5], cb[6], cb[7]}), bfr, acc1, 0, 0, 0);
                }
            }
#pragma unroll
            for (int r = 0; r < 16; ++r) { const int sq = (r & 3) + 8 * (r >> 2) + 4 * hi; red[(wave * 40 + sq) * 32 + r32] = acc0[r]; if (sq < 8) red[(wave * 40 + 32 + sq) * 32 + r32] = acc1[r]; }
            __syncthreads();
            for (int u = tid; u < NSEQ * 32; u += NWAVES * 64) { float v = bias[col + (u & 31)];
#pragma unroll
                for (int w8 = 0; w8 < 8; ++w8) v += red[w8 * 40 * 32 + u];
                MODw[(size_t)(u >> 5) * NMODC + col0 + (u & 31)] = v; }
            __syncthreads();
        }
    }
}
__device__ __forceinline__ void p0_rest(const P0Args& A, LAS unsigned char* lds, int vcu, int G, int tid, int lane, int wave) {
    const int gw = vcu * NWAVES + wave, NGW = G * NWAVES;
    p0_convert<0>(A, lds, gw, NGW, lane, wave);
    float* RA = (float*)(A.ws + WS_ROPEA); float* RB = (float*)(A.ws + WS_ROPEB);
    for (int e = gw * 64 + lane; e < NPOS * 64; e += NGW * 64) {
        const int pi = e >> 6, d = e & 63; const double pos = (double)(pi < 2048 ? pi : 4096 + (pi - 2048));
        const double t = pos * INVF[d] * 0.15915494309189535; const float fr = (float)(t - floor(t));
        const float cs = __builtin_amdgcn_cosf(fr), sn = __builtin_amdgcn_sinf(fr);
        RA[2 * e] = cs; RA[2 * e + 1] = sn;
        if ((d & 1) == 0) { const int eb = pi * 32 + (d >> 1); RB[2 * eb] = cs; RB[2 * eb + 1] = sn; }
    }
}

struct RowOut { const float* gn; int shift_off, scale_off; bf16* dst; };
template <bool HAS_Y, int NOUT, bool XIN_BF, int XOUT  >
__device__ __forceinline__ void rowpass(const float* xp, const float* xs  , bf16* xb  , const bf16* Y, const float* gw, int gate_off, float gs, float* xdst,
                                        const RowOut o0, const RowOut o1, const float* MOD, int gw_id, int NGW, int lane, int ykdim, int G) {
    const int c0 = 8 * lane;
    pg8::StreamK SK; if (HAS_Y) SK.init(M, 1024, ykdim, G, 0);
    for (int seg = 0; seg < 2; ++seg) {
        const int nblk = seg == 0 ? MP / 8 : MS;
        for (int bi = gw_id; bi < nblk; bi += NGW) {
            const int r0 = seg == 0 ? 8 * bi : MP + bi, nr = seg == 0 ? 8 : 1;
            const int seq = r0 < MP ? (r0 >> 11) : 8 + ((r0 - MP) >> 5);
            const float* mrow = MOD + (size_t)seq * NMODC;
            bool two[2] = {false, false};
            if (HAS_Y) { _Pragma("unroll") for (int j = 0; j < 2; ++j) two[j] = SK.pieces((r0 >> 8) * 4 + (lane >> 5) + 2 * j) > 1; }
            float A1[2][8], B0[2][8], S0[2][8], B1[2][8], S1[2][8];
#pragma unroll
            for (int j = 0; j < 2; ++j) {
                if (HAS_Y) { float g[8], t[8]; ld8(gw + c0 + 512 * j, g); ld8(mrow + gate_off + c0 + 512 * j, t);
#pragma unroll
                    for (int e = 0; e < 8; ++e) A1[j][e] = gs * t[e] * g[e]; }
                if (NOUT >= 1) { float g[8], t[8]; ld8(o0.gn + c0 + 512 * j, g); ld8(mrow + o0.scale_off + c0 + 512 * j, t); ld8(mrow + o0.shift_off + c0 + 512 * j, S0[j]);
#pragma unroll
                    for (int e = 0; e < 8; ++e) B0[j][e] = g[e] * (1.0f + t[e]); }
                if (NOUT >= 2) { float g[8], t[8]; ld8(o1.gn + c0 + 512 * j, g); ld8(mrow + o1.scale_off + c0 + 512 * j, t); ld8(mrow + o1.shift_off + c0 + 512 * j, S1[j]);
#pragma unroll
                    for (int e = 0; e < 8; ++e) B1[j][e] = g[e] * (1.0f + t[e]); }
            }
            for (int rr = 0; rr < nr; ++rr) {
                const int r = r0 + rr;
                float x[2][8];
                if (XIN_BF) {
#pragma unroll
                    for (int j = 0; j < 2; ++j) unpack8(ldnt16(xb + (size_t)r * 1024 + c0 + 512 * j), x[j]);
                } else { const float* xrow = (r < MP) ? xp + (size_t)r * 1024 : xs + (size_t)(r - MP) * 1024;
#pragma unroll
                    for (int j = 0; j < 2; ++j) ld8nt(xrow + c0 + 512 * j, x[j]); }
                if (HAS_Y) {
                    float y[2][8]; float ss = 0.f;
#pragma unroll
                    for (int j = 0; j < 2; ++j) { unpack8(ldnt16(Y + (size_t)r * 1024 + c0 + 512 * j), y[j]);
                        if (two[j]) { float y2[8]; unpack8(ldnt16(Y + SZ_A1 / 2 + (size_t)r * 1024 + c0 + 512 * j), y2); _Pragma("unroll") for (int e = 0; e < 8; ++e) y[j][e] += y2[e]; }
#pragma unroll
                        for (int e = 0; e < 8; ++e) ss += y[j][e] * y[j][e]; }
                    const float rstd = rsqrtf(wave_sum(ss) * (1.0f / 1024.0f) + EPS);
#pragma unroll
                    for (int j = 0; j < 2; ++j)
#pragma unroll
                        for (int e = 0; e < 8; ++e) x[j][e] += A1[j][e] * (y[j][e] * rstd);
                }
                if (XOUT == 2) {
#pragma unroll
                    for (int j = 0; j < 2; ++j) st8(xdst + (size_t)r * 1024 + c0 + 512 * j, x[j]);
                }
                if (XOUT == 1) {
#pragma unroll
                    for (int j = 0; j < 2; ++j) __builtin_nontemporal_store(pack8f(x[j]), (GAS v4u*)(xb + (size_t)r * 1024 + c0 + 512 * j));
                }
                if (NOUT >= 1) {
                    float ss = 0.f;
#pragma unroll
                    for (int j = 0; j < 2; ++j)
#pragma unroll
                        for (int e = 0; e < 8; ++e) ss += x[j][e] * x[j][e];
                    const float rstd = rsqrtf(wave_sum(ss) * (1.0f / 1024.0f) + EPS);
#pragma unroll
                    for (int j = 0; j < 2; ++j) { float h[8];
#pragma unroll
                        for (int e = 0; e < 8; ++e) h[e] = (x[j][e] * rstd) * B0[j][e] + S0[j][e];
                        *(GAS v4u*)(o0.dst + (size_t)r * 1024 + c0 + 512 * j) = pack8f(h);
                        if (NOUT >= 2) {
#pragma unroll
                            for (int e = 0; e < 8; ++e) h[e] = (x[j][e] * rstd) * B1[j][e] + S1[j][e];
                            *(GAS v4u*)(o1.dst + (size_t)r * 1024 + c0 + 512 * j) = pack8f(h); } }
                }
            }
        }
    }
}
__device__ __forceinline__ void gatenorm_pass(const bf16* OR_, const bf16* GR, const float* ggn, bf16* AR, int gw_id, int NGW, int lane) {
    float gg[4][8];
#pragma unroll
    for (int j = 0; j < 4; ++j) ld8(ggn + 8 * lane + 512 * j, gg[j]);
    for (int r = gw_id; r < M; r += NGW) {
#pragma unroll
        for (int j = 0; j < 4; ++j) { const size_t off = (size_t)r * 2048 + 8 * lane + 512 * j;
            float o[8], g[8]; unpack8(ldnt16(OR_ + off), o); unpack8(ldnt16(GR + off), g);
            float ss = 0.f;
#pragma unroll
            for (int e = 0; e < 8; ++e) ss += o[e] * o[e];
#pragma unroll
            for (int k = 1; k < 32; k <<= 1) ss += __shfl_xor(ss, k);
            const float rstd = rsqrtf(ss * (1.0f / 256.0f) + EPS);
            float a[8];
#pragma unroll
            for (int e = 0; e < 8; ++e) a[e] = pg8::silu_f(g[e]) * ((o[e] * rstd) * gg[j][e]);
            *(GAS v4u*)(AR + off) = pack8f(a); }
    }
}
__device__ __forceinline__ void diffnorm_pass(const bf16* O0, const bf16* O1, const float* lamp  , const float* gsub  , bf16* AB, int gw_id, int NGW, int lane) {
    const float s01 = wave_sum(lamp[lane] * lamp[64 + lane]), s23 = wave_sum(lamp[128 + lane] * lamp[192 + lane]);
    const float lam = expf(s01) - expf(s23) + LAM_INIT;
    float gs[8]; ld8(gsub + 8 * (lane & 15), gs);
#pragma unroll
    for (int e = 0; e < 8; ++e) gs[e] *= (1.0f - LAM_INIT);
    for (int r = gw_id; r < M; r += NGW) {
#pragma unroll
        for (int j = 0; j < 2; ++j) { const size_t off = (size_t)r * 1024 + 8 * lane + 512 * j;
            float a[8], b[8]; unpack8(ldnt16(O0 + off), a); unpack8(ldnt16(O1 + off), b);
            float ss = 0.f;
#pragma unroll
            for (int e = 0; e < 8; ++e) { a[e] -= lam * b[e]; ss += a[e] * a[e]; }
#pragma unroll
            for (int k = 1; k < 16; k <<= 1) ss += __shfl_xor(ss, k);
            const float rstd = rsqrtf(ss * (1.0f / 128.0f) + EPS);
#pragma unroll
            for (int e = 0; e < 8; ++e) a[e] = (a[e] * rstd) * gs[e];
            *(GAS v4u*)(AB + off) = pack8f(a); }
    }
}

typedef float f32x4_t __attribute__((ext_vector_type(4)));
typedef short v4s_t __attribute__((ext_vector_type(4)));
__device__ __forceinline__ f32x4_t mfma16(const bf16x8 a, const bf16x8 b, const f32x4_t c) { return __builtin_amdgcn_mfma_f32_16x16x32_bf16(a, b, c, 0, 0, 0); }
__device__ __forceinline__ bf16x8 tr16(const LAS unsigned char* p, int skip_bytes) {
    const v4s_t lo = __builtin_amdgcn_ds_read_tr16_b64_v4i16((LAS v4s_t*)p), hi = __builtin_amdgcn_ds_read_tr16_b64_v4i16((LAS v4s_t*)(p + skip_bytes));
    return (bf16x8){lo[0], lo[1], lo[2], lo[3], hi[0], hi[1], hi[2], hi[3]};
}
__device__ __forceinline__ float dppq(float v, int ctrl_b1) { return ctrl_b1 ? __builtin_bit_cast(float, __builtin_amdgcn_update_dpp(0, __builtin_bit_cast(int, v), 0xB1, 0xF, 0xF, false))
                                                                              : __builtin_bit_cast(float, __builtin_amdgcn_update_dpp(0, __builtin_bit_cast(int, v), 0x4E, 0xF, 0xF, false)); }
__device__ __forceinline__ f32x4_t quad_tr(const f32x4_t a, int p) {
    float a0 = a[0], a1 = a[1], a2 = a[2], a3 = a[3];
    { const bool o = (p & 1) != 0; const float r0 = dppq(o ? a0 : a1, 1), r1 = dppq(o ? a2 : a3, 1); if (o) { a0 = r0; a2 = r1; } else { a1 = r0; a3 = r1; } }
    { const bool o = (p & 2) != 0; const float r0 = dppq(o ? a0 : a2, 0), r1 = dppq(o ? a1 : a3, 0); if (o) { a0 = r0; a1 = r1; } else { a2 = r0; a3 = r1; } }
    return (f32x4_t){a0, a1, a2, a3};
}
#define WG_BAR_L() do { asm volatile("s_waitcnt lgkmcnt(0)" ::: "memory"); __builtin_amdgcn_s_barrier(); asm volatile("" ::: "memory"); } while (0)
template <int N, int NVT, bool DB>
__device__ __forceinline__ void ret_unit(LAS unsigned char* lds, const bf16* QR_, const bf16* KR_, const bf16* VR_, bf16* ORo, const float* S_in, float* S_out,
                                         int row0, int nchunks, int h, int vbase, int tid, int lane, int wave) {
    constexpr int QP = 136, VP = NVT * 16 + 8, NTI = N / 16, WPT = 8 / NTI, TVW = NVT / WPT, NKS = N / 32;
    constexpr int OFF_K = N * QP * 2, OFF_V = 2 * N * QP * 2, SETB = OFF_V + N * VP * 2, NSET = DB ? 2 : 1, STB = NVT * 16 * QP * 2, OFF_ST = NSET * SETB;
    static_assert(OFF_ST + NSET * STB <= RING_BYTES, "retention LDS");
    const float lg = lg2gamma(h);
    const int l15 = lane & 15, l4 = lane >> 4, trq = (lane & 15) >> 2, trp = lane & 3;
    const int ti = wave / WPT, tv0 = TVW * (wave % WPT);
    constexpr int NPQ = N * 16 / 512;
    constexpr int VPR = NVT * 2;
    constexpr int NPV = (N * VPR + 511) / 512;
    f32x4_t Sacc[NVT];
    if (DB) {
#pragma unroll
        for (int tv = 0; tv < NVT; ++tv) Sacc[tv] = (f32x4_t){0.f, 0.f, 0.f, 0.f};
    } else {
#pragma unroll
        for (int tv = 0; tv < NVT; ++tv)
            Sacc[tv] = quad_tr(__builtin_nontemporal_load((const GAS f32x4_t*)(S_in + (size_t)(16 * wave + 4 * l4 + trp) * 256 + vbase + 16 * tv + 4 * trq)), trp);
    }
#pragma unroll
    for (int tv = 0; tv < NVT; ++tv) {
        unsigned long long w = (unsigned long long)pk2(Sacc[tv][0], Sacc[tv][1]) | ((unsigned long long)pk2(Sacc[tv][2], Sacc[tv][3]) << 32);
        *(LAS unsigned long long*)(lds + OFF_ST + ((16 * tv + l15) * QP + 16 * wave + 4 * l4) * 2) = w;
    }
    const float qdec = __builtin_amdgcn_exp2f(lg * (float)(16 * ti + l15)), cdec = __builtin_amdgcn_exp2f(lg * (float)N);
    float kdec[NKS][8];
#pragma unroll
    for (int ks = 0; ks < NKS; ++ks)
#pragma unroll
        for (int e = 0; e < 8; ++e) kdec[ks][e] = __builtin_amdgcn_exp2f(lg * (float)(N - (32 * ks + 8 * l4 + e)));
    v4u qreg[NPQ], kreg[NPQ], vreg[NPV];
#define RET_FETCH(c) do { _Pragma("unroll") for (int i_ = 0; i_ < NPQ; ++i_) { const int p_ = tid + 512 * i_, row_ = p_ >> 4, c8_ = p_ & 15; const size_t g_ = (size_t)(row0 + (c) * N + row_) * 1024 + h * 128 + 8 * c8_; \
            qreg[i_] = *(const GAS v4u*)(QR_ + g_); kreg[i_] = *(const GAS v4u*)(KR_ + g_); } \
        _Pragma("unroll") for (int i_ = 0; i_ < NPV; ++i_) { const int p_ = tid + 512 * i_; if (p_ < N * VPR) { const int row_ = p_ / VPR, c8_ = p_ % VPR; vreg[i_] = __builtin_nontemporal_load((const GAS v4u*)(VR_ + (size_t)(row0 + (c) * N + row_) * 2048 + h * 256 + vbase + 8 * c8_)); } } } while (0)
#define RET_STAGE(set) do { LAS unsigned char* sb_ = lds + (set) * SETB; \
        _Pragma("unroll") for (int i_ = 0; i_ < NPQ; ++i_) { const int p_ = tid + 512 * i_, row_ = p_ >> 4, c8_ = p_ & 15; *(LAS v4u*)(sb_ + (row_ * QP + 8 * c8_) * 2) = qreg[i_]; *(LAS v4u*)(sb_ + OFF_K + (row_ * QP + 8 * c8_) * 2) = kreg[i_]; } \
        _Pragma("unroll") for (int i_ = 0; i_ < NPV; ++i_) { const int p_ = tid + 512 * i_; if (p_ < N * VPR) { const int row_ = p_ / VPR, c8_ = p_ % VPR; *(LAS v4u*)(sb_ + OFF_V + (row_ * VP + 8 * c8_) * 2) = vreg[i_]; } } } while (0)
    RET_FETCH(0); RET_STAGE(0);
    if (nchunks > 1) RET_FETCH(1);
    WG_BAR_L();
    for (int c = 0; c < nchunks; ++c) {
        const int set = DB ? (c & 1) : 0;
        const LAS unsigned char* Qs = lds + set * SETB; const LAS unsigned char* Ks = Qs + OFF_K; const LAS unsigned char* Vs = Qs + OFF_V;
        const LAS unsigned char* STr = lds + OFF_ST + set * STB; LAS unsigned char* STw = lds + OFF_ST + (DB ? (set ^ 1) : 0) * STB;
        bf16x8 qf[4];
#pragma unroll
        for (int ks = 0; ks < 4; ++ks) qf[ks] = *(const LAS bf16x8*)(Qs + ((16 * ti + l15) * QP + 32 * ks + 8 * l4) * 2);
        bf16x8 pfr[NKS];
        { f32x4_t sT[NTI];
#pragma unroll
          for (int tj = 0; tj < NTI; ++tj) { f32x4_t acc = (f32x4_t){0.f, 0.f, 0.f, 0.f};
#pragma unroll
              for (int ks = 0; ks < 4; ++ks) acc = mfma16(*(const LAS bf16x8*)(Ks + ((16 * tj + l15) * QP + 32 * ks + 8 * l4) * 2), qf[ks], acc);
#pragma unroll
              for (int rg = 0; rg < 4; ++rg) { const int i = 16 * ti + l15, j = 16 * tj + 4 * l4 + rg; const int dd = i > j ? i - j : j - i; acc[rg] *= __builtin_amdgcn_exp2f(lg * (float)dd); }
              sT[tj] = acc; }
#pragma unroll
          for (int s2 = 0; s2 < NKS; ++s2) pfr[s2] = cvt8(sT[2 * s2], sT[2 * s2 + 1]); }
#pragma unroll
        for (int n = 0; n < TVW; ++n) { const int tv = tv0 + n; f32x4_t acc = (f32x4_t){0.f, 0.f, 0.f, 0.f};
#pragma unroll
            for (int ks = 0; ks < 4; ++ks) acc = mfma16(*(const LAS bf16x8*)(STr + ((16 * tv + l15) * QP + 32 * ks + 8 * l4) * 2), qf[ks], acc);
            acc = acc * qdec;
#pragma unroll
            for (int s2 = 0; s2 < NKS; ++s2) acc = mfma16(tr16(Vs + ((32 * s2 + 4 * l4 + trq) * VP + 16 * tv + 4 * trp) * 2, 16 * VP * 2), pfr[s2], acc);
            const unsigned long long w = (unsigned long long)pk2(acc[0], acc[1]) | ((unsigned long long)pk2(acc[2], acc[3]) << 32);
            *(GAS unsigned long long*)(ORo + (size_t)(row0 + c * N + 16 * ti + l15) * 2048 + h * 256 + vbase + 16 * tv + 4 * l4) = w; }
        { bf16x8 ka[NKS];
#pragma unroll
          for (int ks = 0; ks < NKS; ++ks) { const bf16x8 kr = tr16(Ks + ((32 * ks + 8 * l4 + trq) * QP + 16 * wave + 4 * trp) * 2, 4 * QP * 2);
              float kf[8]; unpack8(__builtin_bit_cast(v4u, kr), kf);
#pragma unroll
              for (int e = 0; e < 8; ++e) kf[e] *= kdec[ks][e];
              ka[ks] = cvt8((f32x4){kf[0], kf[1], kf[2], kf[3]}, (f32x4){kf[4], kf[5], kf[6], kf[7]}); }
#pragma unroll
          for (int tv = 0; tv < NVT; ++tv) { Sacc[tv] = Sacc[tv] * cdec;
#pragma unroll
            for (int ks = 0; ks < NKS; ++ks) Sacc[tv] = mfma16(ka[ks], tr16(Vs + ((32 * ks + 8 * l4 + trq) * VP + 16 * tv + 4 * trp) * 2, 4 * VP * 2), Sacc[tv]);
            if (DB) { const unsigned long long w = (unsigned long long)pk2(Sacc[tv][0], Sacc[tv][1]) | ((unsigned long long)pk2(Sacc[tv][2], Sacc[tv][3]) << 32);
                *(LAS unsigned long long*)(STw + ((16 * tv + l15) * QP + 16 * wave + 4 * l4) * 2) = w; } } }
        if (DB && c + 1 < nchunks) { RET_STAGE(set ^ 1); if (c + 2 < nchunks) RET_FETCH(c + 2); }
        WG_BAR_L();
    }
#undef RET_FETCH
#undef RET_STAGE
#pragma unroll
    for (int tv = 0; tv < NVT; ++tv)
        __builtin_nontemporal_store(quad_tr(Sacc[tv], trp), (GAS f32x4_t*)(S_out + (size_t)(16 * wave + 4 * l4 + trp) * 256 + vbase + 16 * tv + 4 * trq));
}

__device__ __forceinline__ void sattn_unit(LAS unsigned char* lds, int b, int h, const bf16* QB_, const bf16* Q2_  , const float* ck, const float* cv, const float* knew, const float* vnew, bf16* O0_, bf16* O1_, int tid, int lane, int wave) {
    constexpr int NSL = 3, KPITCH = 272, VPITCH = 320, VOFF = 64 * KPITCH, SLOT = VOFF + 64 * VPITCH, NST = 65, PD = 3;
    static_assert(NSL * SLOT <= RING_BYTES && PD == 3 && SLOT % 16 == 0, "sample attention LDS / the counted wait is (PD - 1) * 8 = 16");
    const int t = wave >> 2, kh = (wave >> 1) & 1, vh2 = wave & 1, r32 = lane & 31, hi = lane >> 5;
    bf16x8 qf[4];
    { const bf16* qp = QB_ + (size_t)(MP + 32 * b + r32) * 1024 + (2 * h + t) * 64 + 8 * hi;
      const bf16* qp2 = Q2_ + (size_t)(32 * b + r32) * 1024 + (2 * h + t) * 64 + 8 * hi;
#pragma unroll
      for (int ks = 0; ks < 4; ++ks) { float qa[8]; unpack8(*(const GAS v4u*)(qp + 16 * ks), qa);
#pragma unroll
          for (int pc = 0; pc < 3; ++pc) { float qb2[8]; unpack8(*(const GAS v4u*)(qp2 + (size_t)pc * (1024 * 1024) + 16 * ks), qb2);
#pragma unroll
              for (int e = 0; e < 8; ++e) qa[e] += qb2[e]; }
          qf[ks] = __builtin_bit_cast(bf16x8, pack8f(qa)); }
      asm volatile("s_waitcnt vmcnt(0)" ::: "memory");
#pragma unroll
      for (int ks = 0; ks < 4; ++ks) asm volatile("" : "+v"(qf[ks])); }
    size_t gko[4], gkn[4]; int lko[4], lvo[4];
#pragma unroll
    for (int i = 0; i < 4; ++i) { const int key = (tid >> 5) + 16 * i, pp = tid & 31;
        gko[i] = (size_t)key * 1024 + h * 128 + pp * 4; gkn[i] = (size_t)(key & 31) * 1024 + h * 128 + pp * 4;
        lko[i] = key * KPITCH + pp * 8; lvo[i] = VOFF + key * VPITCH + pp * 8; }
    const float* kbase = ck + (size_t)b * 4096 * 1024; const float* vbase = cv + (size_t)b * 4096 * 1024;
    const float* knb = knew + (size_t)(32 * b) * 1024; const float* vnb = vnew + (size_t)(32 * b) * 1024;
    f32x4 st[PD][8];
#define SA_LOAD(stile, sg) do { const int s_i = (stile) < NST ? (stile) : NST - 1; const bool lastt = s_i == NST - 1; \
        const float* kb_ = lastt ? knb : kbase + (size_t)s_i * 64 * 1024; const float* vb_ = lastt ? vnb : vbase + (size_t)s_i * 64 * 1024; \
        _Pragma("unroll") for (int i_ = 0; i_ < 4; ++i_) { \
            asm volatile("global_load_dwordx4 %0, %1, off nt" : "=&v"(st[sg][i_]) : "v"(kb_ + (lastt ? gkn[i_] : gko[i_])) : "memory"); \
            asm volatile("global_load_dwordx4 %0, %1, off nt" : "=&v"(st[sg][4 + i_]) : "v"(vb_ + (lastt ? gkn[i_] : gko[i_])) : "memory"); } } while (0)
#define SA_WRITE(stile, sg) do { LAS unsigned char* sl_ = lds + ((stile) % NSL) * SLOT; \
        asm volatile("s_waitcnt vmcnt(16)" : "+v"(st[sg][0]), "+v"(st[sg][1]), "+v"(st[sg][2]), "+v"(st[sg][3]), "+v"(st[sg][4]), "+v"(st[sg][5]), "+v"(st[sg][6]), "+v"(st[sg][7]) :: "memory"); \
        _Pragma("unroll") for (int i_ = 0; i_ < 4; ++i_) { \
            *(LAS unsigned long long*)(sl_ + lko[i_]) = (unsigned long long)pg8::cvt_pk_bf16(st[sg][i_][0], st[sg][i_][1]) | ((unsigned long long)pg8::cvt_pk_bf16(st[sg][i_][2], st[sg][i_][3]) << 32); \
            *(LAS unsigned long long*)(sl_ + lvo[i_]) = (unsigned long long)pg8::cvt_pk_bf16(st[sg][4 + i_][0], st[sg][4 + i_][1]) | ((unsigned long long)pg8::cvt_pk_bf16(st[sg][4 + i_][2], st[sg][4 + i_][3]) << 32); } } while (0)
#pragma unroll
    for (int k = 0; k < PD; ++k) SA_LOAD(k, k);
    SA_WRITE(0, 0); SA_LOAD(PD, 0);
    asm volatile("s_waitcnt lgkmcnt(0)" ::: "memory"); __builtin_amdgcn_s_barrier(); asm volatile("" ::: "memory");
    float mrun = -1e30f, lrun = 0.f; f32x16_t o0, o1;
#pragma unroll
    for (int r = 0; r < 16; ++r) { o0[r] = 0.f; o1[r] = 0.f; }
    const int koffs = (32 * kh + r32) * KPITCH + (64 * t + 8 * hi) * 2;
    const int voffs = VOFF + (32 * kh + 4 * hi + ((lane & 15) >> 2)) * VPITCH + (64 * vh2 + 16 * ((lane >> 4) & 1) + 4 * (lane & 3)) * 2;
    for (int t0 = 0; t0 < (NST + PD - 1) / PD * PD; t0 += PD) {
#pragma unroll
      for (int u = 0; u < PD; ++u) { const int stile = t0 + u;
        SA_WRITE(stile + 1, (u + 1) % PD); SA_LOAD(stile + 1 + PD, (u + 1) % PD);
        if (stile < NST - kh) {
        const LAS unsigned char* slot = lds + (stile % NSL) * SLOT;
        f32x16_t s_;
#pragma unroll
        for (int r = 0; r < 16; ++r) s_[r] = 0.f;
#pragma unroll
        for (int ks = 0; ks < 4; ++ks) s_ = __builtin_amdgcn_mfma_f32_32x32x16_bf16(*(const LAS bf16x8*)(slot + koffs + 32 * ks), qf[ks], s_, 0, 0, 0);
        bf16x8 vf[2][2];
#pragma unroll
        for (int s2 = 0; s2 < 2; ++s2)
#pragma unroll
            for (int bk = 0; bk < 2; ++bk) vf[s2][bk] = tr16(slot + voffs + (16 * s2) * VPITCH + (32 * bk) * 2, 8 * VPITCH);
        float mx = s_[0];
#pragma unroll
        for (int r = 1; r < 16; ++r) mx = fmaxf(mx, s_[r]);
        mx = fmaxf(mx, __shfl_xor(mx, 32));
        const float mnew = fmaxf(mrun, mx), alpha = __builtin_amdgcn_exp2f(mrun - mnew); mrun = mnew;
        float rs = 0.f;
#pragma unroll
        for (int r = 0; r < 16; ++r) { s_[r] = __builtin_amdgcn_exp2f(s_[r] - mnew); rs += s_[r]; }
        lrun = lrun * alpha + rs;
#pragma unroll
        for (int r = 0; r < 16; ++r) { o0[r] *= alpha; o1[r] *= alpha; }
#pragma unroll
        for (int s2 = 0; s2 < 2; ++s2) {
            const bf16x8 pf = cvt8((f32x4){s_[8 * s2 + 0], s_[8 * s2 + 1], s_[8 * s2 + 2], s_[8 * s2 + 3]}, (f32x4){s_[8 * s2 + 4], s_[8 * s2 + 5], s_[8 * s2 + 6], s_[8 * s2 + 7]});
            o0 = __builtin_amdgcn_mfma_f32_32x32x16_bf16(vf[s2][0], pf, o0, 0, 0, 0);
            o1 = __builtin_amdgcn_mfma_f32_32x32x16_bf16(vf[s2][1], pf, o1, 0, 0, 0); }
        }
        asm volatile("s_waitcnt lgkmcnt(0)" ::: "memory"); __builtin_amdgcn_s_barrier(); asm volatile("" ::: "memory");
      }
    }
#undef SA_LOAD
#undef SA_WRITE
    asm volatile("s_waitcnt vmcnt(0)" ::: "memory");
    lrun += __shfl_xor(lrun, 32);
    LAS float* mg = (LAS float*)(lds + (wave & ~2) * 8704);
    if (kh == 1) {
#pragma unroll
        for (int r = 0; r < 16; ++r) { mg[r * 64 + lane] = o0[r]; mg[(16 + r) * 64 + lane] = o1[r]; }
        mg[32 * 64 + lane] = mrun; mg[33 * 64 + lane] = lrun; }
    asm volatile("s_waitcnt lgkmcnt(0)" ::: "memory"); __builtin_amdgcn_s_barrier(); asm volatile("" ::: "memory");
    if (kh == 0) {
        const float m1 = mg[32 * 64 + lane], l1 = mg[33 * 64 + lane];
        const float mm = fmaxf(mrun, m1), a0 = __builtin_amdgcn_exp2f(mrun - mm), a1 = __builtin_amdgcn_exp2f(m1 - mm);
        const float inv = 1.0f / (lrun * a0 + l1 * a1);
#pragma unroll
        for (int r = 0; r < 16; ++r) { o0[r] = (o0[r] * a0 + mg[r * 64 + lane] * a1) * inv; o1[r] = (o1[r] * a0 + mg[(16 + r) * 64 + lane] * a1) * inv; }
        bf16* Ot = (t ? O1_ : O0_) + (size_t)(MP + 32 * b + r32) * 1024 + h * 128 + 64 * vh2 + 4 * hi;
#pragma unroll
        for (int g = 0; g < 4; ++g) {
            *(GAS unsigned long long*)(Ot + 8 * g) = (unsigned long long)pk2(o0[4 * g], o0[4 * g + 1]) | ((unsigned long long)pk2(o0[4 * g + 2], o0[4 * g + 3]) << 32);
            *(GAS unsigned long long*)(Ot + 32 + 8 * g) = (unsigned long long)pk2(o1[4 * g], o1[4 * g + 1]) | ((unsigned long long)pk2(o1[4 * g + 2], o1[4 * g + 3]) << 32); } }
    asm volatile("s_waitcnt lgkmcnt(0)" ::: "memory"); __builtin_amdgcn_s_barrier(); asm volatile("" ::: "memory");
}

#ifndef PROBE_MASK
#define PROBE_MASK 0u
#endif
#ifndef PROBE_REPS
#define PROBE_REPS 2
#endif
#ifndef MK_N_LAUNCHES
#define MK_N_LAUNCHES 1
#endif
constexpr int NPHASE = 25;
constexpr int N_LAUNCHES = MK_N_LAUNCHES;
static_assert(N_LAUNCHES == 1 || N_LAUNCHES == NPHASE, "MK_N_LAUNCHES is 1 or 25");
struct Args { const float* in[23]; float* out; unsigned char* ws; int ph_lo, ph_hi; };
static_assert(sizeof(Args) == 25 * 8 + 8, "Args has no holes");

template <class Epi>
__device__ __forceinline__ void run_gemm(LAS unsigned char* lds, const bf16* A, const bf16* Bt, int N, int K, int G, int c, const Epi& E) {
    pg8::Gemm g{A, Bt, M, N, K}; pg8::StaticOrder S; S.init(M, N, K, G, c);
    pg8::gemm_phase<Epi, pg8::StaticOrder, true, true>(lds + RING_OFF, g, S, E);
}
template <class Epi>
__device__ __forceinline__ void run_gemm_q(LAS unsigned char* lds, const bf16* A, const bf16* Bt, int G, int c, const Epi& E) {
    pg8::Gemm g{A, Bt, M, 1024, 1024}; pg8::QSplit S; S.init(G, c);
    pg8::gemm_phase<Epi, pg8::QSplit, true, true>(lds + RING_OFF, g, S, E);
}
template <class Epi>
__device__ __forceinline__ void run_gemm_sk(LAS unsigned char* lds, const bf16* A, const bf16* Bt, int N, int K, int G, int v, const Epi& E) {
    pg8::Gemm g{A, Bt, M, N, K}; pg8::StreamK S; S.init(M, N, K, G, v);
    pg8::gemm_phase<Epi, pg8::StreamK, true, true>(lds + RING_OFF, g, S, E);
}

__global__ void __launch_bounds__(NWAVES * 64, 2) yoco_fwd(Args args) {
    extern __shared__ __attribute__((aligned(16))) unsigned char lds_raw[];
    LAS unsigned char* lds = (LAS unsigned char*)lds_raw;
    volatile LAS unsigned* MISC = (volatile LAS unsigned*)(lds + MISC_OFF);
    const int tid = threadIdx.x, lane = tid & 63, wave = __builtin_amdgcn_readfirstlane(tid >> 6);
    const int G = gridDim.x; const int bx = blockIdx.x; const int vcu = (G % 8 == 0) ? (bx % 8) * (G / 8) + bx / 8 : bx;
    const int gw = vcu * NWAVES + wave, NGW = G * NWAVES;
    unsigned char* ws = args.ws; float* out = args.out;
    gu32* ctl = (gu32*)(ws + WS_CTL);
    for (int u = tid; u < (LDS_BYTES - LDSCTL_OFF) / 4; u += NWAVES * 64) ((LAS unsigned*)(lds + LDSCTL_OFF))[u] = 0u;
    __syncthreads();
    XcdBarrier bar; bar.bar = (unsigned*)(ctl + CW_BAR); bar.x = 0; bar.st = nullptr;
    if (N_LAUNCHES == 1) bar = xcd_barrier_post((unsigned*)(ctl + CW_BAR), MISC + 8);
#define GRID_BAR() do { if (N_LAUNCHES == 1) xcd_barrier(bar); } while (0)
    const int lo = args.ph_lo, hi = args.ph_hi;
#define IN(k) (lo <= (k) && (k) < hi)
#define SEAM(k) do { if (IN((k) + 1)) GRID_BAR(); } while (0)
#define SEAMF(k, a, b) do { const bool inl_ = (N_LAUNCHES == 1) && IN((k) + 1); unsigned t_ = 0u; if (inl_) t_ = xcd_barrier_arrive(bar); \
        { const P0Args A_ = P0ARGS; p0_convert<3>(A_, lds, gw, NGW, lane, wave, (a), (b)); } if (inl_) xcd_barrier_wait(bar, t_); } while (0)

#define x_p (args.in[0])
#define x_s (args.in[1])
#define state_ret (args.in[2])
#define cache_k (args.in[3])
#define cache_v (args.in[4])
#define g_norm (args.in[9])
#define g_gn_a (args.in[13])
#define g_kv (args.in[17])
#define lam_b (args.in[20])
#define g_sub (args.in[21])
#define MOD ((const float*)(ws + WS_MOD))
#define ropeA ((const float*)(ws + WS_ROPEA))
#define ropeB ((const float*)(ws + WS_ROPEB))
#define H ((bf16*)(ws + WS_H))
#define HKV ((bf16*)(ws + WS_HKV))
#define Y ((bf16*)(ws + WS_Y))
#define U ((bf16*)(ws + WS_U))
#define QR ((bf16*)(ws + WS_QR))
#define KR ((bf16*)(ws + WS_KR))
#define VR ((bf16*)(ws + WS_VR))
#define GR ((bf16*)(ws + WS_GR))
#define OR_ ((bf16*)(ws + WS_OR))
#define AR ((bf16*)(ws + WS_AR))
#define KB ((bf16*)(ws + WS_KB))
#define VB ((bf16*)(ws + WS_VB))
#define QB ((bf16*)(ws + WS_QB))
#define O0 ((bf16*)(ws + WS_O0))
#define O1 ((bf16*)(ws + WS_O1))
#define AB ((bf16*)(ws + WS_AB))
#define XB ((bf16*)(ws + WS_XB))
#define X (out + OUT_Y)
    const RowOut none{nullptr, 0, 0, nullptr};
#define WFI(l, i) ((const bf16*)(ws + WS_WFI + (size_t)((l) * 2 + (i)) * SZ_WFI))
#define WFO(l, i) ((const bf16*)(ws + WS_WFO + (size_t)((l) * 2 + (i)) * SZ_WFO))
#define GN(l, j) (g_norm + ((l) * 6 + (j)) * 1024)
#define MC(l, j) (((l) * 9 + (j)) * 1024)

#define P0ARGS P0Args{args.in[5], args.in[6], args.in[7], args.in[8], args.in[10], args.in[11], args.in[12], args.in[14], args.in[15], args.in[16], args.in[18], args.in[19], args.in[22], ws}
    if (IN(0)) { const P0Args A = P0ARGS; p0_mod(A, lds, vcu, G, tid, lane, wave);
        const bool split = (N_LAUNCHES == 1) && IN(1); unsigned tgt = 0u;
        if (split) tgt = xcd_barrier_arrive(bar);
        p0_rest(A, lds, vcu, G, tid, lane, wave);
        if (split) xcd_barrier_wait(bar, tgt); }
    if (IN(1)) { rowpass<false, 1, false, 0>(x_p, x_s, nullptr, nullptr, nullptr, 0, 0.f, nullptr, RowOut{GN(0, 0), MC(0, 0), MC(0, 1), H}, none, MOD, gw, NGW, lane, 0, G); SEAMF(1, 0, 1408); }
    if (IN(2)) { run_gemm(lds, H, WFI(0, 0), 2 * DFF, 1024, G, bx, pg8::EpiSwiglu{U, DFF}); SEAMF(2, 1408, 2944); }
    if (IN(3)) { run_gemm_sk(lds, U, WFO(0, 0), 1024, DFF, G, vcu, pg8::EpiBf16{Y, 1024, SZ_A1 / 2}); SEAMF(3, 2944, 4480); }
    if (IN(4)) { rowpass<true, 1, false, 1>(x_p, x_s, XB, Y, GN(0, 1), MC(0, 2), 0.5f, nullptr, RowOut{GN(0, 2), MC(0, 3), MC(0, 4), H}, none, MOD, gw, NGW, lane, DFF, G); SEAMF(4, 4480, 5064); }
    if (IN(5)) { run_gemm(lds, H, (const bf16*)(ws + WS_WIA), AIN, 1024, G, bx, pg8::EpiRetIn{QR, KR, VR, GR, ropeA});
        { const int nu = 68 * 24, full = nu / G, rem = nu - full * G;
          const int f0 = rem ? rem : 0, nf = G - f0; if (bx >= f0) { const P0Args A = P0ARGS; p0_convert<1>(A, lds, (bx - f0) * NWAVES + wave, nf * NWAVES, lane, wave); } }
        SEAMF(5, 5064, 5648); }
    if (IN(6)) {
        for (int id = vcu; id < 256; id += G) { const int b = id >> 5, h = (id >> 2) & 7, vs = id & 3;
            ret_unit<64, 4, true>(lds, QR, KR, VR, OR_, nullptr, out + OUT_SRP + (size_t)(b * 8 + h) * 128 * 256, 2048 * b, 32, h, 64 * vs, tid, lane, wave); }
        for (int id = vcu; id < 256; id += G) { const int b = id >> 3, h = id & 7;
            ret_unit<32, 16, false>(lds, QR, KR, VR, OR_, state_ret + (size_t)(b * 8 + h) * 128 * 256, out + OUT_SRS + (size_t)(b * 8 + h) * 128 * 256, MP + 32 * b, 1, h, 0, tid, lane, wave); }
        SEAMF(6, 5648, 6232); }
    if (IN(7)) { gatenorm_pass(OR_, GR, g_gn_a, AR, gw, NGW, lane); SEAMF(7, 6232, 6816); }
    if (IN(8)) { run_gemm_sk(lds, AR, (const bf16*)(ws + WS_WOA), 1024, 2048, G, vcu, pg8::EpiBf16{Y, 1024, SZ_A1 / 2}); SEAMF(8, 6816, 7400); }
    if (IN(9)) { rowpass<true, 1, true, 1>(nullptr, nullptr, XB, Y, GN(0, 3), MC(0, 5), 1.0f, nullptr, RowOut{GN(0, 4), MC(0, 6), MC(0, 7), H}, none, MOD, gw, NGW, lane, 2048, G); SEAMF(9, 7400, 7984); }
    if (IN(10)) { run_gemm(lds, H, WFI(0, 1), 2 * DFF, 1024, G, bx, pg8::EpiSwiglu{U, DFF}); SEAMF(10, 7984, 8568); }
    if (IN(11)) { run_gemm_sk(lds, U, WFO(0, 1), 1024, DFF, G, vcu, pg8::EpiBf16{Y, 1024, SZ_A1 / 2}); SEAMF(11, 8568, 9152); }
    if (IN(12)) { rowpass<true, 2, true, 1>(nullptr, nullptr, XB, Y, GN(0, 5), MC(0, 8), 0.5f, nullptr, RowOut{GN(1, 0), MC(1, 0), MC(1, 1), H}, RowOut{g_kv, 18432, 18432 + 1024, HKV}, MOD, gw, NGW, lane, DFF, G); SEAMF(12, 9152, 9728); }
    if (IN(13)) { run_gemm(lds, H, WFI(1, 0), 2 * DFF, 1024, G, bx, pg8::EpiSwiglu{U, DFF});
        const bool inl_ = (N_LAUNCHES == 1) && IN(14); unsigned t_ = 0u; if (inl_) t_ = xcd_barrier_arrive(bar);
        run_gemm(lds, HKV, (const bf16*)(ws + WS_WKV), 2048, 1024, G, (bx + G - (1496 % G)) % G, pg8::EpiKV{KB, VB, out + OUT_KP, out + OUT_KS, out + OUT_VP, out + OUT_VS, ropeB});
        { const P0Args A_ = P0ARGS; p0_convert<3>(A_, lds, gw, NGW, lane, wave, 9728, 9984); }
        if (inl_) xcd_barrier_wait(bar, t_); }
    if (IN(14)) { run_gemm_sk(lds, U, WFO(1, 0), 1024, DFF, G, vcu, pg8::EpiBf16{Y, 1024, SZ_A1 / 2}); SEAMF(14, 9984, 10240); }
    if (IN(15)) { rowpass<true, 1, true, 1>(nullptr, nullptr, XB, Y, GN(1, 1), MC(1, 2), 0.5f, nullptr, RowOut{GN(1, 2), MC(1, 3), MC(1, 4), H}, none, MOD, gw, NGW, lane, DFF, G); SEAM(15); }
    if (IN(16)) { run_gemm_q(lds, H, (const bf16*)(ws + WS_WQB), G, bx, pg8::EpiQ{QB, Y - (size_t)MP * 1024, ropeB, QSCALE});
        { const int f0 = G > 64 ? 64 : 0, nf = G - f0;
          if (bx >= f0) { const P0Args A = P0ARGS; p0_convert<2>(A, lds, (bx - f0) * NWAVES + wave, nf * NWAVES, lane, wave); } }
        SEAM(16); }
    const bool sfirst = IN(17) && IN(18) && ((vcu >> 3) & 1);
    if (IN(18) && sfirst) { for (int id = vcu; id < 256; id += G) sattn_unit(lds, id >> 3, id & 7, QB, Y, cache_k, cache_v, out + OUT_KS, out + OUT_VS, O0, O1, tid, lane, wave); }
    if (IN(17)) {
        const attn_body::AttnTensors AT{(const attn_body::bf16*)QB, (const attn_body::bf16*)KB, (const attn_body::bf16*)VB, (attn_body::bf16*)O0, (attn_body::bf16*)O1};
        const attn_body::StaticOrder S(G, vcu);
        attn_body::attn_phase<attn_body::StaticOrder>((char*)lds_raw + RING_OFF, AT, S); }
    if (IN(18)) {
        if (!sfirst) { for (int id = vcu; id < 256; id += G) sattn_unit(lds, id >> 3, id & 7, QB, Y, cache_k, cache_v, out + OUT_KS, out + OUT_VS, O0, O1, tid, lane, wave); }
        SEAM(18); }
    if (IN(19)) { diffnorm_pass(O0, O1, lam_b, g_sub, AB, gw, NGW, lane); SEAM(19); }
    if (IN(20)) { run_gemm_sk(lds, AB, (const bf16*)(ws + WS_WOB), 1024, 1024, G, vcu, pg8::EpiBf16{Y, 1024, SZ_A1 / 2}); SEAM(20); }
    if (IN(21)) { rowpass<true, 1, true, 1>(nullptr, nullptr, XB, Y, GN(1, 3), MC(1, 5), 1.0f, nullptr, RowOut{GN(1, 4), MC(1, 6), MC(1, 7), H}, none, MOD, gw, NGW, lane, 1024, G); SEAM(21); }
    if (IN(22)) { run_gemm(lds, H, WFI(1, 1), 2 * DFF, 1024, G, bx, pg8::EpiSwiglu{U, DFF}); SEAM(22); }
    if (IN(23)) { run_gemm_sk(lds, U, WFO(1, 1), 1024, DFF, G, vcu, pg8::EpiBf16{Y, 1024, SZ_A1 / 2}); SEAM(23); }
    if (IN(24)) { rowpass<true, 0, true, 2>(nullptr, nullptr, XB, Y, GN(1, 5), MC(1, 8), 0.5f, out + OUT_Y, none, none, MOD, gw, NGW, lane, DFF, G); }
#undef IN
#undef SEAM
#undef SEAMF
#undef GRID_BAR
}

extern "C" void kernel_launch(void* const* d_in, const int* in_sizes, int n_in, void* d_out, int out_size, void* d_ws, size_t ws_size, hipStream_t stream) {
    static int grid = 0;
    if (grid == 0) {
        if (n_in != 23 || in_sizes[0] != MP * D || (size_t)out_size != OUT_END || ws_size < WS_END) { fprintf(stderr, "kernel_launch: unexpected shapes (n_in %d, in0 %d, out %d, ws %zu); nothing launched\n", n_in, n_in > 0 ? in_sizes[0] : -1, out_size, ws_size); grid = -1; return; }
        int dev = 0, cus = 0, per_cu = 0;
        if (hipGetDevice(&dev) != hipSuccess || hipDeviceGetAttribute(&cus, hipDeviceAttributeMultiprocessorCount, dev) != hipSuccess) { fprintf(stderr, "kernel_launch: device query failed\n"); grid = -1; return; }
        if (hipFuncSetAttribute((const void*)yoco_fwd, hipFuncAttributeMaxDynamicSharedMemorySize, LDS_BYTES) != hipSuccess) { fprintf(stderr, "kernel_launch: hipFuncSetAttribute failed\n"); grid = -1; return; }
        if (hipOccupancyMaxActiveBlocksPerMultiprocessor(&per_cu, (const void*)yoco_fwd, NWAVES * 64, LDS_BYTES) != hipSuccess || per_cu < 1)
            fprintf(stderr, "kernel_launch: note: occupancy query reports %d workgroups per CU\n", per_cu);
        (void)hipGetLastError();
        grid = cus;
    }
    if (grid < 0) return;
    if (hipMemsetAsync((char*)d_ws + WS_CTL, 0, ZERO_BYTES, stream) != hipSuccess) { fprintf(stderr, "kernel_launch: hipMemsetAsync failed\n"); return; }
    Args a{};
    for (int i = 0; i < 23; ++i) a.in[i] = (const float*)d_in[i];
    a.out = (float*)d_out; a.ws = (unsigned char*)d_ws;
    for (int li = 0; li < N_LAUNCHES; ++li) {
        a.ph_lo = (N_LAUNCHES == 1) ? 0 : li; a.ph_hi = (N_LAUNCHES == 1) ? NPHASE : li + 1;
        for (int rp = 0; rp < 1 + ((N_LAUNCHES != 1 && ((PROBE_MASK >> li) & 1u)) ? PROBE_REPS : 0); ++rp)
        hipLaunchKernelGGL(yoco_fwd, dim3(grid), dim3(NWAVES * 64), LDS_BYTES, stream, a);
        const hipError_t le = hipPeekAtLastError();
        if (le != hipSuccess) { fprintf(stderr, "kernel_launch: launch %d failed: %s\n", li, hipGetErrorName(le)); break; }
    }
}
```
